# Optimizing an MI355X kernel written in HIP

```python
import math
import jax, jax.numpy as jnp
from jax import lax
import numpy as np

D_MODEL = 2048
BATCH = 2
SEQ = 8192
DEPTH = 2

MEM_LEN = 256
D_CONV = 1024
CONV_WIDTH = 31
CONV_PAD = (CONV_WIDTH - 1) // 2
D_FOURIER = 512
N_FOURIER_GROUPS = 4
FOURIER_GROUP = D_FOURIER // N_FOURIER_GROUPS
N_MEM_HEADS = 4
MEM_HEAD_DIM = 128
D_MEM_Q = N_MEM_HEADS * MEM_HEAD_DIM
N_BRANCHES = 3
D_FF = 5632
D_IN = 2 * D_CONV + D_FOURIER + D_MEM_Q + N_BRANCHES * D_MODEL
DN_ALPHA = (2.0 * DEPTH) ** 0.25
DN_BETA = (8.0 * DEPTH) ** -0.25
LN_EPS = 1e-5

kernel_name = "hybrid_conv_fourier_memattn_deepnorm_encoder"


def layer_norm(x, g, b):
    xf = x.astype(jnp.float32)
    mu = jnp.mean(xf, axis=-1, keepdims=True)
    xc = xf - mu
    var = jnp.mean(xc * xc, axis=-1, keepdims=True)
    y = xc * lax.rsqrt(var + LN_EPS) * g.astype(jnp.float32) + b.astype(jnp.float32)
    return y.astype(x.dtype)


def swiglu_ffn(x, w13, w2):
    h = x @ w13
    a, g = jnp.split(h, 2, axis=-1)
    return (jax.nn.silu(g) * a) @ w2


def conformer_conv_branch(u_val, u_gate, conv_w, conv_b, ln_g, ln_b, w_proj):
    h = u_val * jax.nn.sigmoid(u_gate)
    h = lax.conv_general_dilated(
        h, conv_w[:, None, :].astype(h.dtype),
        window_strides=(1,), padding=[(CONV_PAD, CONV_PAD)],
        dimension_numbers=("NWC", "WIO", "NWC"),
        feature_group_count=D_CONV) + conv_b
    h = jax.nn.silu(layer_norm(h, ln_g, ln_b))
    return h @ w_proj


def fourier_branch(u, w_lin):
    b, s, _ = u.shape
    ug = u.reshape(b, s, N_FOURIER_GROUPS, FOURIER_GROUP).astype(jnp.float32)
    f = jnp.fft.fft2(ug, axes=(1, 3), norm="ortho").real
    f = f.reshape(b, s, D_FOURIER).astype(u.dtype)
    return f @ w_lin


def memory_cross_attention(q_flat, mem, w_kv, w_o):
    b, s, _ = q_flat.shape
    q = q_flat.reshape(b, s, N_MEM_HEADS, MEM_HEAD_DIM)
    kv = mem @ w_kv
    k, v = jnp.split(kv, 2, axis=-1)
    k = k.reshape(b, MEM_LEN, N_MEM_HEADS, MEM_HEAD_DIM)
    v = v.reshape(b, MEM_LEN, N_MEM_HEADS, MEM_HEAD_DIM)
    scores = jnp.einsum("bshd,bmhd->bhsm", q, k).astype(jnp.float32) * (MEM_HEAD_DIM ** -0.5)
    p = jax.nn.softmax(scores, axis=-1).astype(v.dtype)
    o = jnp.einsum("bhsm,bmhd->bshd", p, v).reshape(b, s, D_MEM_Q)
    return o @ w_o


def setup_inputs(seed: int = 0) -> dict:
    key = jax.random.key(seed)
    ks = jax.random.split(key, 24)
    f32 = jnp.float32

    def nrm(k, shape, scale):
        return jax.random.normal(k, shape, f32) * scale

    def gain(k, shape):
        return 1.0 + 0.01 * jax.random.normal(k, shape, f32)

    def bias(k, shape):
        return 0.01 * jax.random.normal(k, shape, f32)

    L, D = DEPTH, D_MODEL
    return {
        "x": nrm(ks[0], (BATCH, SEQ, D), 1.0),
        "mem": nrm(ks[1], (BATCH, MEM_LEN, D), 1.0),
        "ffn1_w13": nrm(ks[2], (L, D, 2 * D_FF), D ** -0.5),
        "ffn1_w2": nrm(ks[3], (L, D_FF, D), DN_BETA * D_FF ** -0.5),
        "ln1_g": gain(ks[4], (L, D)),
        "ln1_b": bias(ks[5], (L, D)),
        "w_in": nrm(ks[6], (L, D, D_IN), D ** -0.5),
        "b_in": bias(ks[7], (L, D_IN)),
        "conv_w": nrm(ks[8], (L, CONV_WIDTH, D_CONV), CONV_WIDTH ** -0.5),
        "conv_b": bias(ks[9], (L, D_CONV)),
        "conv_ln_g": gain(ks[10], (L, D_CONV)),
        "conv_ln_b": bias(ks[11], (L, D_CONV)),
        "w_conv_out": nrm(ks[12], (L, D_CONV, D), D_CONV ** -0.5),
        "w_fourier": nrm(ks[13], (L, D_FOURIER, D), D_FOURIER ** -0.5),
        "w_mem_kv": nrm(ks[14], (L, D, 2 * D_MEM_Q), D ** -0.5),
        "w_mem_o": nrm(ks[15], (L, D_MEM_Q, D), D_MEM_Q ** -0.5),
        "w_out": nrm(ks[16], (L, D, D), DN_BETA * D ** -0.5),
        "ln2_g": gain(ks[17], (L, D)),
        "ln2_b": bias(ks[18], (L, D)),
        "ffn2_w13": nrm(ks[19], (L, D, 2 * D_FF), D ** -0.5),
        "ffn2_w2": nrm(ks[20], (L, D_FF, D), DN_BETA * D_FF ** -0.5),
        "ln3_g": gain(ks[21], (L, D)),
        "ln3_b": bias(ks[22], (L, D)),
    }


def reference(x, mem, ffn1_w13, ffn1_w2, ln1_g, ln1_b, w_in, b_in,
              conv_w, conv_b, conv_ln_g, conv_ln_b, w_conv_out, w_fourier,
              w_mem_kv, w_mem_o, w_out, ln2_g, ln2_b,
              ffn2_w13, ffn2_w2, ln3_g, ln3_b):
    c0 = 0
    c1 = c0 + D_CONV
    c2 = c1 + D_CONV
    c3 = c2 + D_FOURIER
    c4 = c3 + D_MEM_Q
    b, s, _ = x.shape
    for l in range(DEPTH):
        x = layer_norm(DN_ALPHA * x + 0.5 * swiglu_ffn(x, ffn1_w13[l], ffn1_w2[l]),
                       ln1_g[l], ln1_b[l])

        h = x @ w_in[l] + b_in[l]
        y_conv = conformer_conv_branch(h[..., c0:c1], h[..., c1:c2], conv_w[l], conv_b[l],
                                       conv_ln_g[l], conv_ln_b[l], w_conv_out[l])
        y_four = fourier_branch(h[..., c2:c3], w_fourier[l])
        y_mem = memory_cross_attention(h[..., c3:c4], mem, w_mem_kv[l], w_mem_o[l])
        gates = jax.nn.sigmoid(h[..., c4:]).reshape(b, s, N_BRANCHES, D_MODEL)
        merged = (gates[:, :, 0] * y_conv + gates[:, :, 1] * y_four
                  + gates[:, :, 2] * y_mem)
        x = layer_norm(DN_ALPHA * x + merged @ w_out[l], ln2_g[l], ln2_b[l])

        x = layer_norm(DN_ALPHA * x + 0.5 * swiglu_ffn(x, ffn2_w13[l], ffn2_w2[l]),
                       ln3_g[l], ln3_b[l])
    return x
```

```cpp
#include <hip/hip_runtime.h>
#include <hip/hip_cooperative_groups.h>
#include <cstdio>
namespace cg = cooperative_groups;

#ifndef PH_MASK
#define PH_MASK 0xFFFF
#endif
#define PHON(k) ((PH_MASK >> (k)) & 1)
#ifndef ONE_LAUNCH
#define ONE_LAUNCH 1
#endif

#define LAS __attribute__((address_space(3)))
#define DI __device__ __forceinline__
typedef unsigned short bf16_t;
typedef short bf16x8 __attribute__((ext_vector_type(8)));
typedef float f32x4 __attribute__((ext_vector_type(4)));
typedef float f32x2 __attribute__((ext_vector_type(2)));
typedef float f32x16 __attribute__((ext_vector_type(16)));
typedef unsigned u32x4 __attribute__((ext_vector_type(4)));
typedef unsigned u32x2 __attribute__((ext_vector_type(2)));
typedef __bf16 bf16x2_t __attribute__((ext_vector_type(2)));

constexpr int NTOK = 16384, DM = 2048, DFF = 5632, DIN = 9216, SEQ = 8192, NLAYER = 2;
constexpr float DN_ALPHA = 1.4142135623730951f;
constexpr float LN_EPS = 1e-5f;

constexpr size_t WS_CM    = 0;
constexpr size_t CM_HALF  = (size_t)SEQ * SEQ * 2;
constexpr size_t WS_XB    = WS_CM + 2 * CM_HALF;
constexpr size_t WS_MEMB  = WS_XB + (size_t)NTOK * DM * 2;
constexpr size_t WS_W13A  = WS_MEMB + (size_t)512 * DM * 2;
constexpr size_t WS_W2A   = WS_W13A + (size_t)2 * DFF * DM * 2;
constexpr size_t WS_W13B  = WS_W2A + (size_t)DM * DFF * 2;
constexpr size_t WS_W2B   = WS_W13B + (size_t)2 * DFF * DM * 2;
constexpr size_t WS_WIN   = WS_W2B + (size_t)DM * DFF * 2;
constexpr size_t WS_WFT   = WS_WIN + (size_t)DIN * DM * 2;
constexpr size_t WS_WCO   = WS_WFT + (size_t)1024 * DM * 2;
constexpr size_t WS_WF2   = WS_WCO + (size_t)DM * 1024 * 2;
constexpr size_t WS_WKV   = WS_WF2 + (size_t)DM * 1024 * 2;
constexpr size_t WS_WO    = WS_WKV + (size_t)1024 * DM * 2;
constexpr size_t WS_WOUT  = WS_WO + (size_t)DM * 512 * 2;
constexpr size_t WS_BIAST = WS_WOUT + (size_t)DM * DM * 2;
constexpr size_t WS_KK    = WS_BIAST + 4096;
constexpr size_t WS_VT    = WS_KK + (size_t)512 * 512 * 2;
constexpr size_t WS_MIX   = WS_VT + (size_t)512 * 512 * 2;
constexpr size_t WS_G     = WS_MIX;
constexpr size_t WS_GLU   = WS_G + (size_t)NTOK * 6144 * 2;
constexpr size_t WS_TT    = WS_GLU + (size_t)NTOK * 1024 * 2;
constexpr size_t WS_MG    = WS_GLU;
constexpr size_t WS_Q     = WS_TT + (size_t)1024 * NTOK * 2;
constexpr size_t WS_CV    = WS_Q + (size_t)NTOK * 512 * 2;
constexpr size_t WS_PP    = WS_CV + (size_t)NTOK * 1024 * 2;
constexpr size_t WS_OO    = WS_PP + (size_t)NTOK * 1024 * 2;
constexpr size_t WS_END   = WS_OO + (size_t)NTOK * 512 * 2;
constexpr size_t WS_H     = WS_MIX;
static_assert((size_t)NTOK * DFF * 2 <= WS_END - WS_MIX, "H must fit the union region");

constexpr int LDS_BYTES = 131072 + 4096;

DI int ltid() { int t = threadIdx.x; asm volatile("" : "+v"(t)); return t; }
DI unsigned pk2(float a, float b) { f32x2 v = {a, b}; bf16x2_t r = __builtin_convertvector(v, bf16x2_t); return __builtin_bit_cast(unsigned, r); }
DI bf16_t f2bf(float a) { return (bf16_t)(pk2(a, 0.f) & 0xffffu); }
DI float sigmoidf_fast(float x) { return __builtin_amdgcn_rcpf(1.0f + __expf(-x)); }
DI float wave_sum(float v) {
#pragma unroll
    for (int o = 1; o < 64; o <<= 1) v += __shfl_xor(v, o);
    return v;
}
DI u32x4 pack8(const f32x4 v0, const f32x4 v1) { u32x4 w; w.x = pk2(v0[0], v0[1]); w.y = pk2(v0[2], v0[3]); w.z = pk2(v1[0], v1[1]); w.w = pk2(v1[2], v1[3]); return w; }
DI void unpack8(const u32x4 w, f32x4& v0, f32x4& v1) {
    v0[0] = __uint_as_float(w.x << 16); v0[1] = __uint_as_float(w.x & 0xffff0000u); v0[2] = __uint_as_float(w.y << 16); v0[3] = __uint_as_float(w.y & 0xffff0000u);
    v1[0] = __uint_as_float(w.z << 16); v1[1] = __uint_as_float(w.z & 0xffff0000u); v1[2] = __uint_as_float(w.w << 16); v1[3] = __uint_as_float(w.w & 0xffff0000u);
}

constexpr int BK = 64, HALF = 128, HTB = HALF * BK * 2;
DI int lds_byte(int r, int c) { const int st = (r >> 4) * 2 + (c >> 5), rr = r & 15, cc = c & 31, ob = rr * 64 + cc * 2; return st * 1024 + (ob ^ (((ob >> 9) & 1) << 5)); }
DI void stage_rc(int b, int& R, int& C) { const int st = b / 1024, sb = b % 1024, swz = sb ^ (((sb >> 9) & 1) << 5); R = (st >> 1) * 16 + swz / 64; C = (st & 1) * 32 + (swz % 64) / 2; }
DI int perm32(int rho) { const int n = rho >> 4, i = rho & 15; return 8 * (i >> 2) + 4 * n + (i & 3); }

struct Unit { const char* A; const char* B0; const char* B1; int kind, pm, pn; };

DI void tile_decode(int wgid, int nM, int nN, int& pm, int& pn) {
    const int nwg = nM * nN;
    { const int q = nwg / 8, r = nwg % 8, xcd = wgid % 8, off = wgid / 8; wgid = (xcd < r ? xcd * (q + 1) : r * (q + 1) + (xcd - r) * q) + off; }
    const int nig = 8 * nN, gid = wgid / nig, fm = gid * 8, gsz = (nM - fm) < 8 ? (nM - fm) : 8;
    pm = fm + ((wgid % nig) % gsz); pn = (wgid % nig) / gsz;
}

template <class Epi, class Sched>
DI void gemm_phase(LAS unsigned char* lds, const int K, const int lda, const int ldb, const Sched& S, const Epi& E) {
    const int tid = ltid(), wid = __builtin_amdgcn_readfirstlane(tid >> 6), lane = tid & 63, wr = wid >> 2, wc = wid & 3, fr = lane & 15, fq = lane >> 4;
    const int nt = K / BK;
    unsigned voffA[2], voffB[2];
#pragma unroll
    for (int i = 0; i < 2; ++i) { int R, C; stage_rc(tid * 16 + i * 8192, R, C); const int Rb = Epi::PERM ? ((R & ~31) + perm32(R & 31)) : R;
        voffA[i] = (unsigned)(R * lda + C) * 2u; voffB[i] = (unsigned)(Rb * ldb + C) * 2u; }
    const size_t kstep = (size_t)(BK * 2);
    const size_t hstepA = (size_t)HALF * lda * 2;
    const unsigned ldsw = (unsigned)wid * 1024u;
    const int aoff = lds_byte(wr * 64 + fr, fq * 8), boff = lds_byte(wc * 32 + fr, fq * 8);
#define G_SA(b, h) (((b) * 2 + (h)) * HTB)
#define G_SB(b, h) ((4 + (b) * 2 + (h)) * HTB)
#define G_STAGE(bufoff, gbase, voff) do { _Pragma("unroll") for (int _i = 0; _i < 2; ++_i) \
        __builtin_amdgcn_global_load_lds((const unsigned*)((const char*)(gbase) + (voff)[_i]), (LAS unsigned*)(lds + (bufoff) + ldsw + _i * 8192), 16, 0, 0); } while (0)
#define G_LDA(dst, b, h) do { _Pragma("unroll") for (int m = 0; m < 4; ++m) _Pragma("unroll") for (int k = 0; k < 2; ++k) dst[m][k] = *(const LAS bf16x8*)(lds + G_SA(b, h) + aoff + m * 2048 + k * 1024); } while (0)
#define G_LDB(dst, b, h) do { _Pragma("unroll") for (int n = 0; n < 2; ++n) _Pragma("unroll") for (int k = 0; k < 2; ++k) dst[n][k] = *(const LAS bf16x8*)(lds + G_SB(b, h) + boff + n * 2048 + k * 1024); } while (0)
#define G_MMA(ai, bj, At, Bt) do { __builtin_amdgcn_s_setprio(1); _Pragma("unroll") for (int m = 0; m < 4; ++m) _Pragma("unroll") for (int n = 0; n < 2; ++n) _Pragma("unroll") for (int k = 0; k < 2; ++k) \
        acc[ai][bj][m][n] = __builtin_amdgcn_mfma_f32_16x16x32_bf16(Bt[n][k], At[m][k], acc[ai][bj][m][n], 0, 0, 0); __builtin_amdgcn_s_setprio(0); } while (0)
#define G_WAIT_V(n) asm volatile("s_waitcnt vmcnt(" #n ")" ::: "memory")
#define G_WAIT_L(n) asm volatile("s_waitcnt lgkmcnt(" #n ")" ::: "memory")
#define G_BAR __builtin_amdgcn_s_barrier()
#define G_SCHED __builtin_amdgcn_sched_barrier(0)
    Unit cur, nxt; int ui = 0;
    if (!S.next(0, cur)) return;
    f32x4 acc[2][2][4][2];
#pragma unroll
    for (int a = 0; a < 2; ++a)
#pragma unroll
        for (int b = 0; b < 2; ++b)
#pragma unroll
            for (int m = 0; m < 4; ++m)
#pragma unroll
                for (int n = 0; n < 2; ++n) acc[a][b][m][n] = (f32x4){0.f, 0.f, 0.f, 0.f};
    bf16x8 At[4][2], B0[2][2], B1[2][2];
    const char* cA = cur.A; const char* cB0 = cur.B0; const char* cB1 = cur.B1;
    G_STAGE(G_SB(0, 0), cB0, voffB); G_STAGE(G_SA(0, 0), cA, voffA); G_STAGE(G_SB(0, 1), cB1, voffB); G_STAGE(G_SA(0, 1), cA + hstepA, voffA);
    if (wr == 1) G_BAR;
    G_WAIT_V(4); G_BAR;
    G_STAGE(G_SB(1, 0), cB0 + kstep, voffB); G_STAGE(G_SA(1, 0), cA + kstep, voffA); G_STAGE(G_SB(1, 1), cB1 + kstep, voffB);
    G_WAIT_V(6); G_BAR;
    for (;;) {
        const bool has_next = S.next(ui + 1, nxt);
        const char* nA = has_next ? nxt.A : cA; const char* nB0 = has_next ? nxt.B0 : cB0; const char* nB1 = has_next ? nxt.B1 : cB1;
        for (int t = 0; t < nt; t += 2) {
            const bool last = (t == nt - 2);
            const char* a1 = cA + (size_t)(t + 1) * kstep;
            const char* a2 = last ? nA : cA + (size_t)(t + 2) * kstep;
            const char* b20 = last ? nB0 : cB0 + (size_t)(t + 2) * kstep;
            const char* b21 = last ? nB1 : cB1 + (size_t)(t + 2) * kstep;
            const char* a3 = a2 + kstep; const char* b30 = b20 + kstep; const char* b31 = b21 + kstep;
            G_LDB(B0, 0, 0); G_SCHED; G_LDA(At, 0, 0); G_STAGE(G_SA(1, 1), a1 + hstepA, voffA);
            G_WAIT_L(8); G_BAR; G_WAIT_L(0); G_MMA(0, 0, At, B0); G_BAR; G_SCHED;
            G_LDB(B1, 0, 1); G_STAGE(G_SB(0, 0), b20, voffB);
            G_BAR; G_WAIT_L(0); G_MMA(0, 1, At, B1); G_BAR;
            G_LDA(At, 0, 1); G_STAGE(G_SA(0, 0), a2, voffA);
            G_BAR; G_WAIT_L(0); G_MMA(1, 0, At, B0); G_BAR; G_SCHED;
            G_STAGE(G_SB(0, 1), b21, voffB);
            G_WAIT_V(6); G_BAR; G_MMA(1, 1, At, B1); G_BAR;
            G_LDB(B0, 1, 0); G_SCHED; G_LDA(At, 1, 0); G_STAGE(G_SA(0, 1), a2 + hstepA, voffA);
            G_WAIT_L(8); G_BAR; G_WAIT_L(0); G_MMA(0, 0, At, B0); G_BAR; G_SCHED;
            G_LDB(B1, 1, 1); G_STAGE(G_SB(1, 0), b30, voffB);
            G_BAR; G_WAIT_L(0); G_MMA(0, 1, At, B1); G_BAR;
            G_LDA(At, 1, 1); G_STAGE(G_SA(1, 0), a3, voffA);
            G_BAR; G_WAIT_L(0); G_MMA(1, 0, At, B0); G_BAR; G_SCHED;
            G_STAGE(G_SB(1, 1), b31, voffB);
            G_WAIT_V(6); G_BAR; G_MMA(1, 1, At, B1); G_BAR;
        }
        E(acc, cur, wr, wc, fr, fq);
        if (!has_next) break;
#pragma unroll
        for (int a = 0; a < 2; ++a)
#pragma unroll
            for (int b = 0; b < 2; ++b)
#pragma unroll
                for (int m = 0; m < 4; ++m)
#pragma unroll
                    for (int n = 0; n < 2; ++n) acc[a][b][m][n] = (f32x4){0.f, 0.f, 0.f, 0.f};
        cur = nxt; cA = nA; cB0 = nB0; cB1 = nB1; ++ui;
    }
    G_WAIT_V(0);
    if (wr == 0) G_BAR;
    G_BAR;
#undef G_SA
#undef G_SB
#undef G_STAGE
#undef G_LDA
#undef G_LDB
#undef G_MMA
#undef G_WAIT_V
#undef G_WAIT_L
#undef G_BAR
#undef G_SCHED
}

constexpr size_t ROWB = (size_t)DM * 2;
struct SchedFfnUp {
    const char* A; const char* B; int G, c;
    DI bool next(int i, Unit& u) const { const int L = i * G + c; if (L >= 64 * 44) return false; int pm, pn; tile_decode(L, 64, 44, pm, pn);
        u.A = A + (size_t)pm * 256 * ROWB; u.B0 = B + (size_t)pn * 128 * ROWB; u.B1 = u.B0 + (size_t)DFF * ROWB; u.kind = 0; u.pm = pm; u.pn = pn; return true; }
};
struct SchedPlain {
    const char* A; const char* B; int nM, nN; size_t astep, bstep; int G, c;
    DI bool next(int i, Unit& u) const { const int L = i * G + c; if (L >= nM * nN) return false; int pm, pn; tile_decode(L, nM, nN, pm, pn);
        u.A = A + (size_t)pm * astep; u.B0 = B + (size_t)pn * bstep; u.B1 = u.B0 + (bstep >> 1); u.kind = 0; u.pm = pm; u.pn = pn; return true; }
};
struct SchedWin {
    const char* xb; const char* win; const char* wft; const char* memb; const char* wkv; int G, c;
    DI bool next(int i, Unit& u) const {
        int L = i * G + c; int pm, pn;
        if (L < 2176) { tile_decode(L, 64, 34, pm, pn); u.A = xb + (size_t)pm * 256 * ROWB; u.pm = pm;
            if (pn < 8) { u.kind = 0; u.pn = pn; u.B0 = win + (size_t)(pn * 128) * ROWB; u.B1 = win + (size_t)(1024 + pn * 128) * ROWB; }
            else if (pn < 10) { u.kind = 1; u.pn = pn - 8; u.B0 = win + (size_t)(2560 + 256 * (pn - 8)) * ROWB; u.B1 = u.B0 + 128 * ROWB; }
            else { u.kind = 2; u.pn = pn - 10; u.B0 = win + (size_t)(3072 + 256 * (pn - 10)) * ROWB; u.B1 = u.B0 + 128 * ROWB; }
            return true; }
        L -= 2176;
        if (L < 256) { tile_decode(L, 4, 64, pm, pn); u.kind = 3; u.pm = pm; u.pn = pn; u.A = wft + (size_t)pm * 256 * ROWB; u.B0 = xb + (size_t)pn * 256 * ROWB; u.B1 = u.B0 + 128 * ROWB; return true; }
        L -= 256;
        if (L < 4) { tile_decode(L, 2, 2, pm, pn); u.kind = 4; u.pm = pm; u.pn = pn; u.A = memb + (size_t)pm * 256 * ROWB; u.B0 = wkv + (size_t)pn * 256 * ROWB; u.B1 = u.B0 + 128 * ROWB; return true; }
        L -= 4;
        if (L < 4) { tile_decode(L, 2, 2, pm, pn); u.kind = 5; u.pm = pm; u.pn = pn; u.A = wkv + (size_t)(512 + pm * 256) * ROWB; u.B0 = memb + (size_t)pn * 256 * ROWB; u.B1 = u.B0 + 128 * ROWB; return true; }
        return false;
    }
};
struct SchedDft {
    const char* cm; const char* tt; int G, c;
    DI bool next(int i, Unit& u) const { const int L = i * G + c; if (L >= 256) return false; int pm, pn8; tile_decode(L, 32, 8, pm, pn8);
        const int b = pn8 >> 2, p = (pn8 >> 1) & 1, pn = pn8 & 1;
        u.A = cm + (size_t)p * CM_HALF + (size_t)pm * 256 * SEQ * 2; u.B0 = tt + ((size_t)(p * 512 + pn * 256) * NTOK + (size_t)b * SEQ) * 2; u.B1 = u.B0 + (size_t)128 * NTOK * 2;
        u.kind = 0; u.pm = b * 32 + pm; u.pn = p * 2 + pn; return true; }
};

template <int ACT>
DI void store_tile_bf16(const f32x4 (&acc)[2][2][4][2], bf16_t* out, size_t ld, int row0, int col0, const float* colbias, const float* rowbias, float scale) {
    f32x4 cb[2][2];
#pragma unroll
    for (int bj = 0; bj < 2; ++bj)
#pragma unroll
        for (int n = 0; n < 2; ++n) cb[bj][n] = colbias ? *(const f32x4*)(colbias + col0 + bj * HALF + 4 * n) : (f32x4){0.f, 0.f, 0.f, 0.f};
#pragma unroll
    for (int ai = 0; ai < 2; ++ai)
#pragma unroll
        for (int m = 0; m < 4; ++m) { const int row = row0 + ai * HALF + m * 16; const float rb = rowbias ? rowbias[row] : 0.f; bf16_t* rp = out + (size_t)row * ld + col0;
#pragma unroll
            for (int bj = 0; bj < 2; ++bj) { f32x4 v0 = (acc[ai][bj][m][0] + cb[bj][0] + rb) * scale, v1 = (acc[ai][bj][m][1] + cb[bj][1] + rb) * scale;
                if (ACT == 1) {
#pragma unroll
                    for (int j = 0; j < 4; ++j) { v0[j] = sigmoidf_fast(v0[j]); v1[j] = sigmoidf_fast(v1[j]); } }
                *(u32x4*)(rp + bj * HALF) = pack8(v0, v1); } }
}
struct EpiSwiGLU {
    static constexpr bool PERM = true; bf16_t* H;
    DI void operator()(const f32x4 (&acc)[2][2][4][2], const Unit& u, int wr, int wc, int fr, int fq) const {
        const int row0 = u.pm * 256 + wr * 64 + fr, col0 = u.pn * 128 + wc * 32 + 8 * fq;
#pragma unroll
        for (int ai = 0; ai < 2; ++ai)
#pragma unroll
            for (int m = 0; m < 4; ++m) { f32x4 v[2];
#pragma unroll
                for (int n = 0; n < 2; ++n) { const f32x4 a = acc[ai][0][m][n], g = acc[ai][1][m][n];
#pragma unroll
                    for (int j = 0; j < 4; ++j) v[n][j] = a[j] * g[j] * sigmoidf_fast(g[j]); }
                *(u32x4*)(H + (size_t)(row0 + ai * HALF + m * 16) * DFF + col0) = pack8(v[0], v[1]); }
    }
};
struct EpiResid {
    static constexpr bool PERM = false; const float* src; float* dst; float alpha, beta;
    DI void operator()(const f32x4 (&acc)[2][2][4][2], const Unit& u, int wr, int wc, int fr, int fq) const {
        const int row0 = u.pm * 256 + wr * 64 + fr, col0 = u.pn * 256 + wc * 32 + 4 * fq;
#pragma unroll
        for (int ai = 0; ai < 2; ++ai)
#pragma unroll
            for (int m = 0; m < 4; ++m) { const size_t off = (size_t)(row0 + ai * HALF + m * 16) * DM + col0;
#pragma unroll
                for (int bj = 0; bj < 2; ++bj)
#pragma unroll
                    for (int n = 0; n < 2; ++n) { const f32x4 s = *(const f32x4*)(src + off + bj * HALF + n * 16); *(f32x4*)(dst + off + bj * HALF + n * 16) = s * alpha + acc[ai][bj][m][n] * beta; }
                asm volatile("" ::: "memory"); }
    }
};
struct EpiWin {
    static constexpr bool PERM = true;
    const float* bin; const float* biasT; bf16_t *GLU, *Q, *Gt, *TT, *KK, *VT;
    DI void operator()(const f32x4 (&acc)[2][2][4][2], const Unit& u, int wr, int wc, int fr, int fq) const {
        const int row0 = u.pm * 256 + wr * 64 + fr, cin = wc * 32 + 8 * fq;
        if (u.kind == 0) {
            const int col0 = u.pn * 128 + cin; f32x4 bv[2], bg[2];
#pragma unroll
            for (int n = 0; n < 2; ++n) { bv[n] = *(const f32x4*)(bin + col0 + 4 * n); bg[n] = *(const f32x4*)(bin + 1024 + col0 + 4 * n); }
#pragma unroll
            for (int ai = 0; ai < 2; ++ai)
#pragma unroll
                for (int m = 0; m < 4; ++m) { f32x4 v[2];
#pragma unroll
                    for (int n = 0; n < 2; ++n) { const f32x4 a = acc[ai][0][m][n] + bv[n], g = acc[ai][1][m][n] + bg[n];
#pragma unroll
                        for (int j = 0; j < 4; ++j) v[n][j] = a[j] * sigmoidf_fast(g[j]); }
                    *(u32x4*)(GLU + (size_t)(row0 + ai * HALF + m * 16) * 1024 + col0) = pack8(v[0], v[1]); }
        } else if (u.kind == 1) store_tile_bf16<0>(acc, Q, 512, row0, u.pn * 256 + cin, bin + 2560, nullptr, 0.08838834764831845f);
        else if (u.kind == 2) store_tile_bf16<1>(acc, Gt, 6144, row0, u.pn * 256 + cin, bin + 3072, nullptr, 1.0f);
        else if (u.kind == 3) store_tile_bf16<0>(acc, TT, NTOK, row0, u.pn * 256 + cin, nullptr, biasT, 1.0f);
        else if (u.kind == 4) store_tile_bf16<0>(acc, KK, 512, row0, u.pn * 256 + cin, nullptr, nullptr, 1.0f);
        else store_tile_bf16<0>(acc, VT, 512, row0, u.pn * 256 + cin, nullptr, nullptr, 1.0f);
    }
};
struct EpiPlainBf16 {
    static constexpr bool PERM = true; bf16_t* out; int ld;
    DI void operator()(const f32x4 (&acc)[2][2][4][2], const Unit& u, int wr, int wc, int fr, int fq) const {
        store_tile_bf16<0>(acc, out, (size_t)ld, u.pm * 256 + wr * 64 + fr, u.pn * 256 + wc * 32 + 8 * fq, nullptr, nullptr, 1.0f);
    }
};
template <int STEP> struct EpiBranch {
    static constexpr bool PERM = true; const bf16_t* Gt; bf16_t* MG;
    DI void operator()(const f32x4 (&acc)[2][2][4][2], const Unit& u, int wr, int wc, int fr, int fq) const {
        const int row0 = u.pm * 256 + wr * 64 + fr, col0 = u.pn * 256 + wc * 32 + 8 * fq;
#pragma unroll
        for (int ai = 0; ai < 2; ++ai)
#pragma unroll
            for (int m = 0; m < 4; ++m) { const size_t row = (size_t)(row0 + ai * HALF + m * 16);
#pragma unroll
                for (int bj = 0; bj < 2; ++bj) { f32x4 g0, g1, p0 = {0.f, 0.f, 0.f, 0.f}, p1 = {0.f, 0.f, 0.f, 0.f};
                    unpack8(*(const u32x4*)(Gt + row * 6144 + STEP * DM + col0 + bj * HALF), g0, g1);
                    if (STEP > 0) unpack8(*(const u32x4*)(MG + row * DM + col0 + bj * HALF), p0, p1);
                    *(u32x4*)(MG + row * DM + col0 + bj * HALF) = pack8(p0 + g0 * acc[ai][bj][m][0], p1 + g1 * acc[ai][bj][m][1]); }
                asm volatile("" ::: "memory"); }
    }
};

DI void transpose_item(const float* W, int N, bf16_t* WT, int ldo, int row_off, int koff, LAS float* scr, int item, int lane) {
    const int nblk = N / 32, kb = item / nblk, nb = item % nblk, k0 = 64 * kb, n0 = 32 * nb;
#pragma unroll 8
    for (int i = 0; i < 32; ++i) { const int kk = 2 * i + (lane >> 5); scr[kk * 33 + (lane & 31)] = W[(size_t)(k0 + kk) * N + n0 + (lane & 31)]; }
    asm volatile("s_waitcnt lgkmcnt(0)" ::: "memory");
    const int c = lane & 7;
#pragma unroll
    for (int j = 0; j < 4; ++j) { const int n = (lane >> 3) + 8 * j; const LAS float* s = scr + (8 * c) * 33 + n;
        u32x4 o; o.x = pk2(s[0 * 33], s[1 * 33]); o.y = pk2(s[2 * 33], s[3 * 33]); o.z = pk2(s[4 * 33], s[5 * 33]); o.w = pk2(s[6 * 33], s[7 * 33]);
        *(u32x4*)(WT + (size_t)(row_off + n0 + n) * ldo + koff + k0 + 8 * c) = o; }
    asm volatile("s_waitcnt lgkmcnt(0)" ::: "memory");
}

struct Params { const float* in[23]; float* out; unsigned char* ws; int ph_lo, ph_hi; };

DI void convert_weights(const Params& P, int l, LAS unsigned char* lds) {
    const int tid = ltid(), lane = tid & 63, wid = tid >> 6;
    unsigned char* ws = P.ws;
    LAS float* scr = (LAS float*)(lds + wid * 8448);
    const int gw = blockIdx.x * 8 + wid, NGW = gridDim.x * 8;
    constexpr int I13 = 32 * 352, I2 = 88 * 64, IIN = 32 * 288, ICO = 16 * 64, IF = 8 * 64, IKV = 32 * 32, IO = 8 * 64, IOUT = 32 * 64;
    constexpr int NITEMS = 2 * I13 + 2 * I2 + IIN + ICO + 2 * IF + IKV + IO + IOUT;
    const float* w13a = P.in[2] + (size_t)l * DM * 2 * DFF; const float* w2a = P.in[3] + (size_t)l * DFF * DM;
    const float* win = P.in[6] + (size_t)l * DM * DIN; const float* wco = P.in[12] + (size_t)l * 1024 * DM; const float* wf = P.in[13] + (size_t)l * 512 * DM;
    const float* wkv = P.in[14] + (size_t)l * DM * 1024; const float* wo = P.in[15] + (size_t)l * 512 * DM; const float* wout = P.in[16] + (size_t)l * DM * DM;
    const float* w13b = P.in[19] + (size_t)l * DM * 2 * DFF; const float* w2b = P.in[20] + (size_t)l * DFF * DM;
    for (int it = gw; it < NITEMS; it += NGW) {
        int r = it;
        if (r < I13) { transpose_item(w13a, 2 * DFF, (bf16_t*)(ws + WS_W13A), DM, 0, 0, scr, r, lane); continue; } r -= I13;
        if (r < I13) { transpose_item(w13b, 2 * DFF, (bf16_t*)(ws + WS_W13B), DM, 0, 0, scr, r, lane); continue; } r -= I13;
        if (r < I2) { transpose_item(w2a, DM, (bf16_t*)(ws + WS_W2A), DFF, 0, 0, scr, r, lane); continue; } r -= I2;
        if (r < I2) { transpose_item(w2b, DM, (bf16_t*)(ws + WS_W2B), DFF, 0, 0, scr, r, lane); continue; } r -= I2;
        if (r < IIN) { transpose_item(win, DIN, (bf16_t*)(ws + WS_WIN), DM, 0, 0, scr, r, lane); continue; } r -= IIN;
        if (r < ICO) { transpose_item(wco, DM, (bf16_t*)(ws + WS_WCO), 1024, 0, 0, scr, r, lane); continue; } r -= ICO;
        if (r < IF) { transpose_item(wf, DM, (bf16_t*)(ws + WS_WF2), 1024, 0, 0, scr, r, lane); continue; } r -= IF;
        if (r < IF) { transpose_item(wf, DM, (bf16_t*)(ws + WS_WF2), 1024, 0, 512, scr, r, lane); continue; } r -= IF;
        if (r < IKV) { transpose_item(wkv, 1024, (bf16_t*)(ws + WS_WKV), DM, 0, 0, scr, r, lane); continue; } r -= IKV;
        if (r < IO) { transpose_item(wo, DM, (bf16_t*)(ws + WS_WO), 512, 0, 0, scr, r, lane); continue; } r -= IO;
        transpose_item(wout, DM, (bf16_t*)(ws + WS_WOUT), DM, 0, 0, scr, r, lane);
    }
    __syncthreads();
    {
        LAS float* tile = (LAS float*)lds;
        LAS float* tabc = tile + 32 * 129; LAS float* tabs = tabc + 128;
        const float* bin = P.in[7] + (size_t)l * DIN;
        bf16_t* WFT = (bf16_t*)(ws + WS_WFT); float* biasT = (float*)(ws + WS_BIAST);
        if (tid < 128) { float sn, cs; sincospif((float)tid * (1.0f / 64.0f), &sn, &cs); tabc[tid] = cs * 0.08838834764831845f; tabs[tid] = sn * 0.08838834764831845f; }
        for (int item = blockIdx.x; item < 256; item += gridDim.x) {
            const int kb = item >> 2, g = item & 3;
            __syncthreads();
            for (int idx = tid; idx < 32 * 128; idx += 512) { const int kk = idx >> 7, j = idx & 127; tile[kk * 129 + j] = win[(size_t)(kb * 32 + kk) * DIN + 2048 + g * 128 + j]; }
            __syncthreads();
            const int k = tid & 31, ccb = (tid >> 5) * 8;
            float ac[8], as[8];
#pragma unroll
            for (int c8 = 0; c8 < 8; ++c8) { ac[c8] = 0.f; as[c8] = 0.f; }
            for (int j = 0; j < 128; ++j) { const float w = tile[k * 129 + j];
#pragma unroll
                for (int c8 = 0; c8 < 8; ++c8) { const int idx = (j * (ccb + c8)) & 127; ac[c8] += w * tabc[idx]; as[c8] += w * tabs[idx]; } }
#pragma unroll
            for (int c8 = 0; c8 < 8; ++c8) { WFT[(size_t)(g * 128 + ccb + c8) * DM + kb * 32 + k] = f2bf(ac[c8]); WFT[(size_t)(512 + g * 128 + ccb + c8) * DM + kb * 32 + k] = f2bf(as[c8]); }
            if (kb == 0 && tid < 128) { float bc = 0.f, bs = 0.f;
                for (int j = 0; j < 128; ++j) { const float w = bin[2048 + g * 128 + j]; const int idx = (j * tid) & 127; bc += w * tabc[idx]; bs += w * tabs[idx]; }
                biasT[g * 128 + tid] = bc; biasT[512 + g * 128 + tid] = bs; }
        }
        __syncthreads();
    }
}

DI void setup_phase(const Params& P, LAS unsigned char* lds) {
    const int tid = ltid(); unsigned char* ws = P.ws;
    const size_t gt = (size_t)blockIdx.x * 512 + tid, ngt = (size_t)gridDim.x * 512;
    { const f32x4* src = (const f32x4*)P.in[0]; u32x4* dst = (u32x4*)(ws + WS_XB);
      for (size_t i = gt; i < (size_t)NTOK * DM / 8; i += ngt) dst[i] = pack8(src[2 * i], src[2 * i + 1]); }
    { const f32x4* src = (const f32x4*)P.in[1]; u32x4* dst = (u32x4*)(ws + WS_MEMB);
      for (size_t i = gt; i < (size_t)512 * DM / 8; i += ngt) dst[i] = pack8(src[2 * i], src[2 * i + 1]); }
    LAS bf16_t* tab = (LAS bf16_t*)lds;
    __syncthreads();
    for (int m = tid; m < SEQ; m += 512) tab[m] = f2bf(cospif((float)m * (1.0f / 4096.0f)) * 0.011048543456039806f);
    __syncthreads();
    bf16_t* cm0 = (bf16_t*)(ws + WS_CM); bf16_t* cm1 = (bf16_t*)(ws + WS_CM + CM_HALF);
    for (int j = blockIdx.x; j < SEQ; j += gridDim.x) {
        for (int ch = tid; ch < SEQ / 8; ch += 512) {
            unsigned c[8], s[8];
#pragma unroll
            for (int e = 0; e < 8; ++e) { const int idx = (j * (ch * 8 + e)) & (SEQ - 1); c[e] = tab[idx]; s[e] = tab[(idx + 2048) & (SEQ - 1)]; }
            u32x4 vc, vs; vc.x = c[0] | (c[1] << 16); vc.y = c[2] | (c[3] << 16); vc.z = c[4] | (c[5] << 16); vc.w = c[6] | (c[7] << 16);
            vs.x = s[0] | (s[1] << 16); vs.y = s[2] | (s[3] << 16); vs.z = s[4] | (s[5] << 16); vs.w = s[6] | (s[7] << 16);
            *(u32x4*)(cm0 + (size_t)j * SEQ + ch * 8) = vc; *(u32x4*)(cm1 + (size_t)j * SEQ + ch * 8) = vs;
        }
    }
    __syncthreads();
}

DI void ln_phase(float* X, bf16_t* XB, const float* g, const float* bta, bool write_bf16) {
    const int tid = ltid(), lane = tid & 63, gw = blockIdx.x * 8 + (tid >> 6), ngw = gridDim.x * 8;
    f32x4 gv[8], bv[8];
#pragma unroll
    for (int j = 0; j < 8; ++j) { gv[j] = ((const f32x4*)g)[64 * j + lane]; bv[j] = ((const f32x4*)bta)[64 * j + lane]; }
    for (int row = gw; row < NTOK; row += ngw) {
        f32x4* xr = (f32x4*)(X + (size_t)row * DM) + lane; f32x4 v[8]; float s = 0.f;
#pragma unroll
        for (int j = 0; j < 8; ++j) { v[j] = xr[64 * j]; s += (v[j][0] + v[j][1]) + (v[j][2] + v[j][3]); }
        const float mean = wave_sum(s) * (1.0f / DM); float s2 = 0.f;
#pragma unroll
        for (int j = 0; j < 8; ++j) { v[j] = v[j] - mean; s2 += (v[j][0] * v[j][0] + v[j][1] * v[j][1]) + (v[j][2] * v[j][2] + v[j][3] * v[j][3]); }
        const float rstd = 1.0f / sqrtf(wave_sum(s2) * (1.0f / DM) + LN_EPS);
        u32x2* ob = (u32x2*)(XB + (size_t)row * DM) + lane;
#pragma unroll
        for (int j = 0; j < 8; ++j) { const f32x4 y = v[j] * rstd * gv[j] + bv[j]; xr[64 * j] = y;
            if (write_bf16) { u32x2 w; w.x = pk2(y[0], y[1]); w.y = pk2(y[2], y[3]); ob[64 * j] = w; } }
    }
}

constexpr int CT = 16, CROWS = CT + 30;
DI void conv_tile(const bf16_t* GLU, bf16_t* CV, const float* cw, const float* cb, const float* lg, const float* lb, int tile, LAS unsigned char* lds) {
    const int tid = ltid(), lane = tid & 63, wid = __builtin_amdgcn_readfirstlane(tid >> 6);
    const int tok0 = tile * CT, b = tok0 >> 13, s0 = tok0 & (SEQ - 1);
    LAS float* part = (LAS float*)(lds + 131072); LAS float* tot = part + 512;
    LAS float* partw = part + wid; LAS unsigned char* ldst = lds + tid * 4;
    asm volatile("" : "+s"(GLU), "+s"(CV), "+s"(cw), "+s"(cb), "+s"(lg), "+s"(lb));
    asm volatile("" : "+v"(partw), "+v"(tot), "+v"(ldst));
    __syncthreads();
    for (int idx = tid; idx < CROWS * 128; idx += 512) { const int rr = idx >> 7, c16 = idx & 127, s = s0 - 15 + rr; u32x4 v = {0u, 0u, 0u, 0u};
        if (s >= 0 && s < SEQ) v = *(const u32x4*)(GLU + ((size_t)(b * SEQ + s)) * 1024 + c16 * 8);
        *(LAS u32x4*)(lds + rr * 2048 + c16 * 16) = v; }
    __syncthreads();
    float w0[31], w1[31];
#pragma unroll
    for (int j = 0; j < 31; ++j) { const f32x2 w = *(const f32x2*)(cw + j * 1024 + 2 * tid); w0[j] = w[0]; w1[j] = w[1]; }
    float a0[CT], a1[CT];
#pragma unroll
    for (int t = 0; t < CT; ++t) { a0[t] = 0.f; a1[t] = 0.f; }
    unsigned vnext = *(const LAS unsigned*)ldst;
#pragma unroll
    for (int rr = 0; rr < CROWS; ++rr) { const unsigned v = vnext; if (rr + 1 < CROWS) vnext = *(const LAS unsigned*)(ldst + (rr + 1) * 2048);
        asm volatile("" ::: "memory");
        const float x0 = __uint_as_float(v << 16), x1 = __uint_as_float(v & 0xffff0000u);
#pragma unroll
        for (int t = 0; t < CT; ++t) { const int j = rr - t; if (j >= 0 && j <= 30) { a0[t] += x0 * w0[j]; a1[t] += x1 * w1[j]; } } }
    const f32x2 cbv = *(const f32x2*)(cb + 2 * tid);
#pragma unroll
    for (int t = 0; t < CT; ++t) { a0[t] += cbv[0]; a1[t] += cbv[1];
        const float s1 = wave_sum(a0[t] + a1[t]), s2 = wave_sum(a0[t] * a0[t] + a1[t] * a1[t]);
        if (lane == 0) { partw[(2 * t) * 8] = s1; partw[(2 * t + 1) * 8] = s2; } }
    __syncthreads();
    if (tid < 2 * CT) { float s = 0.f;
#pragma unroll
        for (int w = 0; w < 8; ++w) s += part[tid * 8 + w];
        tot[tid] = s; }
    __syncthreads();
    const f32x2 gv = *(const f32x2*)(lg + 2 * tid), bv = *(const f32x2*)(lb + 2 * tid);
#pragma unroll
    for (int t = 0; t < CT; ++t) { const float mean = tot[2 * t] * (1.0f / 1024.0f), var = tot[2 * t + 1] * (1.0f / 1024.0f) - mean * mean, rstd = 1.0f / sqrtf(var + LN_EPS);
        float y0 = (a0[t] - mean) * rstd * gv[0] + bv[0], y1 = (a1[t] - mean) * rstd * gv[1] + bv[1];
        y0 *= sigmoidf_fast(y0); y1 *= sigmoidf_fast(y1);
        *(unsigned*)(CV + (size_t)(tok0 + t) * 1024 + 2 * tid) = pk2(y0, y1); }
}

DI void attn_unit(const bf16_t* Q, const bf16_t* KK, const bf16_t* VT, bf16_t* OO, int b, int h, int qt) {
    const int tid = ltid(), lane = tid & 63, wid = __builtin_amdgcn_readfirstlane(tid >> 6), r = lane & 31, h2 = lane >> 5;
    const int tok0 = b * SEQ + qt * 256 + wid * 32;
    asm volatile("" : "+s"(Q), "+s"(KK), "+s"(VT), "+s"(OO));
    bf16x8 qf[8];
    { const bf16_t* qp = Q + (size_t)(tok0 + r) * 512 + h * 128 + 8 * h2;
#pragma unroll
      for (int s = 0; s < 8; ++s) qf[s] = *(const bf16x8*)(qp + 16 * s); }
    f32x16 sacc[8];
#pragma unroll
    for (int kb = 0; kb < 8; ++kb) {
#pragma unroll
        for (int i = 0; i < 16; ++i) sacc[kb][i] = 0.f;
        const bf16_t* kp = KK + (size_t)(b * 256 + kb * 32 + r) * 512 + h * 128 + 8 * h2;
#pragma unroll
        for (int s = 0; s < 8; ++s) { const bf16x8 kf = *(const bf16x8*)(kp + 16 * s); sacc[kb] = __builtin_amdgcn_mfma_f32_32x32x16_bf16(kf, qf[s], sacc[kb], 0, 0, 0); }
    }
    float mx = -3.0e38f;
#pragma unroll
    for (int kb = 0; kb < 8; ++kb)
#pragma unroll
        for (int i = 0; i < 16; ++i) mx = fmaxf(mx, sacc[kb][i]);
    mx = fmaxf(mx, __shfl_xor(mx, 32));
    float sum = 0.f;
#pragma unroll
    for (int kb = 0; kb < 8; ++kb)
#pragma unroll
        for (int i = 0; i < 16; ++i) { const float p = __expf(sacc[kb][i] - mx); sacc[kb][i] = p; sum += p; }
    sum += __shfl_xor(sum, 32);
    const float inv = 1.0f / sum;
    f32x16 oacc[4];
#pragma unroll
    for (int db = 0; db < 4; ++db)
#pragma unroll
        for (int i = 0; i < 16; ++i) oacc[db][i] = 0.f;
#pragma unroll
    for (int kb = 0; kb < 8; ++kb)
#pragma unroll
        for (int s2 = 0; s2 < 2; ++s2) {
            u32x4 pw; pw.x = pk2(sacc[kb][8 * s2 + 0], sacc[kb][8 * s2 + 1]); pw.y = pk2(sacc[kb][8 * s2 + 2], sacc[kb][8 * s2 + 3]);
            pw.z = pk2(sacc[kb][8 * s2 + 4], sacc[kb][8 * s2 + 5]); pw.w = pk2(sacc[kb][8 * s2 + 6], sacc[kb][8 * s2 + 7]);
            const bf16x8 pf = __builtin_bit_cast(bf16x8, pw);
#pragma unroll
            for (int db = 0; db < 4; ++db) {
                const bf16_t* vp = VT + (size_t)(h * 128 + db * 32 + r) * 512 + b * 256 + kb * 32 + 16 * s2 + 4 * h2;
                const u32x2 lo = *(const u32x2*)vp, hi = *(const u32x2*)(vp + 8);
                u32x4 vw; vw.x = lo.x; vw.y = lo.y; vw.z = hi.x; vw.w = hi.y;
                oacc[db] = __builtin_amdgcn_mfma_f32_32x32x16_bf16(__builtin_bit_cast(bf16x8, vw), pf, oacc[db], 0, 0, 0);
            }
        }
    bf16_t* op = OO + (size_t)(tok0 + r) * 512 + h * 128 + 4 * h2;
#pragma unroll
    for (int db = 0; db < 4; ++db)
#pragma unroll
        for (int g = 0; g < 4; ++g) { u32x2 w; w.x = pk2(oacc[db][4 * g] * inv, oacc[db][4 * g + 1] * inv); w.y = pk2(oacc[db][4 * g + 2] * inv, oacc[db][4 * g + 3] * inv);
            *(u32x2*)(op + db * 32 + 8 * g) = w; }
}

constexpr int NPHASE = 1 + 11 * NLAYER;

__global__ void __launch_bounds__(512, 2) fwd_mega(Params P) {
    extern __shared__ __attribute__((aligned(16))) unsigned char lds_raw[];
    LAS unsigned char* lds = (LAS unsigned char*)lds_raw;
    const int G = gridDim.x, c = blockIdx.x;
    for (int ph = P.ph_lo; ph < P.ph_hi; ++ph) {
        unsigned char* ws = P.ws;
        asm volatile("" : "+s"(ws));
        const char* xb = (const char*)(ws + WS_XB);
        if (ph == 0) {
            if (PHON(0)) setup_phase(P, lds);
            if (PHON(1)) convert_weights(P, 0, lds);
        } else {
            const int l = (ph - 1) / 11, sp = (ph - 1) % 11;
            if (PHON(2) && (sp == 0 || sp == 8)) {
                SchedFfnUp S{xb, (const char*)(ws + (sp == 0 ? WS_W13A : WS_W13B)), G, c};
                EpiSwiGLU E{(bf16_t*)(ws + WS_H)};
                gemm_phase(lds, DM, DM, DM, S, E);
            } else if (PHON(3) && (sp == 1 || sp == 9)) {
                SchedPlain S{(const char*)(ws + WS_H), (const char*)(ws + (sp == 1 ? WS_W2A : WS_W2B)), 64, 8, (size_t)256 * DFF * 2, (size_t)256 * DFF * 2, G, c};
                EpiResid E{(l == 0 && sp == 1) ? P.in[0] : P.out, P.out, DN_ALPHA, 0.5f};
                gemm_phase(lds, DFF, DFF, DFF, S, E);
            } else if (PHON(4) && (sp == 2 || sp == 7 || sp == 10)) {
                const int gi = sp == 2 ? 4 : (sp == 7 ? 17 : 21);
                ln_phase(P.out, (bf16_t*)(ws + WS_XB), P.in[gi] + (size_t)l * DM, P.in[gi + 1] + (size_t)l * DM, !(sp == 10 && l == NLAYER - 1));
                if (PHON(1) && sp == 10 && l + 1 < NLAYER) convert_weights(P, l + 1, lds);
            } else if (PHON(5) && sp == 3) {
                SchedWin S{xb, (const char*)(ws + WS_WIN), (const char*)(ws + WS_WFT), (const char*)(ws + WS_MEMB), (const char*)(ws + WS_WKV), G, c};
                EpiWin E{P.in[7] + (size_t)l * DIN, (const float*)(ws + WS_BIAST), (bf16_t*)(ws + WS_GLU), (bf16_t*)(ws + WS_Q), (bf16_t*)(ws + WS_G), (bf16_t*)(ws + WS_TT), (bf16_t*)(ws + WS_KK), (bf16_t*)(ws + WS_VT)};
                gemm_phase(lds, DM, DM, DM, S, E);
            } else if (sp == 4) {
                if (PHON(6)) { SchedDft S{(const char*)(ws + WS_CM), (const char*)(ws + WS_TT), G, c};
                  EpiPlainBf16 E{(bf16_t*)(ws + WS_PP), 1024};
                  gemm_phase(lds, SEQ, SEQ, NTOK, S, E); }
                if (PHON(7)) for (int t = c; t < NTOK / CT; t += G)
                    conv_tile((const bf16_t*)(ws + WS_GLU), (bf16_t*)(ws + WS_CV), P.in[8] + (size_t)l * 31 * 1024, P.in[9] + (size_t)l * 1024, P.in[10] + (size_t)l * 1024, P.in[11] + (size_t)l * 1024, t, lds);
                if (PHON(8)) for (int t = c; t < 256; t += G)
                    attn_unit((const bf16_t*)(ws + WS_Q), (const bf16_t*)(ws + WS_KK), (const bf16_t*)(ws + WS_VT), (bf16_t*)(ws + WS_OO), t >> 7, (t >> 5) & 3, t & 31);
                __syncthreads();
            } else if (PHON(9) && sp == 5) {
                { SchedPlain S{(const char*)(ws + WS_CV), (const char*)(ws + WS_WCO), 64, 8, (size_t)256 * 1024 * 2, (size_t)256 * 1024 * 2, G, c};
                  EpiBranch<0> E{(const bf16_t*)(ws + WS_G), (bf16_t*)(ws + WS_MG)}; gemm_phase(lds, 1024, 1024, 1024, S, E); }
                { SchedPlain S{(const char*)(ws + WS_PP), (const char*)(ws + WS_WF2), 64, 8, (size_t)256 * 1024 * 2, (size_t)256 * 1024 * 2, G, c};
                  EpiBranch<1> E{(const bf16_t*)(ws + WS_G), (bf16_t*)(ws + WS_MG)}; gemm_phase(lds, 1024, 1024, 1024, S, E); }
                { SchedPlain S{(const char*)(ws + WS_OO), (const char*)(ws + WS_WO), 64, 8, (size_t)256 * 512 * 2, (size_t)256 * 512 * 2, G, c};
                  EpiBranch<2> E{(const bf16_t*)(ws + WS_G), (bf16_t*)(ws + WS_MG)}; gemm_phase(lds, 512, 512, 512, S, E); }
            } else if (PHON(10) && sp == 6) {
                SchedPlain S{(const char*)(ws + WS_MG), (const char*)(ws + WS_WOUT), 64, 8, (size_t)256 * DM * 2, (size_t)256 * DM * 2, G, c};
                EpiResid E{P.out, P.out, DN_ALPHA, 1.0f};
                gemm_phase(lds, DM, DM, DM, S, E);
            }
        }
        if (ph + 1 < P.ph_hi) cg::this_grid().sync();
    }
}

extern "C" void kernel_launch(void* const* d_in, const int* in_sizes, int n_in, void* d_out, int out_size, void* d_ws, size_t ws_size, hipStream_t stream) {
    static int grid = 0;
    if (grid == 0) {
        if (n_in != 23 || out_size != NTOK * DM || ws_size < WS_END) { fprintf(stderr, "kernel_launch: unexpected shapes (n_in %d, out %d, ws %zu < %zu)\n", n_in, out_size, ws_size, (size_t)WS_END); grid = -1; return; }
        int dev = 0, cus = 0, per_cu = 0;
        hipGetDevice(&dev);
        hipDeviceGetAttribute(&cus, hipDeviceAttributeMultiprocessorCount, dev);
        hipFuncSetAttribute((const void*)fwd_mega, hipFuncAttributeMaxDynamicSharedMemorySize, LDS_BYTES);
        hipOccupancyMaxActiveBlocksPerMultiprocessor(&per_cu, (const void*)fwd_mega, 512, LDS_BYTES);
        if (per_cu < 1) { fprintf(stderr, "kernel_launch: occupancy query says %d blocks per CU\n", per_cu); per_cu = 1; }
        (void)hipGetLastError();
        grid = cus;
    }
    if (grid < 0) return;
    Params p{};
    for (int i = 0; i < 23; ++i) p.in[i] = (const float*)d_in[i];
    p.out = (float*)d_out; p.ws = (unsigned char*)d_ws;
#if ONE_LAUNCH
    p.ph_lo = 0; p.ph_hi = NPHASE;
    void* args[] = {&p};
    hipError_t e = hipLaunchCooperativeKernel((const void*)fwd_mega, dim3(grid), dim3(512), args, LDS_BYTES, stream);
    if (e != hipSuccess) fprintf(stderr, "cooperative launch failed: %s (grid %d)\n", hipGetErrorString(e), grid);
#else
    for (int ph = 0; ph < NPHASE; ++ph) { p.ph_lo = ph; p.ph_hi = ph + 1; hipLaunchKernelGGL(fwd_mega, dim3(grid), dim3(512), LDS_BYTES, stream, p); }
#endif
}
```

```cpp
#include <hip/hip_runtime.h>
#include <hip/hip_cooperative_groups.h>
#include <cstdio>
namespace cg = cooperative_groups;

#ifndef PH_MASK
#define PH_MASK 0xFFFF
#endif
#define PHON(k) ((PH_MASK >> (k)) & 1)
#ifndef ONE_LAUNCH
#define ONE_LAUNCH 1
#endif

#define LAS __attribute__((address_space(3)))
#define DI __device__ __forceinline__
typedef unsigned short bf16_t;
typedef short bf16x8 __attribute__((ext_vector_type(8)));
typedef float f32x4 __attribute__((ext_vector_type(4)));
typedef float f32x2 __attribute__((ext_vector_type(2)));
typedef float f32x16 __attribute__((ext_vector_type(16)));
typedef unsigned u32x4 __attribute__((ext_vector_type(4)));
typedef unsigned u32x2 __attribute__((ext_vector_type(2)));
typedef __bf16 bf16x2_t __attribute__((ext_vector_type(2)));

constexpr int NTOK = 16384, DM = 2048, DFF = 5632, DIN = 9216, SEQ = 8192, NLAYER = 2;
constexpr float DN_ALPHA = 1.4142135623730951f;
constexpr float LN_EPS = 1e-5f;

constexpr int HSEQ = SEQ / 2;
constexpr size_t WS_CM    = 0;
constexpr size_t CM_HALF  = (size_t)HSEQ * HSEQ * 2;
constexpr size_t WS_XB    = WS_CM + 2 * CM_HALF;
constexpr size_t WS_MEMB  = WS_XB + (size_t)NTOK * DM * 2;
constexpr size_t WS_XP    = WS_MEMB + (size_t)512 * DM * 2;
constexpr size_t WS_XM    = WS_XP + (size_t)2 * HSEQ * DM * 2;
constexpr size_t WS_W13A  = WS_XM + (size_t)2 * HSEQ * DM * 2;
constexpr size_t WS_W2A   = WS_W13A + (size_t)2 * DFF * DM * 2;
constexpr size_t WS_W13B  = WS_W2A + (size_t)DM * DFF * 2;
constexpr size_t WS_W2B   = WS_W13B + (size_t)2 * DFF * DM * 2;
constexpr size_t WS_WIN   = WS_W2B + (size_t)DM * DFF * 2;
constexpr size_t WS_WFT   = WS_WIN + (size_t)DIN * DM * 2;
constexpr int KBR = 2560;
constexpr size_t WS_WBR   = WS_WFT + (size_t)1024 * DM * 2;
constexpr size_t WS_WKV   = WS_WBR + (size_t)DM * KBR * 2;
constexpr size_t WS_WOUT  = WS_WKV + (size_t)1024 * DM * 2;
constexpr size_t WS_BIAST = WS_WOUT + (size_t)DM * DM * 2;
constexpr size_t WS_STATS = WS_BIAST + 4096;
constexpr size_t WS_BAR   = WS_STATS + (size_t)NTOK * 8;
constexpr size_t WS_UH    = WS_BAR + 16384;
constexpr size_t WS_KK    = WS_UH + 4096;
constexpr size_t WS_VT    = WS_KK + (size_t)512 * 512 * 2;
constexpr size_t WS_MIX   = WS_VT + (size_t)512 * 512 * 2;
constexpr size_t WS_G     = WS_MIX;
constexpr size_t WS_GLU   = WS_G + (size_t)NTOK * 6144 * 2;
constexpr size_t WS_TT    = WS_GLU + (size_t)NTOK * 1024 * 2;
constexpr size_t WS_MG    = WS_GLU;
constexpr size_t WS_Q     = WS_TT + (size_t)1024 * NTOK * 2;
constexpr size_t WS_BR    = WS_Q + (size_t)NTOK * 512 * 2;
constexpr size_t WS_END   = WS_BR + (size_t)NTOK * KBR * 2;
constexpr size_t WS_H     = WS_MIX;
static_assert((size_t)NTOK * DFF * 2 <= WS_END - WS_MIX, "H must fit the union region");

constexpr int LDS_BYTES = 131072 + 4096;

DI int ltid() { int t = threadIdx.x; asm volatile("" : "+v"(t)); return t; }
DI unsigned pk2(float a, float b) { f32x2 v = {a, b}; bf16x2_t r = __builtin_convertvector(v, bf16x2_t); return __builtin_bit_cast(unsigned, r); }
DI bf16_t f2bf(float a) { return (bf16_t)(pk2(a, 0.f) & 0xffffu); }
DI float sigmoidf_fast(float x) { return __builtin_amdgcn_rcpf(1.0f + __expf(-x)); }
DI float wave_sum(float v) {
#pragma unroll
    for (int o = 1; o < 64; o <<= 1) v += __shfl_xor(v, o);
    return v;
}
DI u32x4 pack8(const f32x4 v0, const f32x4 v1) { u32x4 w; w.x = pk2(v0[0], v0[1]); w.y = pk2(v0[2], v0[3]); w.z = pk2(v1[0], v1[1]); w.w = pk2(v1[2], v1[3]); return w; }
DI void unpack8(const u32x4 w, f32x4& v0, f32x4& v1) {
    v0[0] = __uint_as_float(w.x << 16); v0[1] = __uint_as_float(w.x & 0xffff0000u); v0[2] = __uint_as_float(w.y << 16); v0[3] = __uint_as_float(w.y & 0xffff0000u);
    v1[0] = __uint_as_float(w.z << 16); v1[1] = __uint_as_float(w.z & 0xffff0000u); v1[2] = __uint_as_float(w.w << 16); v1[3] = __uint_as_float(w.w & 0xffff0000u);
}

constexpr int BK = 64, HALF = 128, HTB = HALF * BK * 2;
DI int lds_byte(int r, int c) { const int st = (r >> 4) * 2 + (c >> 5), rr = r & 15, cc = c & 31, ob = rr * 64 + cc * 2; return st * 1024 + (ob ^ (((ob >> 9) & 1) << 5)); }
DI void stage_rc(int b, int& R, int& C) { const int st = b / 1024, sb = b % 1024, swz = sb ^ (((sb >> 9) & 1) << 5); R = (st >> 1) * 16 + swz / 64; C = (st & 1) * 32 + (swz % 64) / 2; }
DI int perm32(int rho) { const int n = rho >> 4, i = rho & 15; return 8 * (i >> 2) + 4 * n + (i & 3); }

struct Unit { const char* A; const char* B0; const char* B1; int kind, pm, pn; };

DI void tile_decode(int wgid, int nM, int nN, int& pm, int& pn) {
    const int nwg = nM * nN;
    { const int q = nwg / 8, r = nwg % 8, xcd = wgid % 8, off = wgid / 8; wgid = (xcd < r ? xcd * (q + 1) : r * (q + 1) + (xcd - r) * q) + off; }
    const int nig = 8 * nN, gid = wgid / nig, fm = gid * 8, gsz = (nM - fm) < 8 ? (nM - fm) : 8;
    pm = fm + ((wgid % nig) % gsz); pn = (wgid % nig) / gsz;
}

template <class Epi, class Sched>
DI void gemm_phase(LAS unsigned char* lds, const int K, const int lda, const int ldb, const Sched& S, const Epi& E) {
    const int tid = ltid(), wid = __builtin_amdgcn_readfirstlane(tid >> 6), lane = tid & 63, wr = wid >> 2, wc = wid & 3, fr = lane & 15, fq = lane >> 4;
    const int nt = K / BK;
    unsigned voffA[2], voffB[2];
#pragma unroll
    for (int i = 0; i < 2; ++i) { int R, C; stage_rc(tid * 16 + i * 8192, R, C); const int Rb = Epi::PERM ? ((R & ~31) + perm32(R & 31)) : R;
        voffA[i] = (unsigned)(R * lda + C) * 2u; voffB[i] = (unsigned)(Rb * ldb + C) * 2u; }
    const size_t kstep = (size_t)(BK * 2);
    const size_t hstepA = (size_t)HALF * lda * 2;
    const unsigned ldsw = (unsigned)wid * 1024u;
    const int aoff = lds_byte(wr * 64 + fr, fq * 8), boff = lds_byte(wc * 32 + fr, fq * 8);
#define G_SA(b, h) (((b) * 2 + (h)) * HTB)
#define G_SB(b, h) ((4 + (b) * 2 + (h)) * HTB)
#define G_STAGE(bufoff, gbase, voff) do { _Pragma("unroll") for (int _i = 0; _i < 2; ++_i) \
        __builtin_amdgcn_global_load_lds((const unsigned*)((const char*)(gbase) + (voff)[_i]), (LAS unsigned*)(lds + (bufoff) + ldsw + _i * 8192), 16, 0, 0); } while (0)
#define G_LDA(dst, b, h) do { _Pragma("unroll") for (int m = 0; m < 4; ++m) _Pragma("unroll") for (int k = 0; k < 2; ++k) dst[m][k] = *(const LAS bf16x8*)(lds + G_SA(b, h) + aoff + m * 2048 + k * 1024); } while (0)
#define G_LDB(dst, b, h) do { _Pragma("unroll") for (int n = 0; n < 2; ++n) _Pragma("unroll") for (int k = 0; k < 2; ++k) dst[n][k] = *(const LAS bf16x8*)(lds + G_SB(b, h) + boff + n * 2048 + k * 1024); } while (0)
#define G_MMA(ai, bj, At, Bt) do { __builtin_amdgcn_s_setprio(1); _Pragma("unroll") for (int m = 0; m < 4; ++m) _Pragma("unroll") for (int n = 0; n < 2; ++n) _Pragma("unroll") for (int k = 0; k < 2; ++k) \
        acc[ai][bj][m][n] = __builtin_amdgcn_mfma_f32_16x16x32_bf16(Bt[n][k], At[m][k], acc[ai][bj][m][n], 0, 0, 0); __builtin_amdgcn_s_setprio(0); } while (0)
#define G_WAIT_V(n) asm volatile("s_waitcnt vmcnt(" #n ")" ::: "memory")
#define G_WAIT_L(n) asm volatile("s_waitcnt lgkmcnt(" #n ")" ::: "memory")
#define G_BAR __builtin_amdgcn_s_barrier()
#define G_SCHED __builtin_amdgcn_sched_barrier(0)
    Unit cur, nxt; int ui = 0;
    if (!S.next(0, cur)) return;
    f32x4 acc[2][2][4][2];
#pragma unroll
    for (int a = 0; a < 2; ++a)
#pragma unroll
        for (int b = 0; b < 2; ++b)
#pragma unroll
            for (int m = 0; m < 4; ++m)
#pragma unroll
                for (int n = 0; n < 2; ++n) acc[a][b][m][n] = (f32x4){0.f, 0.f, 0.f, 0.f};
    bf16x8 At[4][2], B0[2][2], B1[2][2];
    const char* cA = cur.A; const char* cB0 = cur.B0; const char* cB1 = cur.B1;
    G_STAGE(G_SB(0, 0), cB0, voffB); G_STAGE(G_SA(0, 0), cA, voffA); G_STAGE(G_SB(0, 1), cB1, voffB); G_STAGE(G_SA(0, 1), cA + hstepA, voffA);
    if (wr == 1) G_BAR;
    G_WAIT_V(4); G_BAR;
    G_STAGE(G_SB(1, 0), cB0 + kstep, voffB); G_STAGE(G_SA(1, 0), cA + kstep, voffA); G_STAGE(G_SB(1, 1), cB1 + kstep, voffB);
    G_WAIT_V(6); G_BAR;
    for (;;) {
        const bool has_next = S.next(ui + 1, nxt);
        const char* nA = has_next ? nxt.A : cA; const char* nB0 = has_next ? nxt.B0 : cB0; const char* nB1 = has_next ? nxt.B1 : cB1;
        for (int t = 0; t < nt; t += 2) {
            const bool last = (t == nt - 2);
            const char* a1 = cA + (size_t)(t + 1) * kstep;
            const char* a2 = last ? nA : cA + (size_t)(t + 2) * kstep;
            const char* b20 = last ? nB0 : cB0 + (size_t)(t + 2) * kstep;
            const char* b21 = last ? nB1 : cB1 + (size_t)(t + 2) * kstep;
            const char* a3 = a2 + kstep; const char* b30 = b20 + kstep; const char* b31 = b21 + kstep;
            if constexpr (Epi::NHOOK > 0) { if (t == Epi::HK1 || t == Epi::HK2) E.hook(acc, cur, t, wr, wc, fr, fq); }
            G_LDB(B0, 0, 0); G_SCHED; G_LDA(At, 0, 0); G_STAGE(G_SA(1, 1), a1 + hstepA, voffA);
            G_WAIT_L(8); G_BAR; G_WAIT_L(0); G_MMA(0, 0, At, B0); G_BAR; G_SCHED;
            G_LDB(B1, 0, 1); G_STAGE(G_SB(0, 0), b20, voffB);
            G_BAR; G_WAIT_L(0); G_MMA(0, 1, At, B1); G_BAR;
            G_LDA(At, 0, 1); G_STAGE(G_SA(0, 0), a2, voffA);
            G_BAR; G_WAIT_L(0); G_MMA(1, 0, At, B0); G_BAR; G_SCHED;
            G_STAGE(G_SB(0, 1), b21, voffB);
            G_WAIT_V(6); G_BAR; G_MMA(1, 1, At, B1); G_BAR;
            G_LDB(B0, 1, 0); G_SCHED; G_LDA(At, 1, 0); G_STAGE(G_SA(0, 1), a2 + hstepA, voffA);
            G_WAIT_L(8); G_BAR; G_WAIT_L(0); G_MMA(0, 0, At, B0); G_BAR; G_SCHED;
            G_LDB(B1, 1, 1); G_STAGE(G_SB(1, 0), b30, voffB);
            G_BAR; G_WAIT_L(0); G_MMA(0, 1, At, B1); G_BAR;
            G_LDA(At, 1, 1); G_STAGE(G_SA(1, 0), a3, voffA);
            G_BAR; G_WAIT_L(0); G_MMA(1, 0, At, B0); G_BAR; G_SCHED;
            G_STAGE(G_SB(1, 1), b31, voffB);
            G_WAIT_V(6); G_BAR; G_MMA(1, 1, At, B1); G_BAR;
        }
        E(acc, cur, wr, wc, fr, fq);
        if (!has_next) break;
#pragma unroll
        for (int a = 0; a < 2; ++a)
#pragma unroll
            for (int b = 0; b < 2; ++b)
#pragma unroll
                for (int m = 0; m < 4; ++m)
#pragma unroll
                    for (int n = 0; n < 2; ++n) acc[a][b][m][n] = (f32x4){0.f, 0.f, 0.f, 0.f};
        cur = nxt; cA = nA; cB0 = nB0; cB1 = nB1; ++ui;
    }
    G_WAIT_V(0);
    if (wr == 0) G_BAR;
    G_BAR;
#undef G_SA
#undef G_SB
#undef G_STAGE
#undef G_LDA
#undef G_LDB
#undef G_MMA
#undef G_WAIT_V
#undef G_WAIT_L
#undef G_BAR
#undef G_SCHED
}

constexpr size_t ROWB = (size_t)DM * 2;
struct SchedFfnUp {
    const char* A; const char* B; int G, c;
    DI bool next(int i, Unit& u) const { const int L = i * G + c; if (L >= 64 * 44) return false; int pm, pn; tile_decode(L, 64, 44, pm, pn);
        u.A = A + (size_t)pm * 256 * ROWB; u.B0 = B + (size_t)pn * 128 * ROWB; u.B1 = u.B0 + (size_t)DFF * ROWB; u.kind = 0; u.pm = pm; u.pn = pn; return true; }
};
struct SchedPlain {
    const char* A; const char* B; int nM, nN; size_t astep, bstep; int G, c;
    DI bool next(int i, Unit& u) const { const int L = i * G + c; if (L >= nM * nN) return false; int pm, pn; tile_decode(L, nM, nN, pm, pn);
        u.A = A + (size_t)pm * astep; u.B0 = B + (size_t)pn * bstep; u.B1 = u.B0 + (bstep >> 1); u.kind = 0; u.pm = pm; u.pn = pn; return true; }
};
struct SchedWin {
    const char* xb; const char* win; const char* wft; const char* xp; const char* xm; int G, c;
    DI bool next(int i, Unit& u) const {
        int L = i * G + c; int pm, pn;
        if (L < 2176) { tile_decode(L, 64, 34, pm, pn); u.A = xb + (size_t)pm * 256 * ROWB; u.pm = pm;
            if (pn < 8) { u.kind = 0; u.pn = pn; u.B0 = win + (size_t)(pn * 128) * ROWB; u.B1 = win + (size_t)(1024 + pn * 128) * ROWB; }
            else if (pn < 10) { u.kind = 1; u.pn = pn - 8; u.B0 = win + (size_t)(2560 + 256 * (pn - 8)) * ROWB; u.B1 = u.B0 + 128 * ROWB; }
            else { u.kind = 2; u.pn = pn - 10; u.B0 = win + (size_t)(3072 + 256 * (pn - 10)) * ROWB; u.B1 = u.B0 + 128 * ROWB; }
            return true; }
        L -= 2176;
        if (L < 128) { tile_decode(L, 4, 32, pm, pn); u.kind = 3; u.pm = pm; u.pn = pn; u.A = wft + (size_t)pm * 256 * ROWB;
            u.B0 = (pm < 2 ? xp : xm) + (size_t)pn * 256 * ROWB; u.B1 = u.B0 + 128 * ROWB; return true; }
        return false;
    }
};
struct SchedKV {
    const char* memb; const char* wkv; int c;
    DI bool next(int i, Unit& u) const {
        if (i > 0 || c >= 8) return false; int pm, pn; tile_decode(c & 3, 2, 2, pm, pn); u.pm = pm; u.pn = pn;
        if (c < 4) { u.kind = 4; u.A = memb + (size_t)pm * 256 * ROWB; u.B0 = wkv + (size_t)pn * 256 * ROWB; }
        else { u.kind = 5; u.A = wkv + (size_t)(512 + pm * 256) * ROWB; u.B0 = memb + (size_t)pn * 256 * ROWB; }
        u.B1 = u.B0 + 128 * ROWB; return true; }
};
struct SchedDft {
    const char* cm; const char* tt; int G, c;
    DI bool next(int i, Unit& u) const { const int L = i * G + c; if (L >= 128) return false; int pm, pn8; tile_decode(L, 16, 8, pm, pn8);
        const int b = pn8 >> 2, p = (pn8 >> 1) & 1, pn = pn8 & 1;
        u.A = cm + (size_t)p * CM_HALF + (size_t)pm * 256 * HSEQ * 2; u.B0 = tt + ((size_t)(p * 512 + pn * 256) * SEQ + (size_t)b * HSEQ) * 2; u.B1 = u.B0 + (size_t)128 * SEQ * 2;
        u.kind = p; u.pm = b * 32 + pm; u.pn = p * 2 + pn; return true; }
};

template <int ACT>
DI void store_tile_bf16(const f32x4 (&acc)[2][2][4][2], bf16_t* out, size_t ld, int row0, int col0, const float* colbias, const float* rowbias, float scale, float cbs = 1.0f) {
    f32x4 cb[2][2];
#pragma unroll
    for (int bj = 0; bj < 2; ++bj)
#pragma unroll
        for (int n = 0; n < 2; ++n) cb[bj][n] = colbias ? *(const f32x4*)(colbias + col0 + bj * HALF + 4 * n) * cbs : (f32x4){0.f, 0.f, 0.f, 0.f};
#pragma unroll
    for (int ai = 0; ai < 2; ++ai)
#pragma unroll
        for (int m = 0; m < 4; ++m) { const int row = row0 + ai * HALF + m * 16; const float rb = rowbias ? rowbias[row] : 0.f; bf16_t* rp = out + (size_t)row * ld + col0;
#pragma unroll
            for (int bj = 0; bj < 2; ++bj) { f32x4 v0 = (acc[ai][bj][m][0] + cb[bj][0] + rb) * scale, v1 = (acc[ai][bj][m][1] + cb[bj][1] + rb) * scale;
                if (ACT == 1) {
#pragma unroll
                    for (int j = 0; j < 4; ++j) { v0[j] = sigmoidf_fast(v0[j]); v1[j] = sigmoidf_fast(v1[j]); } }
                *(u32x4*)(rp + bj * HALF) = pack8(v0, v1); } }
}
struct EpiSwiGLU {
    static constexpr bool PERM = true; static constexpr int NHOOK = 0; bf16_t* H;
    DI void operator()(const f32x4 (&acc)[2][2][4][2], const Unit& u, int wr, int wc, int fr, int fq) const {
        const int row0 = u.pm * 256 + wr * 64 + fr, col0 = u.pn * 128 + wc * 32 + 8 * fq;
#pragma unroll
        for (int ai = 0; ai < 2; ++ai)
#pragma unroll
            for (int m = 0; m < 4; ++m) { f32x4 v[2];
#pragma unroll
                for (int n = 0; n < 2; ++n) { const f32x4 a = acc[ai][0][m][n], g = acc[ai][1][m][n];
#pragma unroll
                    for (int j = 0; j < 4; ++j) v[n][j] = a[j] * g[j] * sigmoidf_fast(g[j]); }
                *(u32x4*)(H + (size_t)(row0 + ai * HALF + m * 16) * DFF + col0) = pack8(v[0], v[1]); }
    }
};
template <bool LNSRC, int BETA2> struct EpiResid {
    static constexpr bool PERM = false; static constexpr int NHOOK = 0; static constexpr float alpha = DN_ALPHA, beta = 0.5f * BETA2; const float* src; float* dst; const float* stats; const float* lng; const float* lnb;
    DI void operator()(const f32x4 (&acc)[2][2][4][2], const Unit& u, int wr, int wc, int fr, int fq) const {
        const int row0 = u.pm * 256 + wr * 64 + fr, col0 = u.pn * 256 + wc * 32 + 4 * fq;
        if constexpr (LNSRC) {
            const f32x4 g00 = *(const f32x4*)(lng + col0) * alpha, g01 = *(const f32x4*)(lng + col0 + 16) * alpha, g10 = *(const f32x4*)(lng + col0 + HALF) * alpha, g11 = *(const f32x4*)(lng + col0 + HALF + 16) * alpha;
            const f32x4 b00 = *(const f32x4*)(lnb + col0) * alpha, b01 = *(const f32x4*)(lnb + col0 + 16) * alpha, b10 = *(const f32x4*)(lnb + col0 + HALF) * alpha, b11 = *(const f32x4*)(lnb + col0 + HALF + 16) * alpha;
#pragma unroll
            for (int ai = 0; ai < 2; ++ai)
#pragma unroll
                for (int mp = 0; mp < 2; ++mp) { f32x4 sv[2][4]; float mean[2], rstd[2];
#pragma unroll
                    for (int mm = 0; mm < 2; ++mm) { const int row = row0 + ai * HALF + (2 * mp + mm) * 16; const size_t off = (size_t)row * DM + col0;
                        mean[mm] = stats[2 * row]; rstd[mm] = stats[2 * row + 1];
                        sv[mm][0] = *(const f32x4*)(src + off); sv[mm][1] = *(const f32x4*)(src + off + 16); sv[mm][2] = *(const f32x4*)(src + off + HALF); sv[mm][3] = *(const f32x4*)(src + off + HALF + 16); }
#pragma unroll
                    for (int mm = 0; mm < 2; ++mm) { const int m = 2 * mp + mm; const size_t off = (size_t)(row0 + ai * HALF + m * 16) * DM + col0;
                        *(f32x4*)(dst + off) = (sv[mm][0] - mean[mm]) * rstd[mm] * g00 + b00 + acc[ai][0][m][0] * beta;
                        *(f32x4*)(dst + off + 16) = (sv[mm][1] - mean[mm]) * rstd[mm] * g01 + b01 + acc[ai][0][m][1] * beta;
                        *(f32x4*)(dst + off + HALF) = (sv[mm][2] - mean[mm]) * rstd[mm] * g10 + b10 + acc[ai][1][m][0] * beta;
                        *(f32x4*)(dst + off + HALF + 16) = (sv[mm][3] - mean[mm]) * rstd[mm] * g11 + b11 + acc[ai][1][m][1] * beta; }
                    asm volatile("" ::: "memory"); }
        } else {
#pragma unroll
            for (int ai = 0; ai < 2; ++ai)
#pragma unroll
                for (int m = 0; m < 4; ++m) { const size_t off = (size_t)(row0 + ai * HALF + m * 16) * DM + col0;
#pragma unroll
                    for (int bj = 0; bj < 2; ++bj)
#pragma unroll
                        for (int n = 0; n < 2; ++n) { const f32x4 sv = *(const f32x4*)(src + off + bj * HALF + n * 16); *(f32x4*)(dst + off + bj * HALF + n * 16) = sv * alpha + acc[ai][bj][m][n] * beta; }
                    asm volatile("" ::: "memory"); }
        }
    }
};
struct EpiWin {
    static constexpr bool PERM = true; static constexpr int NHOOK = 0;
    const float* bin; const float* biasT; bf16_t *GLU, *Q, *Gt, *TT;
    DI void operator()(const f32x4 (&acc)[2][2][4][2], const Unit& u, int wr, int wc, int fr, int fq) const {
        const int row0 = u.pm * 256 + wr * 64 + fr, cin = wc * 32 + 8 * fq;
        if (u.kind == 0) {
            const int col0 = u.pn * 128 + cin; f32x4 bv[2], bg[2];
#pragma unroll
            for (int n = 0; n < 2; ++n) { bv[n] = *(const f32x4*)(bin + col0 + 4 * n); bg[n] = *(const f32x4*)(bin + 1024 + col0 + 4 * n); }
#pragma unroll
            for (int ai = 0; ai < 2; ++ai)
#pragma unroll
                for (int m = 0; m < 4; ++m) { f32x4 v[2];
#pragma unroll
                    for (int n = 0; n < 2; ++n) { const f32x4 a = acc[ai][0][m][n] + bv[n], g = acc[ai][1][m][n] + bg[n];
#pragma unroll
                        for (int j = 0; j < 4; ++j) v[n][j] = a[j] * sigmoidf_fast(g[j]); }
                    *(u32x4*)(GLU + (size_t)(row0 + ai * HALF + m * 16) * 1024 + col0) = pack8(v[0], v[1]); }
        } else if (u.kind == 1) store_tile_bf16<0>(acc, Q, 512, row0, u.pn * 256 + cin, bin + 2560, nullptr, 0.08838834764831845f);
        else if (u.kind == 2) store_tile_bf16<1>(acc, Gt, 6144, row0, u.pn * 256 + cin, bin + 3072, nullptr, 1.0f);
        else {
            const bool cosr = u.pm < 2; const int col0 = u.pn * 256 + cin;
#pragma unroll
            for (int ai = 0; ai < 2; ++ai)
#pragma unroll
                for (int m = 0; m < 4; ++m) { const int row = row0 + ai * HALF + m * 16; const float rb = cosr ? biasT[row] : 0.f;
#pragma unroll
                    for (int bj = 0; bj < 2; ++bj) { f32x4 v0 = acc[ai][bj][m][0] + 2.0f * rb, v1 = acc[ai][bj][m][1] + 2.0f * rb;
                        if (((col0 + bj * HALF) & (HSEQ - 1)) == 0) v0[0] -= rb;
                        *(u32x4*)(TT + (size_t)row * SEQ + col0 + bj * HALF) = pack8(v0, v1); } }
        }
    }
};
struct EpiKV {
    static constexpr bool PERM = true; static constexpr int NHOOK = 0; bf16_t *KK, *VT;
    DI void operator()(const f32x4 (&acc)[2][2][4][2], const Unit& u, int wr, int wc, int fr, int fq) const {
        store_tile_bf16<0>(acc, u.kind == 4 ? KK : VT, 512, u.pm * 256 + wr * 64 + fr, u.pn * 256 + wc * 32 + 8 * fq, nullptr, nullptr, 1.0f);
    }
};
struct EpiDft {
    static constexpr bool PERM = true; static constexpr int NHOOK = 0; bf16_t* out; const float* uh;
    DI void operator()(const f32x4 (&acc)[2][2][4][2], const Unit& u, int wr, int wc, int fr, int fq) const {
        const int b = u.pm >> 5, k0 = (u.pm & 31) * 256 + wr * 64 + fr, col0 = u.pn * 256 + wc * 32 + 8 * fq;
        const float sgn = (fr & 1) ? -1.0f : 1.0f; const unsigned flip = u.kind ? 0x80008000u : 0u;
        f32x4 cb[2][2];
#pragma unroll
        for (int bj = 0; bj < 2; ++bj)
#pragma unroll
            for (int n = 0; n < 2; ++n) cb[bj][n] = (u.kind == 0) ? *(const f32x4*)(uh + b * 512 + col0 + bj * HALF + 4 * n) * sgn : (f32x4){0.f, 0.f, 0.f, 0.f};
#pragma unroll
        for (int ai = 0; ai < 2; ++ai)
#pragma unroll
            for (int m = 0; m < 4; ++m) { const int k = k0 + ai * HALF + m * 16;
                bf16_t* rp = out + (size_t)(b * SEQ + k) * KBR + col0; bf16_t* rq = out + (size_t)(b * SEQ + SEQ - k) * KBR + col0;
#pragma unroll
                for (int bj = 0; bj < 2; ++bj) { u32x4 w = pack8(acc[ai][bj][m][0] + cb[bj][0], acc[ai][bj][m][1] + cb[bj][1]);
                    *(u32x4*)(rp + bj * HALF) = w;
                    if (k != 0) { w.x ^= flip; w.y ^= flip; w.z ^= flip; w.w ^= flip; *(u32x4*)(rq + bj * HALF) = w; } } }
    }
};
struct EpiPlainBf16 {
    static constexpr bool PERM = true; static constexpr int NHOOK = 0; bf16_t* out; int ld;
    DI void operator()(const f32x4 (&acc)[2][2][4][2], const Unit& u, int wr, int wc, int fr, int fq) const {
        store_tile_bf16<0>(acc, out, (size_t)ld, u.pm * 256 + wr * 64 + fr, u.pn * 256 + wc * 32 + 8 * fq, nullptr, nullptr, 1.0f);
    }
};
struct EpiBranchFused {
    static constexpr bool PERM = true; static constexpr int NHOOK = 2, HK1 = 16, HK2 = 32; const bf16_t* Gt; bf16_t* MG;
    DI void hook(f32x4 (&acc)[2][2][4][2], const Unit& u, int t, int wr, int wc, int fr, int fq) const {
        const int sgm = (t == HK1) ? 0 : 1;
        asm volatile("" : "+v"(fr), "+v"(fq));
        const int row0 = u.pm * 256 + wr * 64 + fr, col0 = u.pn * 256 + wc * 32 + 8 * fq;
#pragma unroll
        for (int ai = 0; ai < 2; ++ai) {
            u32x4 ga[4][2], gb[4][2];
#pragma unroll
            for (int m = 0; m < 4; ++m) { const bf16_t* gp = Gt + (size_t)(row0 + ai * HALF + m * 16) * 6144 + sgm * DM + col0;
#pragma unroll
                for (int bj = 0; bj < 2; ++bj) { ga[m][bj] = *(const u32x4*)(gp + bj * HALF); gb[m][bj] = *(const u32x4*)(gp + DM + bj * HALF); } }
#pragma unroll
            for (int m = 0; m < 4; ++m)
#pragma unroll
                for (int bj = 0; bj < 2; ++bj) { f32x4 a0, a1, b0, b1; unpack8(ga[m][bj], a0, a1); unpack8(gb[m][bj], b0, b1);
#pragma unroll
                    for (int j = 0; j < 4; ++j) { acc[ai][bj][m][0][j] *= a0[j] * __builtin_amdgcn_rcpf(b0[j]); acc[ai][bj][m][1][j] *= a1[j] * __builtin_amdgcn_rcpf(b1[j]); } }
            asm volatile("" ::: "memory");
        }
    }
    DI void operator()(const f32x4 (&acc)[2][2][4][2], const Unit& u, int wr, int wc, int fr, int fq) const {
        const int row0 = u.pm * 256 + wr * 64 + fr, col0 = u.pn * 256 + wc * 32 + 8 * fq;
#pragma unroll
        for (int ai = 0; ai < 2; ++ai) {
            u32x4 gg[4][2];
#pragma unroll
            for (int m = 0; m < 4; ++m)
#pragma unroll
                for (int bj = 0; bj < 2; ++bj) gg[m][bj] = *(const u32x4*)(Gt + (size_t)(row0 + ai * HALF + m * 16) * 6144 + 2 * DM + col0 + bj * HALF);
#pragma unroll
            for (int m = 0; m < 4; ++m)
#pragma unroll
                for (int bj = 0; bj < 2; ++bj) { f32x4 g0, g1; unpack8(gg[m][bj], g0, g1);
                    *(u32x4*)(MG + (size_t)(row0 + ai * HALF + m * 16) * DM + col0 + bj * HALF) = pack8(g0 * acc[ai][bj][m][0], g1 * acc[ai][bj][m][1]); }
            asm volatile("" ::: "memory");
        }
    }
};

DI void transpose_item(const float* W, int N, bf16_t* WT, int ldo, int row_off, int koff, LAS float* scr, int item, int lane) {
    const int nblk = N / 32, kb = item / nblk, nb = item % nblk, k0 = 64 * kb, n0 = 32 * nb;
    f32x4 v[8];
    { const float* wp = W + (size_t)(k0 + (lane >> 3)) * N + n0 + 4 * (lane & 7);
#pragma unroll
      for (int i = 0; i < 8; ++i) v[i] = *(const f32x4*)(wp + (size_t)(8 * i) * N); }
#pragma unroll
    for (int i = 0; i < 8; ++i) { LAS float* d = scr + (8 * i + (lane >> 3)) * 33 + 4 * (lane & 7); d[0] = v[i][0]; d[1] = v[i][1]; d[2] = v[i][2]; d[3] = v[i][3]; }
    asm volatile("s_waitcnt lgkmcnt(0)" ::: "memory");
    const int c = lane & 7;
#pragma unroll
    for (int j = 0; j < 4; ++j) { const int n = (lane >> 3) + 8 * j; const LAS float* s = scr + (8 * c) * 33 + n;
        u32x4 o; o.x = pk2(s[0 * 33], s[1 * 33]); o.y = pk2(s[2 * 33], s[3 * 33]); o.z = pk2(s[4 * 33], s[5 * 33]); o.w = pk2(s[6 * 33], s[7 * 33]);
        *(u32x4*)(WT + (size_t)(row_off + n0 + n) * ldo + koff + k0 + 8 * c) = o; }
    asm volatile("s_waitcnt lgkmcnt(0)" ::: "memory");
}

struct Params { const float* in[23]; float* out; unsigned char* ws; int ph_lo, ph_hi; };

DI void convert_weights(const Params& P, int l, LAS unsigned char* lds) {
    const int tid = ltid(), lane = tid & 63, wid = tid >> 6;
    unsigned char* ws = P.ws;
    LAS float* scr = (LAS float*)(lds + wid * 8448);
    const int gw = blockIdx.x * 8 + wid, NGW = gridDim.x * 8;
    constexpr int I13 = 32 * 352, I2 = 88 * 64, IIN = 32 * 288, ICO = 16 * 64, IF = 8 * 64, IKV = 32 * 32, IO = 8 * 64, IOUT = 32 * 64;
    constexpr int NITEMS = 2 * I13 + 2 * I2 + IIN + ICO + 2 * IF + IKV + IO + IOUT;
    const float* w13a = P.in[2] + (size_t)l * DM * 2 * DFF; const float* w2a = P.in[3] + (size_t)l * DFF * DM;
    const float* win = P.in[6] + (size_t)l * DM * DIN; const float* wco = P.in[12] + (size_t)l * 1024 * DM; const float* wf = P.in[13] + (size_t)l * 512 * DM;
    const float* wkv = P.in[14] + (size_t)l * DM * 1024; const float* wo = P.in[15] + (size_t)l * 512 * DM; const float* wout = P.in[16] + (size_t)l * DM * DM;
    const float* w13b = P.in[19] + (size_t)l * DM * 2 * DFF; const float* w2b = P.in[20] + (size_t)l * DFF * DM;
    for (int it = gw; it < NITEMS; it += NGW) {
        int r = it;
        if (r < I13) { transpose_item(w13a, 2 * DFF, (bf16_t*)(ws + WS_W13A), DM, 0, 0, scr, r, lane); continue; } r -= I13;
        if (r < I13) { transpose_item(w13b, 2 * DFF, (bf16_t*)(ws + WS_W13B), DM, 0, 0, scr, r, lane); continue; } r -= I13;
        if (r < I2) { transpose_item(w2a, DM, (bf16_t*)(ws + WS_W2A), DFF, 0, 0, scr, r, lane); continue; } r -= I2;
        if (r < I2) { transpose_item(w2b, DM, (bf16_t*)(ws + WS_W2B), DFF, 0, 0, scr, r, lane); continue; } r -= I2;
        if (r < IIN) { transpose_item(win, DIN, (bf16_t*)(ws + WS_WIN), DM, 0, 0, scr, r, lane); continue; } r -= IIN;
        if (r < ICO) { transpose_item(wco, DM, (bf16_t*)(ws + WS_WBR), KBR, 0, 0, scr, r, lane); continue; } r -= ICO;
        if (r < IF) { transpose_item(wf, DM, (bf16_t*)(ws + WS_WBR), KBR, 0, 1024, scr, r, lane); continue; } r -= IF;
        if (r < IF) { transpose_item(wf, DM, (bf16_t*)(ws + WS_WBR), KBR, 0, 1536, scr, r, lane); continue; } r -= IF;
        if (r < IKV) { transpose_item(wkv, 1024, (bf16_t*)(ws + WS_WKV), DM, 0, 0, scr, r, lane); continue; } r -= IKV;
        if (r < IO) { transpose_item(wo, DM, (bf16_t*)(ws + WS_WBR), KBR, 0, 2048, scr, r, lane); continue; } r -= IO;
        transpose_item(wout, DM, (bf16_t*)(ws + WS_WOUT), DM, 0, 0, scr, r, lane);
    }
    __syncthreads();
    {
        LAS float* tile = (LAS float*)lds;
        LAS float* tabc = tile + 32 * 129; LAS float* tabs = tabc + 128;
        const float* bin = P.in[7] + (size_t)l * DIN;
        bf16_t* WFT = (bf16_t*)(ws + WS_WFT); float* biasT = (float*)(ws + WS_BIAST);
        if (tid < 128) { float sn, cs; sincospif((float)tid * (1.0f / 64.0f), &sn, &cs); tabc[tid] = cs * 0.08838834764831845f; tabs[tid] = sn * 0.08838834764831845f; }
        for (int item = blockIdx.x; item < 256; item += gridDim.x) {
            const int kb = item >> 2, g = item & 3;
            __syncthreads();
            for (int idx = tid; idx < 32 * 128; idx += 512) { const int kk = idx >> 7, j = idx & 127; tile[kk * 129 + j] = win[(size_t)(kb * 32 + kk) * DIN + 2048 + g * 128 + j]; }
            __syncthreads();
            const int k = tid & 31, ccb = (tid >> 5) * 8;
            float ac[8], as[8];
#pragma unroll
            for (int c8 = 0; c8 < 8; ++c8) { ac[c8] = 0.f; as[c8] = 0.f; }
            for (int j = 0; j < 128; ++j) { const float w = tile[k * 129 + j];
#pragma unroll
                for (int c8 = 0; c8 < 8; ++c8) { const int idx = (j * (ccb + c8)) & 127; ac[c8] += w * tabc[idx]; as[c8] += w * tabs[idx]; } }
#pragma unroll
            for (int c8 = 0; c8 < 8; ++c8) { WFT[(size_t)(g * 128 + ccb + c8) * DM + kb * 32 + k] = f2bf(ac[c8]); WFT[(size_t)(512 + g * 128 + ccb + c8) * DM + kb * 32 + k] = f2bf(as[c8]); }
            if (kb == 0 && tid < 128) { float bc = 0.f, bs = 0.f;
                for (int j = 0; j < 128; ++j) { const float w = bin[2048 + g * 128 + j]; const int idx = (j * tid) & 127; bc += w * tabc[idx]; bs += w * tabs[idx]; }
                biasT[g * 128 + tid] = bc; biasT[512 + g * 128 + tid] = bs; }
        }
        __syncthreads();
    }
}

DI void setup_phase(const Params& P, LAS unsigned char* lds) {
    const int tid = ltid(); unsigned char* ws = P.ws;
    const size_t gt = (size_t)blockIdx.x * 512 + tid, ngt = (size_t)gridDim.x * 512;
    { const f32x4* src = (const f32x4*)P.in[0]; u32x4* dst = (u32x4*)(ws + WS_XB);
      for (size_t i = gt; i < (size_t)NTOK * DM / 8; i += ngt) dst[i] = pack8(src[2 * i], src[2 * i + 1]); }
    { const f32x4* src = (const f32x4*)P.in[1]; u32x4* dst = (u32x4*)(ws + WS_MEMB);
      for (size_t i = gt; i < (size_t)512 * DM / 8; i += ngt) dst[i] = pack8(src[2 * i], src[2 * i + 1]); }
    bf16_t* cm0 = (bf16_t*)(ws + WS_CM); bf16_t* cm1 = (bf16_t*)(ws + WS_CM + CM_HALF);
    for (int j = blockIdx.x; j < HSEQ; j += gridDim.x) {
        f32x4 c0, c1, s0, s1;
#pragma unroll
        for (int e = 0; e < 8; ++e) { const float x = (float)((j * (tid * 8 + e)) & (SEQ - 1)) * (1.0f / 8192.0f);
            const float cv = __builtin_amdgcn_cosf(x) * 0.011048543456039806f, sv = __builtin_amdgcn_sinf(x) * -0.011048543456039806f;
            if (e < 4) { c0[e] = cv; s0[e] = sv; } else { c1[e - 4] = cv; s1[e - 4] = sv; } }
        *(u32x4*)(cm0 + (size_t)j * HSEQ + tid * 8) = pack8(c0, c1); *(u32x4*)(cm1 + (size_t)j * HSEQ + tid * 8) = pack8(s0, s1);
    }
}

DI void ln_phase(float* X, bf16_t* XB, float* stats, const float* g, const float* bta, bool final_out) {
    const int tid = ltid(), lane = tid & 63, gw = blockIdx.x * 8 + (tid >> 6), ngw = gridDim.x * 8;
    f32x4 gv[8], bv[8];
#pragma unroll
    for (int j = 0; j < 8; ++j) { gv[j] = ((const f32x4*)g)[64 * j + lane]; bv[j] = ((const f32x4*)bta)[64 * j + lane]; }
    f32x4 nv[8];
    if (gw < NTOK) { const f32x4* xr0 = (const f32x4*)(X + (size_t)gw * DM) + lane;
#pragma unroll
        for (int j = 0; j < 8; ++j) nv[j] = xr0[64 * j]; }
    for (int row = gw; row < NTOK; row += ngw) {
        f32x4* xr = (f32x4*)(X + (size_t)row * DM) + lane; f32x4 v[8]; float s = 0.f;
#pragma unroll
        for (int j = 0; j < 8; ++j) v[j] = nv[j];
        if (row + ngw < NTOK) { const f32x4* xn = (const f32x4*)(X + (size_t)(row + ngw) * DM) + lane;
#pragma unroll
            for (int j = 0; j < 8; ++j) nv[j] = xn[64 * j]; }
#pragma unroll
        for (int j = 0; j < 8; ++j) s += (v[j][0] + v[j][1]) + (v[j][2] + v[j][3]);
        const float mean = wave_sum(s) * (1.0f / DM); float s2 = 0.f;
#pragma unroll
        for (int j = 0; j < 8; ++j) { v[j] = v[j] - mean; s2 += (v[j][0] * v[j][0] + v[j][1] * v[j][1]) + (v[j][2] * v[j][2] + v[j][3] * v[j][3]); }
        const float rstd = 1.0f / sqrtf(wave_sum(s2) * (1.0f / DM) + LN_EPS);
        if (final_out) {
#pragma unroll
            for (int j = 0; j < 8; ++j) xr[64 * j] = v[j] * rstd * gv[j] + bv[j];
        } else {
            if (lane == 0) { f32x2 st = {mean, rstd}; *(f32x2*)(stats + 2 * row) = st; }
            u32x2* ob = (u32x2*)(XB + (size_t)row * DM) + lane;
#pragma unroll
            for (int j = 0; j < 8; ++j) { const f32x4 y = v[j] * rstd * gv[j] + bv[j]; u32x2 w; w.x = pk2(y[0], y[1]); w.y = pk2(y[2], y[3]); ob[64 * j] = w; }
        }
    }
}

DI void ln_row(f32x4 (&v)[8], const f32x4 (&gv)[8], const f32x4 (&bv)[8], float* stats, int row, bf16_t* XB, int lane) {
    float s = 0.f;
#pragma unroll
    for (int j = 0; j < 8; ++j) s += (v[j][0] + v[j][1]) + (v[j][2] + v[j][3]);
    const float mean = wave_sum(s) * (1.0f / DM); float s2 = 0.f;
#pragma unroll
    for (int j = 0; j < 8; ++j) { v[j] = v[j] - mean; s2 += (v[j][0] * v[j][0] + v[j][1] * v[j][1]) + (v[j][2] * v[j][2] + v[j][3] * v[j][3]); }
    const float rstd = 1.0f / sqrtf(wave_sum(s2) * (1.0f / DM) + LN_EPS);
    if (lane == 0) { f32x2 st = {mean, rstd}; *(f32x2*)(stats + 2 * row) = st; }
    u32x2* ob = (u32x2*)(XB + (size_t)row * DM) + lane;
#pragma unroll
    for (int j = 0; j < 8; ++j) { v[j] = v[j] * rstd * gv[j] + bv[j]; u32x2 w; w.x = pk2(v[j][0], v[j][1]); w.y = pk2(v[j][2], v[j][3]); ob[64 * j] = w; }
}
DI void ln_fold_phase(const float* X, bf16_t* XB, bf16_t* XP, bf16_t* XM, float* stats, const float* g, const float* bta) {
    const int tid = ltid(), lane = tid & 63, wv = ((int)blockIdx.x - 8) * 8 + (tid >> 6), nwv = ((int)gridDim.x - 8) * 8;
    f32x4 gv[8], bv[8];
#pragma unroll
    for (int j = 0; j < 8; ++j) { gv[j] = ((const f32x4*)g)[64 * j + lane]; bv[j] = ((const f32x4*)bta)[64 * j + lane]; }
    for (int it = wv; it < 2 * (HSEQ + 1); it += nwv) {
        const int b = it / (HSEQ + 1), i = it - b * (HSEQ + 1);
        const bool pair = (i != 0) && (i != HSEQ);
        const int rowA = b * SEQ + i, rowB = b * SEQ + (SEQ - i);
        f32x4 va[8], vb[8];
        { const f32x4* xa = (const f32x4*)(X + (size_t)rowA * DM) + lane;
#pragma unroll
          for (int j = 0; j < 8; ++j) va[j] = xa[64 * j]; }
        if (pair) { const f32x4* xq = (const f32x4*)(X + (size_t)rowB * DM) + lane;
#pragma unroll
            for (int j = 0; j < 8; ++j) vb[j] = xq[64 * j]; }
        else {
#pragma unroll
            for (int j = 0; j < 8; ++j) vb[j] = (f32x4){0.f, 0.f, 0.f, 0.f}; }
        ln_row(va, gv, bv, stats, rowA, XB, lane);
        if (pair) ln_row(vb, gv, bv, stats, rowB, XB, lane);
        if (i != HSEQ) {
            u32x2* op = (u32x2*)(XP + (size_t)(b * HSEQ + i) * DM) + lane; u32x2* om = (u32x2*)(XM + (size_t)(b * HSEQ + i) * DM) + lane;
#pragma unroll
            for (int j = 0; j < 8; ++j) { f32x4 p = va[j], m = {0.f, 0.f, 0.f, 0.f}; if (pair) { p = va[j] + vb[j]; m = va[j] - vb[j]; }
                u32x2 w; w.x = pk2(p[0], p[1]); w.y = pk2(p[2], p[3]); op[64 * j] = w; w.x = pk2(m[0], m[1]); w.y = pk2(m[2], m[3]); om[64 * j] = w; }
        }
    }
}

constexpr int CT = 16, CROWS = CT + 30;
DI void conv_tile(const bf16_t* GLU, bf16_t* CV, const float* cw, const float* cb, const float* lg, const float* lb, int tile, LAS unsigned char* lds) {
    const int tid = ltid(), lane = tid & 63, wid = __builtin_amdgcn_readfirstlane(tid >> 6);
    const int tok0 = tile * CT, b = tok0 >> 13, s0 = tok0 & (SEQ - 1);
    LAS unsigned char* ldst = lds + tid * 4;
    asm volatile("" : "+v"(ldst));
    asm volatile("" : "+s"(GLU), "+s"(CV), "+s"(cw), "+s"(cb), "+s"(lg), "+s"(lb));
    __syncthreads();
    for (int idx = tid; idx < CROWS * 128; idx += 512) { const int rr = idx >> 7, c16 = idx & 127, s = s0 - 15 + rr; u32x4 v = {0u, 0u, 0u, 0u};
        if (s >= 0 && s < SEQ) v = *(const u32x4*)(GLU + ((size_t)(b * SEQ + s)) * 1024 + c16 * 8);
        *(LAS u32x4*)(lds + rr * 2048 + c16 * 16) = v; }
    __syncthreads();
    float w0[31], w1[31];
#pragma unroll
    for (int j = 0; j < 31; ++j) { const f32x2 w = *(const f32x2*)(cw + j * 1024 + 2 * tid); w0[j] = w[0]; w1[j] = w[1]; }
    float a0[CT], a1[CT];
#pragma unroll
    for (int t = 0; t < CT; ++t) { a0[t] = 0.f; a1[t] = 0.f; }
    unsigned vnext = *(const LAS unsigned*)ldst;
#pragma unroll
    for (int rr = 0; rr < CROWS; ++rr) { const unsigned v = vnext; if (rr + 1 < CROWS) vnext = *(const LAS unsigned*)(ldst + (rr + 1) * 2048);
        asm volatile("" ::: "memory");
        const float x0 = __uint_as_float(v << 16), x1 = __uint_as_float(v & 0xffff0000u);
#pragma unroll
        for (int t = 0; t < CT; ++t) { const int j = rr - t; if (j >= 0 && j <= 30) { a0[t] += x0 * w0[j]; a1[t] += x1 * w1[j]; } } }
    const f32x2 cbv = *(const f32x2*)(cb + 2 * tid);
    __syncthreads();
    { LAS float* yw = (LAS float*)lds + 2 * tid;
      asm volatile("" : "+v"(yw));
#pragma unroll
      for (int t = 0; t < CT; ++t) { f32x2 y = {a0[t] + cbv[0], a1[t] + cbv[1]}; *(LAS f32x2*)(yw + t * 1024) = y; } }
    __syncthreads();
    {
        f32x4 gv[4], bv[4];
#pragma unroll
        for (int i = 0; i < 4; ++i) { gv[i] = *(const f32x4*)(lg + 4 * lane + 256 * i); bv[i] = *(const f32x4*)(lb + 4 * lane + 256 * i); }
#pragma unroll
        for (int tt = 0; tt < 2; ++tt) { const int t = 2 * wid + tt; const LAS float* yr = (const LAS float*)lds + t * 1024 + 4 * lane;
            f32x4 v[4]; float s = 0.f;
#pragma unroll
            for (int i = 0; i < 4; ++i) { v[i] = *(const LAS f32x4*)(yr + 256 * i); s += (v[i][0] + v[i][1]) + (v[i][2] + v[i][3]); }
            const float mean = wave_sum(s) * (1.0f / 1024.0f); float s2 = 0.f;
#pragma unroll
            for (int i = 0; i < 4; ++i) { v[i] = v[i] - mean; s2 += (v[i][0] * v[i][0] + v[i][1] * v[i][1]) + (v[i][2] * v[i][2] + v[i][3] * v[i][3]); }
            const float rstd = 1.0f / sqrtf(wave_sum(s2) * (1.0f / 1024.0f) + LN_EPS);
            bf16_t* op = CV + (size_t)(tok0 + t) * KBR + 4 * lane;
#pragma unroll
            for (int i = 0; i < 4; ++i) { f32x4 y = v[i] * rstd * gv[i] + bv[i];
#pragma unroll
                for (int j = 0; j < 4; ++j) y[j] *= sigmoidf_fast(y[j]);
                u32x2 w; w.x = pk2(y[0], y[1]); w.y = pk2(y[2], y[3]); *(u32x2*)(op + 256 * i) = w; } }
    }
}

DI void attn_unit(const bf16_t* Q, const bf16_t* KK, const bf16_t* VT, bf16_t* OO, int b, int h, int qt, LAS unsigned char* lds) {
    const int tid = ltid(), lane = tid & 63, wid = __builtin_amdgcn_readfirstlane(tid >> 6), r = lane & 31, h2 = lane >> 5;
    const int tok0 = b * SEQ + qt * 256 + wid * 32;
    asm volatile("" : "+s"(Q), "+s"(KK), "+s"(VT), "+s"(OO));
    LAS unsigned char* ldsK = lds; LAS unsigned char* ldsV = lds + 65536;
    __syncthreads();
#pragma unroll
    for (int i = 0; i < 8; ++i) { const int id = i * 512 + tid, row = id >> 4, ch = id & 15;
        const u32x4 v = *(const u32x4*)(KK + (size_t)(b * 256 + row) * 512 + h * 128 + ch * 8);
        *(LAS u32x4*)(ldsK + row * 256 + ((ch ^ (row & 15)) << 4)) = v; }
#pragma unroll
    for (int i = 0; i < 8; ++i) { const int id = i * 512 + tid, row = id >> 5, ch = id & 31;
        const u32x4 v = *(const u32x4*)(VT + (size_t)(h * 128 + row) * 512 + b * 256 + ch * 8);
        *(LAS u32x4*)(ldsV + row * 512 + ((ch ^ (row & 31)) << 4)) = v; }
    bf16x8 qf[8];
    { const bf16_t* qp = Q + (size_t)(tok0 + r) * 512 + h * 128 + 8 * h2;
#pragma unroll
      for (int s = 0; s < 8; ++s) qf[s] = *(const bf16x8*)(qp + 16 * s); }
    __syncthreads();
    f32x16 sacc[8];
    { const LAS unsigned char* kbase = ldsK + r * 256; const int rx = r & 15;
#pragma unroll
      for (int kb = 0; kb < 8; ++kb) {
#pragma unroll
        for (int i = 0; i < 16; ++i) sacc[kb][i] = 0.f;
#pragma unroll
        for (int s = 0; s < 8; ++s) { const bf16x8 kf = *(const LAS bf16x8*)(kbase + kb * 8192 + (((2 * s + h2) ^ rx) << 4)); sacc[kb] = __builtin_amdgcn_mfma_f32_32x32x16_bf16(kf, qf[s], sacc[kb], 0, 0, 0); }
      } }
    float mx = -3.0e38f;
#pragma unroll
    for (int kb = 0; kb < 8; ++kb)
#pragma unroll
        for (int i = 0; i < 16; ++i) mx = fmaxf(mx, sacc[kb][i]);
    mx = fmaxf(mx, __shfl_xor(mx, 32));
    float sum = 0.f;
#pragma unroll
    for (int kb = 0; kb < 8; ++kb)
#pragma unroll
        for (int i = 0; i < 16; ++i) { const float p = __expf(sacc[kb][i] - mx); sacc[kb][i] = p; sum += p; }
    sum += __shfl_xor(sum, 32);
    const float inv = 1.0f / sum;
    f32x16 oacc[4];
#pragma unroll
    for (int db = 0; db < 4; ++db)
#pragma unroll
        for (int i = 0; i < 16; ++i) oacc[db][i] = 0.f;
    { const LAS unsigned char* vbase = ldsV + r * 512 + h2 * 8;
#pragma unroll
      for (int kb = 0; kb < 8; ++kb)
#pragma unroll
        for (int s2 = 0; s2 < 2; ++s2) {
            u32x4 pw; pw.x = pk2(sacc[kb][8 * s2 + 0], sacc[kb][8 * s2 + 1]); pw.y = pk2(sacc[kb][8 * s2 + 2], sacc[kb][8 * s2 + 3]);
            pw.z = pk2(sacc[kb][8 * s2 + 4], sacc[kb][8 * s2 + 5]); pw.w = pk2(sacc[kb][8 * s2 + 6], sacc[kb][8 * s2 + 7]);
            const bf16x8 pf = __builtin_bit_cast(bf16x8, pw);
            const int c0 = 4 * kb + 2 * s2;
#pragma unroll
            for (int db = 0; db < 4; ++db) {
                const u32x2 lo = *(const LAS u32x2*)(vbase + db * 16384 + ((c0 ^ r) << 4)), hi = *(const LAS u32x2*)(vbase + db * 16384 + (((c0 + 1) ^ r) << 4));
                u32x4 vw; vw.x = lo.x; vw.y = lo.y; vw.z = hi.x; vw.w = hi.y;
                oacc[db] = __builtin_amdgcn_mfma_f32_32x32x16_bf16(__builtin_bit_cast(bf16x8, vw), pf, oacc[db], 0, 0, 0);
            }
        } }
    bf16_t* op = OO + (size_t)(tok0 + r) * KBR + h * 128 + 4 * h2;
#pragma unroll
    for (int db = 0; db < 4; ++db)
#pragma unroll
        for (int g = 0; g < 4; ++g) { u32x2 w; w.x = pk2(oacc[db][4 * g] * inv, oacc[db][4 * g + 1] * inv); w.y = pk2(oacc[db][4 * g + 2] * inv, oacc[db][4 * g + 3] * inv);
            *(u32x2*)(op + db * 32 + 8 * g) = w; }
}

#define XB_TMO      128
#define XB_XCNT(j)  (256  + 64 * (j))
#define XB_XSUB(j)  (1280 + 64 * (j))
#define XB_XGEN(j)  (2304 + 64 * (j))
#define XB_TOP      3328
#define XB_TOPGEN   3392
#define XCD_BAR_WORDS 3456
#define XB_SPIN_CAP (1u << 18)

__device__ __forceinline__ unsigned xb_ld(unsigned* p)              { return __hip_atomic_load(p, __ATOMIC_RELAXED, __HIP_MEMORY_SCOPE_AGENT); }
__device__ __forceinline__ unsigned xb_add(unsigned* p, unsigned v) { return __hip_atomic_fetch_add(p, v, __ATOMIC_RELAXED, __HIP_MEMORY_SCOPE_AGENT); }
__device__ __forceinline__ unsigned xb_xcc_id() { return (unsigned)__builtin_amdgcn_s_getreg((3 << 11) | 20) & 0xFu; }
#define XB_SPIN(cond, bar) do { unsigned _sp = 0; while (cond) { __builtin_amdgcn_s_sleep(1); \
    if ((++_sp & 255u) == 0u) { if (xb_ld(&(bar)[XB_TMO])) break; if (_sp > XB_SPIN_CAP) { atomicAdd(&(bar)[XB_TMO], 1u); break; } } } } while (0)

struct XcdBarrier {
    unsigned* bar; unsigned x;
    volatile LAS unsigned* st;
};

__device__ __forceinline__ XcdBarrier xcd_barrier_post(unsigned* bar, volatile LAS unsigned* st) {
    XcdBarrier b; b.bar = bar; b.x = xb_xcc_id(); b.st = st;
    if (threadIdx.x == 0) (void)xb_add(&bar[XB_XCNT(b.x)], 1u);
    return b;
}
__device__ __forceinline__ void xcd_barrier_complete(unsigned* bar, unsigned x, unsigned& nloc, unsigned& nx) {
    const unsigned G = gridDim.x * gridDim.y * gridDim.z;
    unsigned sum, cnt, mine, sp = 0u;
    for (;;) {
        sum = 0u; cnt = 0u; mine = 0u;
#pragma unroll
        for (unsigned j = 0; j < 16; ++j) { const unsigned c = xb_ld(&bar[XB_XCNT(j)]); sum += c; cnt += (c > 0u) ? 1u : 0u; mine = (j == x) ? c : mine; }
        if (sum == G) break;
        __builtin_amdgcn_s_sleep(1);
        if ((++sp & 255u) == 0u) { if (xb_ld(&bar[XB_TMO])) break; if (sp > XB_SPIN_CAP) { atomicAdd(&bar[XB_TMO], 1u); break; } }
    }
    nloc = mine > 0u ? mine : 1u; nx = cnt > 0u ? cnt : 1u;
}

__device__ __forceinline__ void xcd_barrier(const XcdBarrier& b) {
    asm volatile("s_waitcnt vmcnt(0)" ::: "memory");
    __syncthreads();
    if (threadIdx.x == 0) {
        unsigned* bar = b.bar;
        __builtin_amdgcn_s_waitcnt(0);
        unsigned nloc = b.st[0], nx = b.st[1];
        if (nloc == 0u) { xcd_barrier_complete(bar, b.x, nloc, nx); b.st[0] = nloc; b.st[1] = nx; }
        const unsigned old = xb_add(&bar[XB_XSUB(b.x)], 1u);
        const unsigned gen = old / nloc;
        if (old + 1u == (gen + 1u) * nloc) {
            __builtin_amdgcn_fence(__ATOMIC_RELEASE, "agent");
            asm volatile("s_waitcnt vmcnt(0)" ::: "memory");
            const unsigned og = xb_add(&bar[XB_TOP], 1u);
            const unsigned tg = og / nx;
            if (og + 1u == (tg + 1u) * nx) xb_add(&bar[XB_TOPGEN], 1u);
            else XB_SPIN(xb_ld(&bar[XB_TOPGEN]) == tg, bar);
            __builtin_amdgcn_fence(__ATOMIC_ACQUIRE, "agent");
            xb_add(&bar[XB_XGEN(b.x)], 1u);
            asm volatile("s_waitcnt vmcnt(0)" ::: "memory");
        } else {
            XB_SPIN(xb_ld(&bar[XB_XGEN(b.x)]) == gen, bar);
            __builtin_amdgcn_fence(__ATOMIC_ACQUIRE, "agent");
            asm volatile("s_waitcnt vmcnt(0)" ::: "memory");
        }
    }
    __syncthreads();
}


constexpr int NPHASE = 1 + 11 * NLAYER;

__global__ void __launch_bounds__(512, 2) fwd_mega(Params P) {
    extern __shared__ __attribute__((aligned(16))) unsigned char lds_raw[];
    LAS unsigned char* lds = (LAS unsigned char*)lds_raw;
    const int G = gridDim.x, c = blockIdx.x;
    volatile LAS unsigned* bar_st = (volatile LAS unsigned*)(lds + LDS_BYTES - 16);
    if (threadIdx.x == 0) { bar_st[0] = 0u; bar_st[1] = 0u; }
    __syncthreads();
    XcdBarrier gbar = xcd_barrier_post((unsigned*)(P.ws + WS_BAR), bar_st);
#ifdef PROBE_MASK
    unsigned long long pr_acc = 0, pr_t0 = 0;
#endif
    for (int ph = P.ph_lo; ph < P.ph_hi; ++ph) {
#ifdef PROBE_MASK
        if ((PROBE_MASK >> ph) & 1) pr_t0 = wall_clock64();
#endif
        unsigned char* ws = P.ws;
        asm volatile("" : "+s"(ws));
        const char* xb = (const char*)(ws + WS_XB);
        if (ph == 0) {
            if (PHON(0)) setup_phase(P, lds);
            if (PHON(1)) convert_weights(P, 0, lds);
        } else {
            const int l = (ph - 1) / 11, sp = (ph - 1) % 11;
            if (PHON(2) && (sp == 0 || sp == 8)) {
                SchedFfnUp S{xb, (const char*)(ws + (sp == 0 ? WS_W13A : WS_W13B)), G, c};
                EpiSwiGLU E{(bf16_t*)(ws + WS_H)};
                gemm_phase(lds, DM, DM, DM, S, E);
            } else if (PHON(3) && (sp == 1 || sp == 9)) {
                SchedPlain S{(const char*)(ws + WS_H), (const char*)(ws + (sp == 1 ? WS_W2A : WS_W2B)), 64, 8, (size_t)256 * DFF * 2, (size_t)256 * DFF * 2, G, c};
                const float* stats = (const float*)(ws + WS_STATS);
                if (l == 0 && sp == 1) { EpiResid<false, 1> E{P.in[0], P.out, stats, nullptr, nullptr}; gemm_phase(lds, DFF, DFF, DFF, S, E); }
                else {
                    const float* lg = (sp == 1) ? P.in[21] + (size_t)(l - 1) * DM : P.in[17] + (size_t)l * DM;
                    const float* lb = (sp == 1) ? P.in[22] + (size_t)(l - 1) * DM : P.in[18] + (size_t)l * DM;
                    asm volatile("" : "+s"(lg), "+s"(lb), "+s"(stats));
                    EpiResid<true, 1> E{P.out, P.out, stats, lg, lb}; gemm_phase(lds, DFF, DFF, DFF, S, E); }
            } else if (PHON(4) && (sp == 2 || sp == 7 || sp == 10)) {
                const int gi = sp == 2 ? 4 : (sp == 7 ? 17 : 21);
                if (sp == 2) {
                    if (c < 8) { SchedKV S{(const char*)(ws + WS_MEMB), (const char*)(ws + WS_WKV), c}; EpiKV E{(bf16_t*)(ws + WS_KK), (bf16_t*)(ws + WS_VT)}; gemm_phase(lds, DM, DM, DM, S, E); }
                    else ln_fold_phase(P.out, (bf16_t*)(ws + WS_XB), (bf16_t*)(ws + WS_XP), (bf16_t*)(ws + WS_XM), (float*)(ws + WS_STATS), P.in[4] + (size_t)l * DM, P.in[5] + (size_t)l * DM);
                } else
                ln_phase(P.out, (bf16_t*)(ws + WS_XB), (float*)(ws + WS_STATS), P.in[gi] + (size_t)l * DM, P.in[gi + 1] + (size_t)l * DM, sp == 10 && l == NLAYER - 1);
                if (PHON(1) && sp == 10 && l + 1 < NLAYER) convert_weights(P, l + 1, lds);
            } else if (PHON(5) && sp == 3) {
                {
                    const int tid = ltid(), lane = tid & 63, gwv = c * 8 + (tid >> 6);
                    if (gwv < 1024) { const int bb = gwv >> 9, ch = gwv & 511;
                        const u32x4* xr = (const u32x4*)(xb + ((size_t)(bb * SEQ + HSEQ)) * ROWB) + lane; const u32x4* wrow = (const u32x4*)(ws + WS_WFT + (size_t)ch * ROWB) + lane; float sdot = 0.f;
#pragma unroll
                        for (int i = 0; i < 4; ++i) { f32x4 x0, x1, w0, w1; unpack8(xr[64 * i], x0, x1); unpack8(wrow[64 * i], w0, w1);
                            sdot += (x0[0] * w0[0] + x0[1] * w0[1]) + (x0[2] * w0[2] + x0[3] * w0[3]) + (x1[0] * w1[0] + x1[1] * w1[1]) + (x1[2] * w1[2] + x1[3] * w1[3]); }
                        sdot = wave_sum(sdot);
                        if (lane == 0) ((float*)(ws + WS_UH))[gwv] = (sdot + ((const float*)(ws + WS_BIAST))[ch]) * 0.011048543456039806f; }
                }
                SchedWin S{xb, (const char*)(ws + WS_WIN), (const char*)(ws + WS_WFT), (const char*)(ws + WS_XP), (const char*)(ws + WS_XM), G, c};
                EpiWin E{P.in[7] + (size_t)l * DIN, (const float*)(ws + WS_BIAST), (bf16_t*)(ws + WS_GLU), (bf16_t*)(ws + WS_Q), (bf16_t*)(ws + WS_G), (bf16_t*)(ws + WS_TT)};
                gemm_phase(lds, DM, DM, DM, S, E);
            } else if (sp == 4) {
                if (PHON(6)) { SchedDft S{(const char*)(ws + WS_CM), (const char*)(ws + WS_TT), G, c};
                  EpiDft E{(bf16_t*)(ws + WS_BR) + 1024, (const float*)(ws + WS_UH)};
                  gemm_phase(lds, HSEQ, HSEQ, SEQ, S, E); }
                const int half = G >> 1, hi = (c >= half) ? 1 : 0, cc = c - hi * half;
                if (hi) {
                    const int tid = ltid(), lane = tid & 63, gwv = cc * 8 + (tid >> 6);
                    if (gwv < 1024) { const int bb = gwv >> 9, ch = gwv & 511;
                        const u32x4* tr = (const u32x4*)(ws + WS_TT + ((size_t)ch * SEQ + (size_t)bb * HSEQ) * 2) + lane; float sa = 0.f;
#pragma unroll
                        for (int i = 0; i < 8; ++i) { f32x4 x0, x1; unpack8(tr[64 * i], x0, x1); sa += (x0[0] - x0[1]) + (x0[2] - x0[3]) + (x1[0] - x1[1]) + (x1[2] - x1[3]); }
                        sa = wave_sum(sa);
                        if (lane == 0) { bf16_t* orow = (bf16_t*)(ws + WS_BR) + (size_t)(bb * SEQ + HSEQ) * KBR; orow[1024 + ch] = f2bf(sa * 0.011048543456039806f + ((const float*)(ws + WS_UH))[gwv]); orow[1536 + ch] = 0; } }
                }
                if (PHON(7)) { const int nct = hi ? 6 : 2, ct0 = hi ? 2 * half : 0;
                    for (int j = 0; j < nct; ++j)
                        conv_tile((const bf16_t*)(ws + WS_GLU), (bf16_t*)(ws + WS_BR), P.in[8] + (size_t)l * 31 * 1024, P.in[9] + (size_t)l * 1024, P.in[10] + (size_t)l * 1024, P.in[11] + (size_t)l * 1024, ct0 + cc + half * j, lds); }
                if (PHON(8) && hi) for (int j = 0; j < 2; ++j) { const int t = cc + half * j;
                    attn_unit((const bf16_t*)(ws + WS_Q), (const bf16_t*)(ws + WS_KK), (const bf16_t*)(ws + WS_VT), (bf16_t*)(ws + WS_BR) + 2048, t >> 7, (t >> 5) & 3, t & 31, lds); }
                __syncthreads();
            } else if (PHON(9) && sp == 5) {
                SchedPlain S{(const char*)(ws + WS_BR), (const char*)(ws + WS_WBR), 64, 8, (size_t)256 * KBR * 2, (size_t)256 * KBR * 2, G, c};
                EpiBranchFused E{(const bf16_t*)(ws + WS_G), (bf16_t*)(ws + WS_MG)};
                gemm_phase(lds, KBR, KBR, KBR, S, E);
            } else if (PHON(10) && sp == 6) {
                SchedPlain S{(const char*)(ws + WS_MG), (const char*)(ws + WS_WOUT), 64, 8, (size_t)256 * DM * 2, (size_t)256 * DM * 2, G, c};
                const float* stats = (const float*)(ws + WS_STATS); const float* lg = P.in[4] + (size_t)l * DM; const float* lb = P.in[5] + (size_t)l * DM;
                asm volatile("" : "+s"(lg), "+s"(lb), "+s"(stats));
                EpiResid<true, 2> E{P.out, P.out, stats, lg, lb};
                gemm_phase(lds, DM, DM, DM, S, E);
            }
        }
        if (ph + 1 < P.ph_hi) { if (P.ph_lo < 0) cg::this_grid().sync(); else xcd_barrier(gbar); }
#ifdef PROBE_MASK
        if ((PROBE_MASK >> ph) & 1) pr_acc += wall_clock64() - pr_t0;
#endif
    }
#ifdef PROBE_MASK
    if (c == 0) { const unsigned long long t0 = wall_clock64(); while (wall_clock64() - t0 < (unsigned long long)PROBE_MULT * pr_acc) __builtin_amdgcn_s_sleep(32); }
#endif
}

extern "C" void kernel_launch(void* const* d_in, const int* in_sizes, int n_in, void* d_out, int out_size, void* d_ws, size_t ws_size, hipStream_t stream) {
    static int grid = 0;
    if (grid == 0) {
        if (n_in != 23 || out_size != NTOK * DM || ws_size < WS_END) { fprintf(stderr, "kernel_launch: unexpected shapes (n_in %d, out %d, ws %zu < %zu)\n", n_in, out_size, ws_size, (size_t)WS_END); grid = -1; return; }
        int dev = 0, cus = 0, per_cu = 0;
        hipGetDevice(&dev);
        hipDeviceGetAttribute(&cus, hipDeviceAttributeMultiprocessorCount, dev);
        hipFuncSetAttribute((const void*)fwd_mega, hipFuncAttributeMaxDynamicSharedMemorySize, LDS_BYTES);
        hipOccupancyMaxActiveBlocksPerMultiprocessor(&per_cu, (const void*)fwd_mega, 512, LDS_BYTES);
        if (per_cu < 1) { fprintf(stderr, "kernel_launch: occupancy query says %d blocks per CU\n", per_cu); per_cu = 1; }
        (void)hipGetLastError();
        grid = cus;
    }
    if (grid < 0) return;
    Params p{};
    for (int i = 0; i < 23; ++i) p.in[i] = (const float*)d_in[i];
    p.out = (float*)d_out; p.ws = (unsigned char*)d_ws;
#if ONE_LAUNCH
    hipMemsetAsync((unsigned char*)d_ws + WS_BAR, 0, XCD_BAR_WORDS * sizeof(unsigned), stream);
    p.ph_lo = 0; p.ph_hi = NPHASE;
    void* args[] = {&p};
    hipError_t e = hipLaunchCooperativeKernel((const void*)fwd_mega, dim3(grid), dim3(512), args, LDS_BYTES, stream);
    if (e != hipSuccess) fprintf(stderr, "cooperative launch failed: %s (grid %d)\n", hipGetErrorString(e), grid);
#else
    for (int ph = 0; ph < NPHASE; ++ph) { p.ph_lo = ph; p.ph_hi = ph + 1; hipLaunchKernelGGL(fwd_mega, dim3(grid), dim3(512), LDS_BYTES, stream, p); }
#endif
}
```

```cpp
#include <hip/hip_runtime.h>
#include <hip/hip_cooperative_groups.h>
#include <cstdio>
namespace cg = cooperative_groups;

#ifndef PH_MASK
#define PH_MASK 0xFFFF
#endif
#define PHON(k) ((PH_MASK >> (k)) & 1)
#ifndef ONE_LAUNCH
#define ONE_LAUNCH 1
#endif

#define LAS __attribute__((address_space(3)))
#define DI __device__ __forceinline__
typedef unsigned short bf16_t;
typedef short bf16x8 __attribute__((ext_vector_type(8)));
typedef float f32x4 __attribute__((ext_vector_type(4)));
typedef float f32x2 __attribute__((ext_vector_type(2)));
typedef float f32x16 __attribute__((ext_vector_type(16)));
typedef unsigned u32x4 __attribute__((ext_vector_type(4)));
typedef unsigned u32x2 __attribute__((ext_vector_type(2)));
typedef __bf16 bf16x2_t __attribute__((ext_vector_type(2)));

constexpr int NTOK = 16384, DM = 2048, DFF = 5632, DIN = 9216, SEQ = 8192, NLAYER = 2;
constexpr float DN_ALPHA = 1.4142135623730951f;
constexpr float LN_EPS = 1e-5f;

constexpr int HSEQ = SEQ / 2;
constexpr size_t WS_CM    = 0;
constexpr size_t CM_HALF  = (size_t)HSEQ * HSEQ * 2;
constexpr size_t WS_XB    = WS_CM + 2 * CM_HALF;
constexpr size_t WS_MEMB  = WS_XB + (size_t)NTOK * DM * 2;
constexpr size_t WS_XP    = WS_MEMB + (size_t)512 * DM * 2;
constexpr size_t WS_XM    = WS_XP + (size_t)2 * HSEQ * DM * 2;
constexpr size_t WS_W13A  = WS_XM + (size_t)2 * HSEQ * DM * 2;
constexpr size_t WS_W2A   = WS_W13A + (size_t)2 * DFF * DM * 2;
constexpr size_t WS_W13B  = WS_W2A + (size_t)DM * DFF * 2;
constexpr size_t WS_W2B   = WS_W13B + (size_t)2 * DFF * DM * 2;
constexpr size_t WS_WIN   = WS_W2B + (size_t)DM * DFF * 2;
constexpr size_t WS_WFT   = WS_WIN + (size_t)DIN * DM * 2;
constexpr int KBR = 2560;
constexpr size_t WS_WBR   = WS_WFT + (size_t)1024 * DM * 2;
constexpr size_t WS_WKV   = WS_WBR + (size_t)DM * KBR * 2;
constexpr size_t WS_WOUT  = WS_WKV + (size_t)1024 * DM * 2;
constexpr size_t WS_BIAST = WS_WOUT + (size_t)DM * DM * 2;
constexpr size_t WS_STATS = WS_BIAST + 4096;
constexpr size_t WS_BAR   = WS_STATS + (size_t)NTOK * 8;
constexpr size_t WS_UH    = WS_BAR + 16384;
constexpr size_t WS_KK    = WS_UH + 4096;
constexpr size_t WS_VT    = WS_KK + (size_t)512 * 512 * 2;
constexpr size_t WS_MIX   = WS_VT + (size_t)512 * 512 * 2;
constexpr size_t WS_G     = WS_MIX;
constexpr size_t WS_GLU   = WS_G + (size_t)NTOK * 6144 * 2;
constexpr size_t WS_TT    = WS_GLU + (size_t)NTOK * 1024 * 2;
constexpr size_t WS_MG    = WS_GLU;
constexpr size_t WS_Q     = WS_TT + (size_t)1024 * NTOK * 2;
constexpr size_t WS_BR    = WS_Q + (size_t)NTOK * 512 * 2;
constexpr size_t WS_END   = WS_BR + (size_t)NTOK * KBR * 2;
constexpr size_t WS_H     = WS_MIX;
static_assert((size_t)NTOK * DFF * 2 <= WS_END - WS_MIX, "H must fit the union region");

constexpr int LDS_BYTES = 131072 + 4096;

DI int ltid() { int t = threadIdx.x; asm volatile("" : "+v"(t)); return t; }
DI unsigned pk2(float a, float b) { f32x2 v = {a, b}; bf16x2_t r = __builtin_convertvector(v, bf16x2_t); return __builtin_bit_cast(unsigned, r); }
DI bf16_t f2bf(float a) { return (bf16_t)(pk2(a, 0.f) & 0xffffu); }
DI float sigmoidf_fast(float x) { return __builtin_amdgcn_rcpf(1.0f + __expf(-x)); }
DI float wave_sum(float v) {
#pragma unroll
    for (int o = 1; o < 64; o <<= 1) v += __shfl_xor(v, o);
    return v;
}
DI u32x4 pack8(const f32x4 v0, const f32x4 v1) { u32x4 w; w.x = pk2(v0[0], v0[1]); w.y = pk2(v0[2], v0[3]); w.z = pk2(v1[0], v1[1]); w.w = pk2(v1[2], v1[3]); return w; }
DI void unpack8(const u32x4 w, f32x4& v0, f32x4& v1) {
    v0[0] = __uint_as_float(w.x << 16); v0[1] = __uint_as_float(w.x & 0xffff0000u); v0[2] = __uint_as_float(w.y << 16); v0[3] = __uint_as_float(w.y & 0xffff0000u);
    v1[0] = __uint_as_float(w.z << 16); v1[1] = __uint_as_float(w.z & 0xffff0000u); v1[2] = __uint_as_float(w.w << 16); v1[3] = __uint_as_float(w.w & 0xffff0000u);
}

constexpr int BK = 64, HALF = 128, HTB = HALF * BK * 2;
DI int lds_byte(int r, int c) { const int st = (r >> 4) * 2 + (c >> 5), rr = r & 15, cc = c & 31, ob = rr * 64 + cc * 2; return st * 1024 + (ob ^ (((ob >> 9) & 1) << 5)); }
DI void stage_rc(int b, int& R, int& C) { const int st = b / 1024, sb = b % 1024, swz = sb ^ (((sb >> 9) & 1) << 5); R = (st >> 1) * 16 + swz / 64; C = (st & 1) * 32 + (swz % 64) / 2; }
DI int perm32(int rho) { const int n = rho >> 4, i = rho & 15; return 8 * (i >> 2) + 4 * n + (i & 3); }

struct Unit { const char* A; const char* B0; const char* B1; int kind, pm, pn; };

DI void tile_decode(int wgid, int nM, int nN, int& pm, int& pn) {
    const int nwg = nM * nN;
    { const int q = nwg / 8, r = nwg % 8, xcd = wgid % 8, off = wgid / 8; wgid = (xcd < r ? xcd * (q + 1) : r * (q + 1) + (xcd - r) * q) + off; }
    const int nig = 8 * nN, gid = wgid / nig, fm = gid * 8, gsz = (nM - fm) < 8 ? (nM - fm) : 8;
    pm = fm + ((wgid % nig) % gsz); pn = (wgid % nig) / gsz;
}

template <class Epi, class Sched>
DI void gemm_phase(LAS unsigned char* lds, const int K, const int lda, const int ldb, const Sched& S, const Epi& E) {
    const int tid = ltid(), wid = __builtin_amdgcn_readfirstlane(tid >> 6), lane = tid & 63, wr = wid >> 2, wc = wid & 3, fr = lane & 15, fq = lane >> 4;
    const int nt = K / BK;
    unsigned voffA[2], voffB[2];
#pragma unroll
    for (int i = 0; i < 2; ++i) { int R, C; stage_rc(tid * 16 + i * 8192, R, C); const int Rb = Epi::PERM ? ((R & ~31) + perm32(R & 31)) : R;
        voffA[i] = (unsigned)(R * lda + C) * 2u; voffB[i] = (unsigned)(Rb * ldb + C) * 2u; }
    const size_t kstep = (size_t)(BK * 2);
    const size_t hstepA = (size_t)HALF * lda * 2;
    const unsigned ldsw = (unsigned)wid * 1024u;
    const int aoff = lds_byte(wr * 64 + fr, fq * 8), boff = lds_byte(wc * 32 + fr, fq * 8);
#define G_SA(b, h) (((b) * 2 + (h)) * HTB)
#define G_SB(b, h) ((4 + (b) * 2 + (h)) * HTB)
#define G_STAGE(bufoff, gbase, voff) do { _Pragma("unroll") for (int _i = 0; _i < 2; ++_i) \
        __builtin_amdgcn_global_load_lds((const unsigned*)((const char*)(gbase) + (voff)[_i]), (LAS unsigned*)(lds + (bufoff) + ldsw + _i * 8192), 16, 0, 0); } while (0)
#define G_LDA(dst, b, h) do { _Pragma("unroll") for (int m = 0; m < 4; ++m) _Pragma("unroll") for (int k = 0; k < 2; ++k) dst[m][k] = *(const LAS bf16x8*)(lds + G_SA(b, h) + aoff + m * 2048 + k * 1024); } while (0)
#define G_LDB(dst, b, h) do { _Pragma("unroll") for (int n = 0; n < 2; ++n) _Pragma("unroll") for (int k = 0; k < 2; ++k) dst[n][k] = *(const LAS bf16x8*)(lds + G_SB(b, h) + boff + n * 2048 + k * 1024); } while (0)
#define G_MMA(ai, bj, At, Bt) do { __builtin_amdgcn_s_setprio(1); _Pragma("unroll") for (int m = 0; m < 4; ++m) _Pragma("unroll") for (int n = 0; n < 2; ++n) _Pragma("unroll") for (int k = 0; k < 2; ++k) \
        acc[ai][bj][m][n] = __builtin_amdgcn_mfma_f32_16x16x32_bf16(Bt[n][k], At[m][k], acc[ai][bj][m][n], 0, 0, 0); __builtin_amdgcn_s_setprio(0); } while (0)
#define G_WAIT_V(n) asm volatile("s_waitcnt vmcnt(" #n ")" ::: "memory")
#define G_WAIT_L(n) asm volatile("s_waitcnt lgkmcnt(" #n ")" ::: "memory")
#define G_BAR __builtin_amdgcn_s_barrier()
#define G_SCHED __builtin_amdgcn_sched_barrier(0)
    Unit cur, nxt; int ui = 0;
    if (!S.next(0, cur)) return;
    f32x4 acc[2][2][4][2];
#pragma unroll
    for (int a = 0; a < 2; ++a)
#pragma unroll
        for (int b = 0; b < 2; ++b)
#pragma unroll
            for (int m = 0; m < 4; ++m)
#pragma unroll
                for (int n = 0; n < 2; ++n) acc[a][b][m][n] = (f32x4){0.f, 0.f, 0.f, 0.f};
    bf16x8 At[4][2], B0[2][2], B1[2][2];
    const char* cA = cur.A; const char* cB0 = cur.B0; const char* cB1 = cur.B1;
    G_STAGE(G_SB(0, 0), cB0, voffB); G_STAGE(G_SA(0, 0), cA, voffA); G_STAGE(G_SB(0, 1), cB1, voffB); G_STAGE(G_SA(0, 1), cA + hstepA, voffA);
    if (wr == 1) G_BAR;
    G_WAIT_V(4); G_BAR;
    G_STAGE(G_SB(1, 0), cB0 + kstep, voffB); G_STAGE(G_SA(1, 0), cA + kstep, voffA); G_STAGE(G_SB(1, 1), cB1 + kstep, voffB);
    G_WAIT_V(6); G_BAR;
    for (;;) {
        const bool has_next = S.next(ui + 1, nxt);
        const char* nA = has_next ? nxt.A : cA; const char* nB0 = has_next ? nxt.B0 : cB0; const char* nB1 = has_next ? nxt.B1 : cB1;
        for (int t = 0; t < nt; t += 2) {
            const bool last = (t == nt - 2);
            const char* a1 = cA + (size_t)(t + 1) * kstep;
            const char* a2 = last ? nA : cA + (size_t)(t + 2) * kstep;
            const char* b20 = last ? nB0 : cB0 + (size_t)(t + 2) * kstep;
            const char* b21 = last ? nB1 : cB1 + (size_t)(t + 2) * kstep;
            const char* a3 = a2 + kstep; const char* b30 = b20 + kstep; const char* b31 = b21 + kstep;
            if constexpr (Epi::NHOOK > 0) { if (t == Epi::HK1 || t == Epi::HK2) E.hook(acc, cur, t, wr, wc, fr, fq); }
            G_LDB(B0, 0, 0); G_SCHED; G_LDA(At, 0, 0); G_STAGE(G_SA(1, 1), a1 + hstepA, voffA);
            G_WAIT_L(8); G_BAR; G_WAIT_L(0); G_MMA(0, 0, At, B0); G_BAR; G_SCHED;
            G_LDB(B1, 0, 1); G_STAGE(G_SB(0, 0), b20, voffB);
            G_BAR; G_WAIT_L(0); G_MMA(0, 1, At, B1); G_BAR;
            G_LDA(At, 0, 1); G_STAGE(G_SA(0, 0), a2, voffA);
            G_BAR; G_WAIT_L(0); G_MMA(1, 0, At, B0); G_BAR; G_SCHED;
            G_STAGE(G_SB(0, 1), b21, voffB);
            G_WAIT_V(6); G_BAR; G_MMA(1, 1, At, B1); G_BAR;
            G_LDB(B0, 1, 0); G_SCHED; G_LDA(At, 1, 0); G_STAGE(G_SA(0, 1), a2 + hstepA, voffA);
            G_WAIT_L(8); G_BAR; G_WAIT_L(0); G_MMA(0, 0, At, B0); G_BAR; G_SCHED;
            G_LDB(B1, 1, 1); G_STAGE(G_SB(1, 0), b30, voffB);
            G_BAR; G_WAIT_L(0); G_MMA(0, 1, At, B1); G_BAR;
            G_LDA(At, 1, 1); G_STAGE(G_SA(1, 0), a3, voffA);
            G_BAR; G_WAIT_L(0); G_MMA(1, 0, At, B0); G_BAR; G_SCHED;
            G_STAGE(G_SB(1, 1), b31, voffB);
            G_WAIT_V(6); G_BAR; G_MMA(1, 1, At, B1); G_BAR;
        }
        E(acc, cur, wr, wc, fr, fq);
        if (!has_next) break;
#pragma unroll
        for (int a = 0; a < 2; ++a)
#pragma unroll
            for (int b = 0; b < 2; ++b)
#pragma unroll
                for (int m = 0; m < 4; ++m)
#pragma unroll
                    for (int n = 0; n < 2; ++n) acc[a][b][m][n] = (f32x4){0.f, 0.f, 0.f, 0.f};
        cur = nxt; cA = nA; cB0 = nB0; cB1 = nB1; ++ui;
    }
    G_WAIT_V(0);
    if (wr == 0) G_BAR;
    G_BAR;
#undef G_SA
#undef G_SB
#undef G_STAGE
#undef G_LDA
#undef G_LDB
#undef G_MMA
#undef G_WAIT_V
#undef G_WAIT_L
#undef G_BAR
#undef G_SCHED
}

constexpr size_t ROWB = (size_t)DM * 2;
struct SchedFfnUp {
    const char* A; const char* B; int G, c;
    DI bool next(int i, Unit& u) const { const int L = i * G + c; if (L >= 64 * 44) return false; int pm, pn; tile_decode(L, 64, 44, pm, pn);
        u.A = A + (size_t)pm * 256 * ROWB; u.B0 = B + (size_t)pn * 128 * ROWB; u.B1 = u.B0 + (size_t)DFF * ROWB; u.kind = 0; u.pm = pm; u.pn = pn; return true; }
};
struct SchedPlain {
    const char* A; const char* B; int nM, nN; size_t astep, bstep; int G, c;
    DI bool next(int i, Unit& u) const { const int L = i * G + c; if (L >= nM * nN) return false; int pm, pn;
        if (nN == 8 && G == 256 && (nM & 31) == 0) { const int x = c & 7, r = c >> 3; pm = 32 * i + 4 * x + (r >> 3); pn = r & 7; }
        else tile_decode(L, nM, nN, pm, pn);
        u.A = A + (size_t)pm * astep; u.B0 = B + (size_t)pn * bstep; u.B1 = u.B0 + (bstep >> 1); u.kind = 0; u.pm = pm; u.pn = pn; return true; }
};
struct SchedWin {
    const char* xb; const char* win; const char* wft; const char* xp; const char* xm; int G, c;
    DI bool next(int i, Unit& u) const {
        int L = i * G + c; int pm, pn;
        if (L < 2176) { tile_decode(L, 64, 34, pm, pn); u.A = xb + (size_t)pm * 256 * ROWB; u.pm = pm;
            if (pn < 8) { u.kind = 0; u.pn = pn; u.B0 = win + (size_t)(pn * 128) * ROWB; u.B1 = win + (size_t)(1024 + pn * 128) * ROWB; }
            else if (pn < 10) { u.kind = 1; u.pn = pn - 8; u.B0 = win + (size_t)(2560 + 256 * (pn - 8)) * ROWB; u.B1 = u.B0 + 128 * ROWB; }
            else { u.kind = 2; u.pn = pn - 10; u.B0 = win + (size_t)(3072 + 256 * (pn - 10)) * ROWB; u.B1 = u.B0 + 128 * ROWB; }
            return true; }
        L -= 2176;
        if (L < 128) { tile_decode(L, 4, 32, pm, pn); u.kind = 3; u.pm = pm; u.pn = pn; u.A = wft + (size_t)pm * 256 * ROWB;
            u.B0 = (pm < 2 ? xp : xm) + (size_t)pn * 256 * ROWB; u.B1 = u.B0 + 128 * ROWB; return true; }
        return false;
    }
};
struct SchedKV {
    const char* memb; const char* wkv; int c;
    DI bool next(int i, Unit& u) const {
        if (i > 0 || c >= 8) return false; int pm, pn; tile_decode(c & 3, 2, 2, pm, pn); u.pm = pm; u.pn = pn;
        if (c < 4) { u.kind = 4; u.A = memb + (size_t)pm * 256 * ROWB; u.B0 = wkv + (size_t)pn * 256 * ROWB; }
        else { u.kind = 5; u.A = wkv + (size_t)(512 + pm * 256) * ROWB; u.B0 = memb + (size_t)pn * 256 * ROWB; }
        u.B1 = u.B0 + 128 * ROWB; return true; }
};
struct SchedDft {
    const char* cm; const char* tt; int G, c;
    DI bool next(int i, Unit& u) const { const int L = i * G + c; if (L >= 128) return false; int pm, pn8; tile_decode(L, 16, 8, pm, pn8);
        const int b = pn8 >> 2, p = (pn8 >> 1) & 1, pn = pn8 & 1;
        u.A = cm + (size_t)p * CM_HALF + (size_t)pm * 256 * HSEQ * 2; u.B0 = tt + ((size_t)(p * 512 + pn * 256) * SEQ + (size_t)b * HSEQ) * 2; u.B1 = u.B0 + (size_t)128 * SEQ * 2;
        u.kind = p; u.pm = b * 32 + pm; u.pn = p * 2 + pn; return true; }
};

template <int ACT>
DI void store_tile_bf16(const f32x4 (&acc)[2][2][4][2], bf16_t* out, size_t ld, int row0, int col0, const float* colbias, const float* rowbias, float scale, float cbs = 1.0f) {
    f32x4 cb[2][2];
#pragma unroll
    for (int bj = 0; bj < 2; ++bj)
#pragma unroll
        for (int n = 0; n < 2; ++n) cb[bj][n] = colbias ? *(const f32x4*)(colbias + col0 + bj * HALF + 4 * n) * cbs : (f32x4){0.f, 0.f, 0.f, 0.f};
#pragma unroll
    for (int ai = 0; ai < 2; ++ai)
#pragma unroll
        for (int m = 0; m < 4; ++m) { const int row = row0 + ai * HALF + m * 16; const float rb = rowbias ? rowbias[row] : 0.f; bf16_t* rp = out + (size_t)row * ld + col0;
#pragma unroll
            for (int bj = 0; bj < 2; ++bj) { f32x4 v0 = (acc[ai][bj][m][0] + cb[bj][0] + rb) * scale, v1 = (acc[ai][bj][m][1] + cb[bj][1] + rb) * scale;
                if (ACT == 1) {
#pragma unroll
                    for (int j = 0; j < 4; ++j) { v0[j] = sigmoidf_fast(v0[j]); v1[j] = sigmoidf_fast(v1[j]); } }
                *(u32x4*)(rp + bj * HALF) = pack8(v0, v1); } }
}
struct EpiSwiGLU {
    static constexpr bool PERM = true; static constexpr int NHOOK = 0; bf16_t* H;
    DI void operator()(const f32x4 (&acc)[2][2][4][2], const Unit& u, int wr, int wc, int fr, int fq) const {
        const int row0 = u.pm * 256 + wr * 64 + fr, col0 = u.pn * 128 + wc * 32 + 8 * fq;
#pragma unroll
        for (int ai = 0; ai < 2; ++ai)
#pragma unroll
            for (int m = 0; m < 4; ++m) { f32x4 v[2];
#pragma unroll
                for (int n = 0; n < 2; ++n) { const f32x4 a = acc[ai][0][m][n], g = acc[ai][1][m][n];
#pragma unroll
                    for (int j = 0; j < 4; ++j) v[n][j] = a[j] * g[j] * sigmoidf_fast(g[j]); }
                *(u32x4*)(H + (size_t)(row0 + ai * HALF + m * 16) * DFF + col0) = pack8(v[0], v[1]); }
    }
};
template <bool LNSRC, int BETA2> struct EpiResid {
    static constexpr bool PERM = false; static constexpr int NHOOK = 0; static constexpr float alpha = DN_ALPHA, beta = 0.5f * BETA2; const float* src; float* dst; const float* stats; const float* lng; const float* lnb;
    DI void operator()(const f32x4 (&acc)[2][2][4][2], const Unit& u, int wr, int wc, int fr, int fq) const {
        const int row0 = u.pm * 256 + wr * 64 + fr, col0 = u.pn * 256 + wc * 32 + 4 * fq;
        if constexpr (LNSRC) {
            const f32x4 g00 = *(const f32x4*)(lng + col0) * alpha, g01 = *(const f32x4*)(lng + col0 + 16) * alpha, g10 = *(const f32x4*)(lng + col0 + HALF) * alpha, g11 = *(const f32x4*)(lng + col0 + HALF + 16) * alpha;
            const f32x4 b00 = *(const f32x4*)(lnb + col0) * alpha, b01 = *(const f32x4*)(lnb + col0 + 16) * alpha, b10 = *(const f32x4*)(lnb + col0 + HALF) * alpha, b11 = *(const f32x4*)(lnb + col0 + HALF + 16) * alpha;
#pragma unroll
            for (int ai = 0; ai < 2; ++ai)
#pragma unroll
                for (int mp = 0; mp < 2; ++mp) { f32x4 sv[2][4]; float mean[2], rstd[2];
#pragma unroll
                    for (int mm = 0; mm < 2; ++mm) { const int row = row0 + ai * HALF + (2 * mp + mm) * 16; const size_t off = (size_t)row * DM + col0;
                        mean[mm] = stats[2 * row]; rstd[mm] = stats[2 * row + 1];
                        sv[mm][0] = *(const f32x4*)(src + off); sv[mm][1] = *(const f32x4*)(src + off + 16); sv[mm][2] = *(const f32x4*)(src + off + HALF); sv[mm][3] = *(const f32x4*)(src + off + HALF + 16); }
#pragma unroll
                    for (int mm = 0; mm < 2; ++mm) { const int m = 2 * mp + mm; const size_t off = (size_t)(row0 + ai * HALF + m * 16) * DM + col0;
                        *(f32x4*)(dst + off) = (sv[mm][0] - mean[mm]) * rstd[mm] * g00 + b00 + acc[ai][0][m][0] * beta;
                        *(f32x4*)(dst + off + 16) = (sv[mm][1] - mean[mm]) * rstd[mm] * g01 + b01 + acc[ai][0][m][1] * beta;
                        *(f32x4*)(dst + off + HALF) = (sv[mm][2] - mean[mm]) * rstd[mm] * g10 + b10 + acc[ai][1][m][0] * beta;
                        *(f32x4*)(dst + off + HALF + 16) = (sv[mm][3] - mean[mm]) * rstd[mm] * g11 + b11 + acc[ai][1][m][1] * beta; }
                    asm volatile("" ::: "memory"); }
        } else {
#pragma unroll
            for (int ai = 0; ai < 2; ++ai)
#pragma unroll
                for (int m = 0; m < 4; ++m) { const size_t off = (size_t)(row0 + ai * HALF + m * 16) * DM + col0;
#pragma unroll
                    for (int bj = 0; bj < 2; ++bj)
#pragma unroll
                        for (int n = 0; n < 2; ++n) { const f32x4 sv = *(const f32x4*)(src + off + bj * HALF + n * 16); *(f32x4*)(dst + off + bj * HALF + n * 16) = sv * alpha + acc[ai][bj][m][n] * beta; }
                    asm volatile("" ::: "memory"); }
        }
    }
};
struct EpiWin {
    static constexpr bool PERM = true; static constexpr int NHOOK = 0;
    const float* bin; const float* biasT; bf16_t *GLU, *Q, *Gt, *TT;
    DI void operator()(const f32x4 (&acc)[2][2][4][2], const Unit& u, int wr, int wc, int fr, int fq) const {
        const int row0 = u.pm * 256 + wr * 64 + fr, cin = wc * 32 + 8 * fq;
        if (u.kind == 0) {
            const int col0 = u.pn * 128 + cin; f32x4 bv[2], bg[2];
#pragma unroll
            for (int n = 0; n < 2; ++n) { bv[n] = *(const f32x4*)(bin + col0 + 4 * n); bg[n] = *(const f32x4*)(bin + 1024 + col0 + 4 * n); }
#pragma unroll
            for (int ai = 0; ai < 2; ++ai)
#pragma unroll
                for (int m = 0; m < 4; ++m) { f32x4 v[2];
#pragma unroll
                    for (int n = 0; n < 2; ++n) { const f32x4 a = acc[ai][0][m][n] + bv[n], g = acc[ai][1][m][n] + bg[n];
#pragma unroll
                        for (int j = 0; j < 4; ++j) v[n][j] = a[j] * sigmoidf_fast(g[j]); }
                    *(u32x4*)(GLU + (size_t)(row0 + ai * HALF + m * 16) * 1024 + col0) = pack8(v[0], v[1]); }
        } else if (u.kind == 1) store_tile_bf16<0>(acc, Q, 512, row0, u.pn * 256 + cin, bin + 2560, nullptr, 0.08838834764831845f);
        else if (u.kind == 2) store_tile_bf16<1>(acc, Gt, 6144, row0, u.pn * 256 + cin, bin + 3072, nullptr, 1.0f);
        else {
            const bool cosr = u.pm < 2; const int col0 = u.pn * 256 + cin;
#pragma unroll
            for (int ai = 0; ai < 2; ++ai)
#pragma unroll
                for (int m = 0; m < 4; ++m) { const int row = row0 + ai * HALF + m * 16; const float rb = cosr ? biasT[row] : 0.f;
#pragma unroll
                    for (int bj = 0; bj < 2; ++bj) { f32x4 v0 = acc[ai][bj][m][0] + 2.0f * rb, v1 = acc[ai][bj][m][1] + 2.0f * rb;
                        if (((col0 + bj * HALF) & (HSEQ - 1)) == 0) v0[0] -= rb;
                        *(u32x4*)(TT + (size_t)row * SEQ + col0 + bj * HALF) = pack8(v0, v1); } }
        }
    }
};
struct EpiKV {
    static constexpr bool PERM = true; static constexpr int NHOOK = 0; bf16_t *KK, *VT;
    DI void operator()(const f32x4 (&acc)[2][2][4][2], const Unit& u, int wr, int wc, int fr, int fq) const {
        store_tile_bf16<0>(acc, u.kind == 4 ? KK : VT, 512, u.pm * 256 + wr * 64 + fr, u.pn * 256 + wc * 32 + 8 * fq, nullptr, nullptr, 1.0f);
    }
};
struct EpiDft {
    static constexpr bool PERM = true; static constexpr int NHOOK = 0; bf16_t* out; const float* uh;
    DI void operator()(const f32x4 (&acc)[2][2][4][2], const Unit& u, int wr, int wc, int fr, int fq) const {
        const int b = u.pm >> 5, k0 = (u.pm & 31) * 256 + wr * 64 + fr, col0 = u.pn * 256 + wc * 32 + 8 * fq;
        const float sgn = (fr & 1) ? -1.0f : 1.0f; const unsigned flip = u.kind ? 0x80008000u : 0u;
        f32x4 cb[2][2];
#pragma unroll
        for (int bj = 0; bj < 2; ++bj)
#pragma unroll
            for (int n = 0; n < 2; ++n) cb[bj][n] = (u.kind == 0) ? *(const f32x4*)(uh + b * 512 + col0 + bj * HALF + 4 * n) * sgn : (f32x4){0.f, 0.f, 0.f, 0.f};
#pragma unroll
        for (int ai = 0; ai < 2; ++ai)
#pragma unroll
            for (int m = 0; m < 4; ++m) { const int k = k0 + ai * HALF + m * 16;
                bf16_t* rp = out + (size_t)(b * SEQ + k) * KBR + col0; bf16_t* rq = out + (size_t)(b * SEQ + SEQ - k) * KBR + col0;
#pragma unroll
                for (int bj = 0; bj < 2; ++bj) { u32x4 w = pack8(acc[ai][bj][m][0] + cb[bj][0], acc[ai][bj][m][1] + cb[bj][1]);
                    *(u32x4*)(rp + bj * HALF) = w;
                    if (k != 0) { w.x ^= flip; w.y ^= flip; w.z ^= flip; w.w ^= flip; *(u32x4*)(rq + bj * HALF) = w; } } }
    }
};
struct EpiPlainBf16 {
    static constexpr bool PERM = true; static constexpr int NHOOK = 0; bf16_t* out; int ld;
    DI void operator()(const f32x4 (&acc)[2][2][4][2], const Unit& u, int wr, int wc, int fr, int fq) const {
        store_tile_bf16<0>(acc, out, (size_t)ld, u.pm * 256 + wr * 64 + fr, u.pn * 256 + wc * 32 + 8 * fq, nullptr, nullptr, 1.0f);
    }
};
struct EpiBranchFused {
    static constexpr bool PERM = true; static constexpr int NHOOK = 2, HK1 = 16, HK2 = 32; const bf16_t* Gt; bf16_t* MG;
    DI void hook(f32x4 (&acc)[2][2][4][2], const Unit& u, int t, int wr, int wc, int fr, int fq) const {
        const int sgm = (t == HK1) ? 0 : 1;
        asm volatile("" : "+v"(fr), "+v"(fq));
        const int row0 = u.pm * 256 + wr * 64 + fr, col0 = u.pn * 256 + wc * 32 + 8 * fq;
#pragma unroll
        for (int ai = 0; ai < 2; ++ai) {
            u32x4 ga[4][2], gb[4][2];
#pragma unroll
            for (int m = 0; m < 4; ++m) { const bf16_t* gp = Gt + (size_t)(row0 + ai * HALF + m * 16) * 6144 + sgm * DM + col0;
#pragma unroll
                for (int bj = 0; bj < 2; ++bj) { ga[m][bj] = *(const u32x4*)(gp + bj * HALF); gb[m][bj] = *(const u32x4*)(gp + DM + bj * HALF); } }
#pragma unroll
            for (int m = 0; m < 4; ++m)
#pragma unroll
                for (int bj = 0; bj < 2; ++bj) { f32x4 a0, a1, b0, b1; unpack8(ga[m][bj], a0, a1); unpack8(gb[m][bj], b0, b1);
#pragma unroll
                    for (int j = 0; j < 4; ++j) { acc[ai][bj][m][0][j] *= a0[j] * __builtin_amdgcn_rcpf(b0[j]); acc[ai][bj][m][1][j] *= a1[j] * __builtin_amdgcn_rcpf(b1[j]); } }
            asm volatile("" ::: "memory");
        }
    }
    DI void operator()(const f32x4 (&acc)[2][2][4][2], const Unit& u, int wr, int wc, int fr, int fq) const {
        const int row0 = u.pm * 256 + wr * 64 + fr, col0 = u.pn * 256 + wc * 32 + 8 * fq;
#pragma unroll
        for (int ai = 0; ai < 2; ++ai) {
            u32x4 gg[4][2];
#pragma unroll
            for (int m = 0; m < 4; ++m)
#pragma unroll
                for (int bj = 0; bj < 2; ++bj) gg[m][bj] = *(const u32x4*)(Gt + (size_t)(row0 + ai * HALF + m * 16) * 6144 + 2 * DM + col0 + bj * HALF);
#pragma unroll
            for (int m = 0; m < 4; ++m)
#pragma unroll
                for (int bj = 0; bj < 2; ++bj) { f32x4 g0, g1; unpack8(gg[m][bj], g0, g1);
                    *(u32x4*)(MG + (size_t)(row0 + ai * HALF + m * 16) * DM + col0 + bj * HALF) = pack8(g0 * acc[ai][bj][m][0], g1 * acc[ai][bj][m][1]); }
            asm volatile("" ::: "memory");
        }
    }
};

DI void transpose_item(const float* W, int N, bf16_t* WT, int ldo, int row_off, int koff, LAS float* scr, int item, int lane) {
    const int nblk = N / 32, kb = item / nblk, nb = item % nblk, k0 = 64 * kb, n0 = 32 * nb;
    f32x4 v[8];
    { const float* wp = W + (size_t)(k0 + (lane >> 3)) * N + n0 + 4 * (lane & 7);
#pragma unroll
      for (int i = 0; i < 8; ++i) v[i] = *(const f32x4*)(wp + (size_t)(8 * i) * N); }
#pragma unroll
    for (int i = 0; i < 8; ++i) { LAS float* d = scr + (8 * i + (lane >> 3)) * 33 + 4 * (lane & 7); d[0] = v[i][0]; d[1] = v[i][1]; d[2] = v[i][2]; d[3] = v[i][3]; }
    asm volatile("s_waitcnt lgkmcnt(0)" ::: "memory");
    const int c = lane & 7;
#pragma unroll
    for (int j = 0; j < 4; ++j) { const int n = (lane >> 3) + 8 * j; const LAS float* s = scr + (8 * c) * 33 + n;
        u32x4 o; o.x = pk2(s[0 * 33], s[1 * 33]); o.y = pk2(s[2 * 33], s[3 * 33]); o.z = pk2(s[4 * 33], s[5 * 33]); o.w = pk2(s[6 * 33], s[7 * 33]);
        *(u32x4*)(WT + (size_t)(row_off + n0 + n) * ldo + koff + k0 + 8 * c) = o; }
    asm volatile("s_waitcnt lgkmcnt(0)" ::: "memory");
}

struct Params { const float* in[23]; float* out; unsigned char* ws; int ph_lo, ph_hi; };

DI void convert_weights(const Params& P, int l, LAS unsigned char* lds) {
    const int tid = ltid(), lane = tid & 63, wid = tid >> 6;
    unsigned char* ws = P.ws;
    LAS float* scr = (LAS float*)(lds + wid * 8448);
    const int gw = blockIdx.x * 8 + wid, NGW = gridDim.x * 8;
    constexpr int I13 = 32 * 352, I2 = 88 * 64, IIN = 32 * 288, ICO = 16 * 64, IF = 8 * 64, IKV = 32 * 32, IO = 8 * 64, IOUT = 32 * 64;
    constexpr int NITEMS = 2 * I13 + 2 * I2 + IIN + ICO + 2 * IF + IKV + IO + IOUT;
    const float* w13a = P.in[2] + (size_t)l * DM * 2 * DFF; const float* w2a = P.in[3] + (size_t)l * DFF * DM;
    const float* win = P.in[6] + (size_t)l * DM * DIN; const float* wco = P.in[12] + (size_t)l * 1024 * DM; const float* wf = P.in[13] + (size_t)l * 512 * DM;
    const float* wkv = P.in[14] + (size_t)l * DM * 1024; const float* wo = P.in[15] + (size_t)l * 512 * DM; const float* wout = P.in[16] + (size_t)l * DM * DM;
    const float* w13b = P.in[19] + (size_t)l * DM * 2 * DFF; const float* w2b = P.in[20] + (size_t)l * DFF * DM;
    for (int it = gw; it < NITEMS; it += NGW) {
        int r = it;
        if (r < I13) { transpose_item(w13a, 2 * DFF, (bf16_t*)(ws + WS_W13A), DM, 0, 0, scr, r, lane); continue; } r -= I13;
        if (r < I13) { transpose_item(w13b, 2 * DFF, (bf16_t*)(ws + WS_W13B), DM, 0, 0, scr, r, lane); continue; } r -= I13;
        if (r < I2) { transpose_item(w2a, DM, (bf16_t*)(ws + WS_W2A), DFF, 0, 0, scr, r, lane); continue; } r -= I2;
        if (r < I2) { transpose_item(w2b, DM, (bf16_t*)(ws + WS_W2B), DFF, 0, 0, scr, r, lane); continue; } r -= I2;
        if (r < IIN) { transpose_item(win, DIN, (bf16_t*)(ws + WS_WIN), DM, 0, 0, scr, r, lane); continue; } r -= IIN;
        if (r < ICO) { transpose_item(wco, DM, (bf16_t*)(ws + WS_WBR), KBR, 0, 0, scr, r, lane); continue; } r -= ICO;
        if (r < IF) { transpose_item(wf, DM, (bf16_t*)(ws + WS_WBR), KBR, 0, 1024, scr, r, lane); continue; } r -= IF;
        if (r < IF) { transpose_item(wf, DM, (bf16_t*)(ws + WS_WBR), KBR, 0, 1536, scr, r, lane); continue; } r -= IF;
        if (r < IKV) { transpose_item(wkv, 1024, (bf16_t*)(ws + WS_WKV), DM, 0, 0, scr, r, lane); continue; } r -= IKV;
        if (r < IO) { transpose_item(wo, DM, (bf16_t*)(ws + WS_WBR), KBR, 0, 2048, scr, r, lane); continue; } r -= IO;
        transpose_item(wout, DM, (bf16_t*)(ws + WS_WOUT), DM, 0, 0, scr, r, lane);
    }
    __syncthreads();
    {
        LAS float* tile = (LAS float*)lds;
        LAS float* tabc = tile + 32 * 129; LAS float* tabs = tabc + 128;
        const float* bin = P.in[7] + (size_t)l * DIN;
        bf16_t* WFT = (bf16_t*)(ws + WS_WFT); float* biasT = (float*)(ws + WS_BIAST);
        if (tid < 128) { float sn, cs; sincospif((float)tid * (1.0f / 64.0f), &sn, &cs); tabc[tid] = cs * 0.08838834764831845f; tabs[tid] = sn * 0.08838834764831845f; }
        for (int item = blockIdx.x; item < 256; item += gridDim.x) {
            const int kb = item >> 2, g = item & 3;
            __syncthreads();
            for (int idx = tid; idx < 32 * 128; idx += 512) { const int kk = idx >> 7, j = idx & 127; tile[kk * 129 + j] = win[(size_t)(kb * 32 + kk) * DIN + 2048 + g * 128 + j]; }
            __syncthreads();
            const int k = tid & 31, ccb = (tid >> 5) * 8;
            float ac[8], as[8];
#pragma unroll
            for (int c8 = 0; c8 < 8; ++c8) { ac[c8] = 0.f; as[c8] = 0.f; }
            for (int j = 0; j < 128; ++j) { const float w = tile[k * 129 + j];
#pragma unroll
                for (int c8 = 0; c8 < 8; ++c8) { const int idx = (j * (ccb + c8)) & 127; ac[c8] += w * tabc[idx]; as[c8] += w * tabs[idx]; } }
#pragma unroll
            for (int c8 = 0; c8 < 8; ++c8) { WFT[(size_t)(g * 128 + ccb + c8) * DM + kb * 32 + k] = f2bf(ac[c8]); WFT[(size_t)(512 + g * 128 + ccb + c8) * DM + kb * 32 + k] = f2bf(as[c8]); }
            if (kb == 0 && tid < 128) { float bc = 0.f, bs = 0.f;
                for (int j = 0; j < 128; ++j) { const float w = bin[2048 + g * 128 + j]; const int idx = (j * tid) & 127; bc += w * tabc[idx]; bs += w * tabs[idx]; }
                biasT[g * 128 + tid] = bc; biasT[512 + g * 128 + tid] = bs; }
        }
        __syncthreads();
    }
}

DI void setup_phase(const Params& P, LAS unsigned char* lds) {
    const int tid = ltid(); unsigned char* ws = P.ws;
    const size_t gt = (size_t)blockIdx.x * 512 + tid, ngt = (size_t)gridDim.x * 512;
    { const f32x4* src = (const f32x4*)P.in[0]; u32x4* dst = (u32x4*)(ws + WS_XB);
      for (size_t i = gt; i < (size_t)NTOK * DM / 8; i += ngt) dst[i] = pack8(src[2 * i], src[2 * i + 1]); }
    { const f32x4* src = (const f32x4*)P.in[1]; u32x4* dst = (u32x4*)(ws + WS_MEMB);
      for (size_t i = gt; i < (size_t)512 * DM / 8; i += ngt) dst[i] = pack8(src[2 * i], src[2 * i + 1]); }
    bf16_t* cm0 = (bf16_t*)(ws + WS_CM); bf16_t* cm1 = (bf16_t*)(ws + WS_CM + CM_HALF);
    for (int j = blockIdx.x; j < HSEQ; j += gridDim.x) {
        f32x4 c0, c1, s0, s1;
#pragma unroll
        for (int e = 0; e < 8; ++e) { const float x = (float)((j * (tid * 8 + e)) & (SEQ - 1)) * (1.0f / 8192.0f);
            const float cv = __builtin_amdgcn_cosf(x) * 0.011048543456039806f, sv = __builtin_amdgcn_sinf(x) * -0.011048543456039806f;
            if (e < 4) { c0[e] = cv; s0[e] = sv; } else { c1[e - 4] = cv; s1[e - 4] = sv; } }
        *(u32x4*)(cm0 + (size_t)j * HSEQ + tid * 8) = pack8(c0, c1); *(u32x4*)(cm1 + (size_t)j * HSEQ + tid * 8) = pack8(s0, s1);
    }
}

DI void ln_phase(float* X, bf16_t* XB, float* stats, const float* g, const float* bta, bool final_out) {
    const int tid = ltid(), lane = tid & 63, gw = blockIdx.x * 8 + (tid >> 6), ngw = gridDim.x * 8;
    f32x4 gv[8], bv[8];
#pragma unroll
    for (int j = 0; j < 8; ++j) { gv[j] = ((const f32x4*)g)[64 * j + lane]; bv[j] = ((const f32x4*)bta)[64 * j + lane]; }
    f32x4 nv[8];
    if (gw < NTOK) { const f32x4* xr0 = (const f32x4*)(X + (size_t)gw * DM) + lane;
#pragma unroll
        for (int j = 0; j < 8; ++j) nv[j] = xr0[64 * j]; }
    for (int row = gw; row < NTOK; row += ngw) {
        f32x4* xr = (f32x4*)(X + (size_t)row * DM) + lane; f32x4 v[8]; float s = 0.f;
#pragma unroll
        for (int j = 0; j < 8; ++j) v[j] = nv[j];
        if (row + ngw < NTOK) { const f32x4* xn = (const f32x4*)(X + (size_t)(row + ngw) * DM) + lane;
#pragma unroll
            for (int j = 0; j < 8; ++j) nv[j] = xn[64 * j]; }
#pragma unroll
        for (int j = 0; j < 8; ++j) s += (v[j][0] + v[j][1]) + (v[j][2] + v[j][3]);
        const float mean = wave_sum(s) * (1.0f / DM); float s2 = 0.f;
#pragma unroll
        for (int j = 0; j < 8; ++j) { v[j] = v[j] - mean; s2 += (v[j][0] * v[j][0] + v[j][1] * v[j][1]) + (v[j][2] * v[j][2] + v[j][3] * v[j][3]); }
        const float rstd = 1.0f / sqrtf(wave_sum(s2) * (1.0f / DM) + LN_EPS);
        if (final_out) {
#pragma unroll
            for (int j = 0; j < 8; ++j) xr[64 * j] = v[j] * rstd * gv[j] + bv[j];
        } else {
            if (lane == 0) { f32x2 st = {mean, rstd}; *(f32x2*)(stats + 2 * row) = st; }
            u32x2* ob = (u32x2*)(XB + (size_t)row * DM) + lane;
#pragma unroll
            for (int j = 0; j < 8; ++j) { const f32x4 y = v[j] * rstd * gv[j] + bv[j]; u32x2 w; w.x = pk2(y[0], y[1]); w.y = pk2(y[2], y[3]); ob[64 * j] = w; }
        }
    }
}

DI void ln_row(f32x4 (&v)[8], const f32x4 (&gv)[8], const f32x4 (&bv)[8], float* stats, int row, bf16_t* XB, int lane) {
    float s = 0.f;
#pragma unroll
    for (int j = 0; j < 8; ++j) s += (v[j][0] + v[j][1]) + (v[j][2] + v[j][3]);
    const float mean = wave_sum(s) * (1.0f / DM); float s2 = 0.f;
#pragma unroll
    for (int j = 0; j < 8; ++j) { v[j] = v[j] - mean; s2 += (v[j][0] * v[j][0] + v[j][1] * v[j][1]) + (v[j][2] * v[j][2] + v[j][3] * v[j][3]); }
    const float rstd = 1.0f / sqrtf(wave_sum(s2) * (1.0f / DM) + LN_EPS);
    if (lane == 0) { f32x2 st = {mean, rstd}; *(f32x2*)(stats + 2 * row) = st; }
    u32x2* ob = (u32x2*)(XB + (size_t)row * DM) + lane;
#pragma unroll
    for (int j = 0; j < 8; ++j) { v[j] = v[j] * rstd * gv[j] + bv[j]; u32x2 w; w.x = pk2(v[j][0], v[j][1]); w.y = pk2(v[j][2], v[j][3]); ob[64 * j] = w; }
}
DI void ln_fold_phase(const float* X, bf16_t* XB, bf16_t* XP, bf16_t* XM, float* stats, const float* g, const float* bta, int vb) {
    const int tid = ltid(), lane = tid & 63, wv = (vb - 8) * 8 + (tid >> 6), nwv = ((int)gridDim.x - 8) * 8;
    f32x4 gv[8], bv[8];
#pragma unroll
    for (int j = 0; j < 8; ++j) { gv[j] = ((const f32x4*)g)[64 * j + lane]; bv[j] = ((const f32x4*)bta)[64 * j + lane]; }
    for (int it = wv; it < 2 * (HSEQ + 1); it += nwv) {
        const int b = it / (HSEQ + 1), i = it - b * (HSEQ + 1);
        const bool pair = (i != 0) && (i != HSEQ);
        const int rowA = b * SEQ + i, rowB = b * SEQ + (SEQ - i);
        f32x4 va[8], vb[8];
        { const f32x4* xa = (const f32x4*)(X + (size_t)rowA * DM) + lane;
#pragma unroll
          for (int j = 0; j < 8; ++j) va[j] = xa[64 * j]; }
        if (pair) { const f32x4* xq = (const f32x4*)(X + (size_t)rowB * DM) + lane;
#pragma unroll
            for (int j = 0; j < 8; ++j) vb[j] = xq[64 * j]; }
        else {
#pragma unroll
            for (int j = 0; j < 8; ++j) vb[j] = (f32x4){0.f, 0.f, 0.f, 0.f}; }
        ln_row(va, gv, bv, stats, rowA, XB, lane);
        if (pair) ln_row(vb, gv, bv, stats, rowB, XB, lane);
        if (i != HSEQ) {
            u32x2* op = (u32x2*)(XP + (size_t)(b * HSEQ + i) * DM) + lane; u32x2* om = (u32x2*)(XM + (size_t)(b * HSEQ + i) * DM) + lane;
#pragma unroll
            for (int j = 0; j < 8; ++j) { f32x4 p = va[j], m = {0.f, 0.f, 0.f, 0.f}; if (pair) { p = va[j] + vb[j]; m = va[j] - vb[j]; }
                u32x2 w; w.x = pk2(p[0], p[1]); w.y = pk2(p[2], p[3]); op[64 * j] = w; w.x = pk2(m[0], m[1]); w.y = pk2(m[2], m[3]); om[64 * j] = w; }
        }
    }
}

constexpr int CT = 16, CROWS = CT + 30;
DI void conv_tile(const bf16_t* GLU, bf16_t* CV, const float* cw, const float* cb, const float* lg, const float* lb, int tile, LAS unsigned char* lds) {
    const int tid = ltid(), lane = tid & 63, wid = __builtin_amdgcn_readfirstlane(tid >> 6);
    const int tok0 = tile * CT, b = tok0 >> 13, s0 = tok0 & (SEQ - 1);
    LAS unsigned char* ldst = lds + tid * 4;
    asm volatile("" : "+v"(ldst));
    asm volatile("" : "+s"(GLU), "+s"(CV), "+s"(cw), "+s"(cb), "+s"(lg), "+s"(lb));
    __syncthreads();
    for (int idx = tid; idx < CROWS * 128; idx += 512) { const int rr = idx >> 7, c16 = idx & 127, s = s0 - 15 + rr; u32x4 v = {0u, 0u, 0u, 0u};
        if (s >= 0 && s < SEQ) v = *(const u32x4*)(GLU + ((size_t)(b * SEQ + s)) * 1024 + c16 * 8);
        *(LAS u32x4*)(lds + rr * 2048 + c16 * 16) = v; }
    __syncthreads();
    float w0[31], w1[31];
#pragma unroll
    for (int j = 0; j < 31; ++j) { const f32x2 w = *(const f32x2*)(cw + j * 1024 + 2 * tid); w0[j] = w[0]; w1[j] = w[1]; }
    float a0[CT], a1[CT];
#pragma unroll
    for (int t = 0; t < CT; ++t) { a0[t] = 0.f; a1[t] = 0.f; }
    unsigned vnext = *(const LAS unsigned*)ldst;
#pragma unroll
    for (int rr = 0; rr < CROWS; ++rr) { const unsigned v = vnext; if (rr + 1 < CROWS) vnext = *(const LAS unsigned*)(ldst + (rr + 1) * 2048);
        asm volatile("" ::: "memory");
        const float x0 = __uint_as_float(v << 16), x1 = __uint_as_float(v & 0xffff0000u);
#pragma unroll
        for (int t = 0; t < CT; ++t) { const int j = rr - t; if (j >= 0 && j <= 30) { a0[t] += x0 * w0[j]; a1[t] += x1 * w1[j]; } } }
    const f32x2 cbv = *(const f32x2*)(cb + 2 * tid);
    __syncthreads();
    { LAS float* yw = (LAS float*)lds + 2 * tid;
      asm volatile("" : "+v"(yw));
#pragma unroll
      for (int t = 0; t < CT; ++t) { f32x2 y = {a0[t] + cbv[0], a1[t] + cbv[1]}; *(LAS f32x2*)(yw + t * 1024) = y; } }
    __syncthreads();
    {
        f32x4 gv[4], bv[4];
#pragma unroll
        for (int i = 0; i < 4; ++i) { gv[i] = *(const f32x4*)(lg + 4 * lane + 256 * i); bv[i] = *(const f32x4*)(lb + 4 * lane + 256 * i); }
#pragma unroll
        for (int tt = 0; tt < 2; ++tt) { const int t = 2 * wid + tt; const LAS float* yr = (const LAS float*)lds + t * 1024 + 4 * lane;
            f32x4 v[4]; float s = 0.f;
#pragma unroll
            for (int i = 0; i < 4; ++i) { v[i] = *(const LAS f32x4*)(yr + 256 * i); s += (v[i][0] + v[i][1]) + (v[i][2] + v[i][3]); }
            const float mean = wave_sum(s) * (1.0f / 1024.0f); float s2 = 0.f;
#pragma unroll
            for (int i = 0; i < 4; ++i) { v[i] = v[i] - mean; s2 += (v[i][0] * v[i][0] + v[i][1] * v[i][1]) + (v[i][2] * v[i][2] + v[i][3] * v[i][3]); }
            const float rstd = 1.0f / sqrtf(wave_sum(s2) * (1.0f / 1024.0f) + LN_EPS);
            bf16_t* op = CV + (size_t)(tok0 + t) * KBR + 4 * lane;
#pragma unroll
            for (int i = 0; i < 4; ++i) { f32x4 y = v[i] * rstd * gv[i] + bv[i];
#pragma unroll
                for (int j = 0; j < 4; ++j) y[j] *= sigmoidf_fast(y[j]);
                u32x2 w; w.x = pk2(y[0], y[1]); w.y = pk2(y[2], y[3]); *(u32x2*)(op + 256 * i) = w; } }
    }
}

DI void attn_unit(const bf16_t* Q, const bf16_t* KK, const bf16_t* VT, bf16_t* OO, int b, int h, int qt, LAS unsigned char* lds) {
    const int tid = ltid(), lane = tid & 63, wid = __builtin_amdgcn_readfirstlane(tid >> 6), r = lane & 31, h2 = lane >> 5;
    const int tok0 = b * SEQ + qt * 256 + wid * 32;
    asm volatile("" : "+s"(Q), "+s"(KK), "+s"(VT), "+s"(OO));
    LAS unsigned char* ldsK = lds; LAS unsigned char* ldsV = lds + 65536;
    __syncthreads();
#pragma unroll
    for (int i = 0; i < 8; ++i) { const int id = i * 512 + tid, row = id >> 4, ch = id & 15;
        const u32x4 v = *(const u32x4*)(KK + (size_t)(b * 256 + row) * 512 + h * 128 + ch * 8);
        *(LAS u32x4*)(ldsK + row * 256 + ((ch ^ (row & 15)) << 4)) = v; }
#pragma unroll
    for (int i = 0; i < 8; ++i) { const int id = i * 512 + tid, row = id >> 5, ch = id & 31;
        const u32x4 v = *(const u32x4*)(VT + (size_t)(h * 128 + row) * 512 + b * 256 + ch * 8);
        *(LAS u32x4*)(ldsV + row * 512 + ((ch ^ (row & 31)) << 4)) = v; }
    bf16x8 qf[8];
    { const bf16_t* qp = Q + (size_t)(tok0 + r) * 512 + h * 128 + 8 * h2;
#pragma unroll
      for (int s = 0; s < 8; ++s) qf[s] = *(const bf16x8*)(qp + 16 * s); }
    __syncthreads();
    f32x16 sacc[8];
    { const LAS unsigned char* kbase = ldsK + r * 256; const int rx = r & 15;
#pragma unroll
      for (int kb = 0; kb < 8; ++kb) {
#pragma unroll
        for (int i = 0; i < 16; ++i) sacc[kb][i] = 0.f;
#pragma unroll
        for (int s = 0; s < 8; ++s) { const bf16x8 kf = *(const LAS bf16x8*)(kbase + kb * 8192 + (((2 * s + h2) ^ rx) << 4)); sacc[kb] = __builtin_amdgcn_mfma_f32_32x32x16_bf16(kf, qf[s], sacc[kb], 0, 0, 0); }
      } }
    float mx = -3.0e38f;
#pragma unroll
    for (int kb = 0; kb < 8; ++kb)
#pragma unroll
        for (int i = 0; i < 16; ++i) mx = fmaxf(mx, sacc[kb][i]);
    mx = fmaxf(mx, __shfl_xor(mx, 32));
    float sum = 0.f;
#pragma unroll
    for (int kb = 0; kb < 8; ++kb)
#pragma unroll
        for (int i = 0; i < 16; ++i) { const float p = __expf(sacc[kb][i] - mx); sacc[kb][i] = p; sum += p; }
    sum += __shfl_xor(sum, 32);
    const float inv = 1.0f / sum;
    f32x16 oacc[4];
#pragma unroll
    for (int db = 0; db < 4; ++db)
#pragma unroll
        for (int i = 0; i < 16; ++i) oacc[db][i] = 0.f;
    { const LAS unsigned char* vbase = ldsV + r * 512 + h2 * 8;
#pragma unroll
      for (int kb = 0; kb < 8; ++kb)
#pragma unroll
        for (int s2 = 0; s2 < 2; ++s2) {
            u32x4 pw; pw.x = pk2(sacc[kb][8 * s2 + 0], sacc[kb][8 * s2 + 1]); pw.y = pk2(sacc[kb][8 * s2 + 2], sacc[kb][8 * s2 + 3]);
            pw.z = pk2(sacc[kb][8 * s2 + 4], sacc[kb][8 * s2 + 5]); pw.w = pk2(sacc[kb][8 * s2 + 6], sacc[kb][8 * s2 + 7]);
            const bf16x8 pf = __builtin_bit_cast(bf16x8, pw);
            const int c0 = 4 * kb + 2 * s2;
#pragma unroll
            for (int db = 0; db < 4; ++db) {
                const u32x2 lo = *(const LAS u32x2*)(vbase + db * 16384 + ((c0 ^ r) << 4)), hi = *(const LAS u32x2*)(vbase + db * 16384 + (((c0 + 1) ^ r) << 4));
                u32x4 vw; vw.x = lo.x; vw.y = lo.y; vw.z = hi.x; vw.w = hi.y;
                oacc[db] = __builtin_amdgcn_mfma_f32_32x32x16_bf16(__builtin_bit_cast(bf16x8, vw), pf, oacc[db], 0, 0, 0);
            }
        } }
    bf16_t* op = OO + (size_t)(tok0 + r) * KBR + h * 128 + 4 * h2;
#pragma unroll
    for (int db = 0; db < 4; ++db)
#pragma unroll
        for (int g = 0; g < 4; ++g) { u32x2 w; w.x = pk2(oacc[db][4 * g] * inv, oacc[db][4 * g + 1] * inv); w.y = pk2(oacc[db][4 * g + 2] * inv, oacc[db][4 * g + 3] * inv);
            *(u32x2*)(op + db * 32 + 8 * g) = w; }
}

#define XB_TMO      128
#define XB_XCNT(j)  (256  + 64 * (j))
#define XB_XSUB(j)  (1280 + 64 * (j))
#define XB_XGEN(j)  (2304 + 64 * (j))
#define XB_TOP      3328
#define XB_TOPGEN   3392
#define XCD_BAR_WORDS 3456
#define XB_SPIN_CAP (1u << 18)

__device__ __forceinline__ unsigned xb_ld(unsigned* p)              { return __hip_atomic_load(p, __ATOMIC_RELAXED, __HIP_MEMORY_SCOPE_AGENT); }
__device__ __forceinline__ unsigned xb_add(unsigned* p, unsigned v) { return __hip_atomic_fetch_add(p, v, __ATOMIC_RELAXED, __HIP_MEMORY_SCOPE_AGENT); }
__device__ __forceinline__ unsigned xb_xcc_id() { return (unsigned)__builtin_amdgcn_s_getreg((3 << 11) | 20) & 0xFu; }
#define XB_SPIN(cond, bar) do { unsigned _sp = 0; while (cond) { __builtin_amdgcn_s_sleep(1); \
    if ((++_sp & 255u) == 0u) { if (xb_ld(&(bar)[XB_TMO])) break; if (_sp > XB_SPIN_CAP) { atomicAdd(&(bar)[XB_TMO], 1u); break; } } } } while (0)

struct XcdBarrier {
    unsigned* bar; unsigned x;
    volatile LAS unsigned* st;
};

__device__ __forceinline__ XcdBarrier xcd_barrier_post(unsigned* bar, volatile LAS unsigned* st) {
    XcdBarrier b; b.bar = bar; b.x = xb_xcc_id(); b.st = st;
    if (threadIdx.x == 0) (void)xb_add(&bar[XB_XCNT(b.x)], 1u);
    return b;
}
__device__ __forceinline__ void xcd_barrier_complete(unsigned* bar, unsigned x, unsigned& nloc, unsigned& nx) {
    const unsigned G = gridDim.x * gridDim.y * gridDim.z;
    unsigned sum, cnt, mine, sp = 0u;
    for (;;) {
        sum = 0u; cnt = 0u; mine = 0u;
#pragma unroll
        for (unsigned j = 0; j < 16; ++j) { const unsigned c = xb_ld(&bar[XB_XCNT(j)]); sum += c; cnt += (c > 0u) ? 1u : 0u; mine = (j == x) ? c : mine; }
        if (sum == G) break;
        __builtin_amdgcn_s_sleep(1);
        if ((++sp & 255u) == 0u) { if (xb_ld(&bar[XB_TMO])) break; if (sp > XB_SPIN_CAP) { atomicAdd(&bar[XB_TMO], 1u); break; } }
    }
    nloc = mine > 0u ? mine : 1u; nx = cnt > 0u ? cnt : 1u;
}

__device__ __forceinline__ void xcd_barrier(const XcdBarrier& b) {
    asm volatile("s_waitcnt vmcnt(0)" ::: "memory");
    __syncthreads();
    if (threadIdx.x == 0) {
        unsigned* bar = b.bar;
        __builtin_amdgcn_s_waitcnt(0);
        unsigned nloc = b.st[0], nx = b.st[1];
        if (nloc == 0u) { xcd_barrier_complete(bar, b.x, nloc, nx); b.st[0] = nloc; b.st[1] = nx; }
        const unsigned old = xb_add(&bar[XB_XSUB(b.x)], 1u);
        const unsigned gen = old / nloc;
        if (old + 1u == (gen + 1u) * nloc) {
            __builtin_amdgcn_fence(__ATOMIC_RELEASE, "agent");
            asm volatile("s_waitcnt vmcnt(0)" ::: "memory");
            const unsigned og = xb_add(&bar[XB_TOP], 1u);
            const unsigned tg = og / nx;
            if (og + 1u == (tg + 1u) * nx) xb_add(&bar[XB_TOPGEN], 1u);
            else XB_SPIN(xb_ld(&bar[XB_TOPGEN]) == tg, bar);
            __builtin_amdgcn_fence(__ATOMIC_ACQUIRE, "agent");
            xb_add(&bar[XB_XGEN(b.x)], 1u);
            asm volatile("s_waitcnt vmcnt(0)" ::: "memory");
        } else {
            XB_SPIN(xb_ld(&bar[XB_XGEN(b.x)]) == gen, bar);
            __builtin_amdgcn_fence(__ATOMIC_ACQUIRE, "agent");
            asm volatile("s_waitcnt vmcnt(0)" ::: "memory");
        }
    }
    __syncthreads();
}


constexpr int NPHASE = 1 + 11 * NLAYER;

__global__ void __launch_bounds__(512, 2) fwd_mega(Params P) {
    extern __shared__ __attribute__((aligned(16))) unsigned char lds_raw[];
    LAS unsigned char* lds = (LAS unsigned char*)lds_raw;
    const int G = gridDim.x;
    if (threadIdx.x == 0) {
        unsigned vc = blockIdx.x;
#if ONE_LAUNCH
        unsigned* cen = (unsigned*)(P.ws + WS_BAR);
        const unsigned x = xb_xcc_id(), rank = xb_add(cen + 8 * x, 1u);
        unsigned sum = 0, base = 0, sp = 0;
        for (;;) { sum = 0; base = 0;
#pragma unroll
            for (unsigned j = 0; j < 16; ++j) { const unsigned cj = xb_ld(cen + 8 * j); sum += cj; base += (j < x) ? cj : 0u; }
            if (sum == (unsigned)G) break;
            __builtin_amdgcn_s_sleep(1);
            if (++sp > XB_SPIN_CAP) break; }
        const unsigned cp = base + rank, per = (unsigned)G / 8u;
        if (sum == (unsigned)G && (G % 8) == 0 && cp < (unsigned)G) vc = (cp % per) * 8u + cp / per;
#endif
        *(volatile LAS unsigned*)(lds + LDS_BYTES - 8) = vc;
    }
    __syncthreads();
    const int c = __builtin_amdgcn_readfirstlane((int)*(volatile LAS unsigned*)(lds + LDS_BYTES - 8));
    volatile LAS unsigned* bar_st = (volatile LAS unsigned*)(lds + LDS_BYTES - 16);
    if (threadIdx.x == 0) { bar_st[0] = 0u; bar_st[1] = 0u; }
    __syncthreads();
    XcdBarrier gbar = xcd_barrier_post((unsigned*)(P.ws + WS_BAR), bar_st);
#ifdef PROBE_MASK
    unsigned long long pr_acc = 0, pr_t0 = 0;
#endif
    for (int ph = P.ph_lo; ph < P.ph_hi; ++ph) {
#ifdef PROBE_MASK
        if ((PROBE_MASK >> ph) & 1) pr_t0 = wall_clock64();
#endif
        unsigned char* ws = P.ws;
        asm volatile("" : "+s"(ws));
        const char* xb = (const char*)(ws + WS_XB);
        if (ph == 0) {
            if (PHON(0)) setup_phase(P, lds);
            if (PHON(1)) convert_weights(P, 0, lds);
        } else {
            const int l = (ph - 1) / 11, sp = (ph - 1) % 11;
            if (PHON(2) && (sp == 0 || sp == 8)) {
                SchedFfnUp S{xb, (const char*)(ws + (sp == 0 ? WS_W13A : WS_W13B)), G, c};
                EpiSwiGLU E{(bf16_t*)(ws + WS_H)};
                gemm_phase(lds, DM, DM, DM, S, E);
            } else if (PHON(3) && (sp == 1 || sp == 9)) {
                SchedPlain S{(const char*)(ws + WS_H), (const char*)(ws + (sp == 1 ? WS_W2A : WS_W2B)), 64, 8, (size_t)256 * DFF * 2, (size_t)256 * DFF * 2, G, c};
                const float* stats = (const float*)(ws + WS_STATS);
                if (l == 0 && sp == 1) { EpiResid<false, 1> E{P.in[0], P.out, stats, nullptr, nullptr}; gemm_phase(lds, DFF, DFF, DFF, S, E); }
                else {
                    const float* lg = (sp == 1) ? P.in[21] + (size_t)(l - 1) * DM : P.in[17] + (size_t)l * DM;
                    const float* lb = (sp == 1) ? P.in[22] + (size_t)(l - 1) * DM : P.in[18] + (size_t)l * DM;
                    asm volatile("" : "+s"(lg), "+s"(lb), "+s"(stats));
                    EpiResid<true, 1> E{P.out, P.out, stats, lg, lb}; gemm_phase(lds, DFF, DFF, DFF, S, E); }
            } else if (PHON(4) && (sp == 2 || sp == 7 || sp == 10)) {
                const int gi = sp == 2 ? 4 : (sp == 7 ? 17 : 21);
                if (sp == 2) {
                    if (c < 8) { SchedKV S{(const char*)(ws + WS_MEMB), (const char*)(ws + WS_WKV), c}; EpiKV E{(bf16_t*)(ws + WS_KK), (bf16_t*)(ws + WS_VT)}; gemm_phase(lds, DM, DM, DM, S, E); }
                    else ln_fold_phase(P.out, (bf16_t*)(ws + WS_XB), (bf16_t*)(ws + WS_XP), (bf16_t*)(ws + WS_XM), (float*)(ws + WS_STATS), P.in[4] + (size_t)l * DM, P.in[5] + (size_t)l * DM, c);
                } else
                ln_phase(P.out, (bf16_t*)(ws + WS_XB), (float*)(ws + WS_STATS), P.in[gi] + (size_t)l * DM, P.in[gi + 1] + (size_t)l * DM, sp == 10 && l == NLAYER - 1);
                if (PHON(1) && sp == 10 && l + 1 < NLAYER) convert_weights(P, l + 1, lds);
            } else if (PHON(5) && sp == 3) {
                {
                    const int tid = ltid(), lane = tid & 63, gwv = c * 8 + (tid >> 6);
                    if (gwv < 1024) { const int bb = gwv >> 9, ch = gwv & 511;
                        const u32x4* xr = (const u32x4*)(xb + ((size_t)(bb * SEQ + HSEQ)) * ROWB) + lane; const u32x4* wrow = (const u32x4*)(ws + WS_WFT + (size_t)ch * ROWB) + lane; float sdot = 0.f;
#pragma unroll
                        for (int i = 0; i < 4; ++i) { f32x4 x0, x1, w0, w1; unpack8(xr[64 * i], x0, x1); unpack8(wrow[64 * i], w0, w1);
                            sdot += (x0[0] * w0[0] + x0[1] * w0[1]) + (x0[2] * w0[2] + x0[3] * w0[3]) + (x1[0] * w1[0] + x1[1] * w1[1]) + (x1[2] * w1[2] + x1[3] * w1[3]); }
                        sdot = wave_sum(sdot);
                        if (lane == 0) ((float*)(ws + WS_UH))[gwv] = (sdot + ((const float*)(ws + WS_BIAST))[ch]) * 0.011048543456039806f; }
                }
                SchedWin S{xb, (const char*)(ws + WS_WIN), (const char*)(ws + WS_WFT), (const char*)(ws + WS_XP), (const char*)(ws + WS_XM), G, c};
                EpiWin E{P.in[7] + (size_t)l * DIN, (const float*)(ws + WS_BIAST), (bf16_t*)(ws + WS_GLU), (bf16_t*)(ws + WS_Q), (bf16_t*)(ws + WS_G), (bf16_t*)(ws + WS_TT)};
                gemm_phase(lds, DM, DM, DM, S, E);
            } else if (sp == 4) {
                if (PHON(6)) { SchedDft S{(const char*)(ws + WS_CM), (const char*)(ws + WS_TT), G, c};
                  EpiDft E{(bf16_t*)(ws + WS_BR) + 1024, (const float*)(ws + WS_UH)};
                  gemm_phase(lds, HSEQ, HSEQ, SEQ, S, E); }
                const int half = G >> 1, hi = (c >= half) ? 1 : 0, cc = c - hi * half;
                if (hi) {
                    const int tid = ltid(), lane = tid & 63, gwv = cc * 8 + (tid >> 6);
                    if (gwv < 1024) { const int bb = gwv >> 9, ch = gwv & 511;
                        const u32x4* tr = (const u32x4*)(ws + WS_TT + ((size_t)ch * SEQ + (size_t)bb * HSEQ) * 2) + lane; float sa = 0.f;
#pragma unroll
                        for (int i = 0; i < 8; ++i) { f32x4 x0, x1; unpack8(tr[64 * i], x0, x1); sa += (x0[0] - x0[1]) + (x0[2] - x0[3]) + (x1[0] - x1[1]) + (x1[2] - x1[3]); }
                        sa = wave_sum(sa);
                        if (lane == 0) { bf16_t* orow = (bf16_t*)(ws + WS_BR) + (size_t)(bb * SEQ + HSEQ) * KBR; orow[1024 + ch] = f2bf(sa * 0.011048543456039806f + ((const float*)(ws + WS_UH))[gwv]); orow[1536 + ch] = 0; } }
                }
                if (PHON(7)) { const int nct = hi ? 6 : 2, ct0 = hi ? 2 * half : 0;
                    for (int j = 0; j < nct; ++j)
                        conv_tile((const bf16_t*)(ws + WS_GLU), (bf16_t*)(ws + WS_BR), P.in[8] + (size_t)l * 31 * 1024, P.in[9] + (size_t)l * 1024, P.in[10] + (size_t)l * 1024, P.in[11] + (size_t)l * 1024, ct0 + cc + half * j, lds); }
                if (PHON(8) && hi) for (int j = 0; j < 2; ++j) { const int t = cc + half * j;
                    attn_unit((const bf16_t*)(ws + WS_Q), (const bf16_t*)(ws + WS_KK), (const bf16_t*)(ws + WS_VT), (bf16_t*)(ws + WS_BR) + 2048, t >> 7, (t >> 5) & 3, t & 31, lds); }
                __syncthreads();
            } else if (PHON(9) && sp == 5) {
                SchedPlain S{(const char*)(ws + WS_BR), (const char*)(ws + WS_WBR), 64, 8, (size_t)256 * KBR * 2, (size_t)256 * KBR * 2, G, c};
                EpiBranchFused E{(const bf16_t*)(ws + WS_G), (bf16_t*)(ws + WS_MG)};
                gemm_phase(lds, KBR, KBR, KBR, S, E);
            } else if (PHON(10) && sp == 6) {
                SchedPlain S{(const char*)(ws + WS_MG), (const char*)(ws + WS_WOUT), 64, 8, (size_t)256 * DM * 2, (size_t)256 * DM * 2, G, c};
                const float* stats = (const float*)(ws + WS_STATS); const float* lg = P.in[4] + (size_t)l * DM; const float* lb = P.in[5] + (size_t)l * DM;
                asm volatile("" : "+s"(lg), "+s"(lb), "+s"(stats));
                EpiResid<true, 2> E{P.out, P.out, stats, lg, lb};
                gemm_phase(lds, DM, DM, DM, S, E);
            }
        }
        if (ph + 1 < P.ph_hi) { if (P.ph_lo < 0) cg::this_grid().sync(); else xcd_barrier(gbar); }
#ifdef PROBE_MASK
        if ((PROBE_MASK >> ph) & 1) pr_acc += wall_clock64() - pr_t0;
#endif
    }
#ifdef PROBE_MASK
    if (c == 0) { const unsigned long long t0 = wall_clock64(); while (wall_clock64() - t0 < (unsigned long long)PROBE_MULT * pr_acc) __builtin_amdgcn_s_sleep(32); }
#endif
}

extern "C" void kernel_launch(void* const* d_in, const int* in_sizes, int n_in, void* d_out, int out_size, void* d_ws, size_t ws_size, hipStream_t stream) {
    static int grid = 0;
    if (grid == 0) {
        if (n_in != 23 || out_size != NTOK * DM || ws_size < WS_END) { fprintf(stderr, "kernel_launch: unexpected shapes (n_in %d, out %d, ws %zu < %zu)\n", n_in, out_size, ws_size, (size_t)WS_END); grid = -1; return; }
        int dev = 0, cus = 0, per_cu = 0;
        hipGetDevice(&dev);
        hipDeviceGetAttribute(&cus, hipDeviceAttributeMultiprocessorCount, dev);
        hipFuncSetAttribute((const void*)fwd_mega, hipFuncAttributeMaxDynamicSharedMemorySize, LDS_BYTES);
        hipOccupancyMaxActiveBlocksPerMultiprocessor(&per_cu, (const void*)fwd_mega, 512, LDS_BYTES);
        if (per_cu < 1) { fprintf(stderr, "kernel_launch: occupancy query says %d blocks per CU\n", per_cu); per_cu = 1; }
        (void)hipGetLastError();
        grid = cus;
    }
    if (grid < 0) return;
    Params p{};
    for (int i = 0; i < 23; ++i) p.in[i] = (const float*)d_in[i];
    p.out = (float*)d_out; p.ws = (unsigned char*)d_ws;
#if ONE_LAUNCH
    hipMemsetAsync((unsigned char*)d_ws + WS_BAR, 0, XCD_BAR_WORDS * sizeof(unsigned), stream);
    p.ph_lo = 0; p.ph_hi = NPHASE;
    void* args[] = {&p};
    hipError_t e = hipLaunchCooperativeKernel((const void*)fwd_mega, dim3(grid), dim3(512), args, LDS_BYTES, stream);
    if (e != hipSuccess) fprintf(stderr, "cooperative launch failed: %s (grid %d)\n", hipGetErrorString(e), grid);
#else
    for (int ph = 0; ph < NPHASE; ++ph) { p.ph_lo = ph; p.ph_hi = ph + 1; hipLaunchKernelGGL(fwd_mega, dim3(grid), dim3(512), LDS_BYTES, stream, p); }
#endif
}
```

```cpp
#include <hip/hip_runtime.h>
#include <hip/hip_cooperative_groups.h>
#include <cstdio>
namespace cg = cooperative_groups;

#ifndef PH_MASK
#define PH_MASK 0xFFFF
#endif
#define PHON(k) ((PH_MASK >> (k)) & 1)
#ifndef ONE_LAUNCH
#define ONE_LAUNCH 1
#endif

#define LAS __attribute__((address_space(3)))
#define DI __device__ __forceinline__
typedef unsigned short bf16_t;
typedef short bf16x8 __attribute__((ext_vector_type(8)));
typedef float f32x4 __attribute__((ext_vector_type(4)));
typedef float f32x2 __attribute__((ext_vector_type(2)));
typedef float f32x16 __attribute__((ext_vector_type(16)));
typedef unsigned u32x4 __attribute__((ext_vector_type(4)));
typedef unsigned u32x2 __attribute__((ext_vector_type(2)));
typedef __bf16 bf16x2_t __attribute__((ext_vector_type(2)));

constexpr int NTOK = 16384, DM = 2048, DFF = 5632, DIN = 9216, SEQ = 8192, NLAYER = 2;
constexpr float DN_ALPHA = 1.4142135623730951f;
constexpr float LN_EPS = 1e-5f;

constexpr int HSEQ = SEQ / 2;
constexpr size_t WS_CM    = 0;
constexpr size_t CM_HALF  = (size_t)HSEQ * HSEQ * 2;
constexpr size_t WS_XB    = WS_CM + 2 * CM_HALF;
constexpr size_t WS_MEMB  = WS_XB + (size_t)NTOK * DM * 2;
constexpr size_t WS_XP    = WS_MEMB + (size_t)512 * DM * 2;
constexpr size_t WS_XM    = WS_XP + (size_t)2 * HSEQ * DM * 2;
constexpr size_t WS_W13A  = WS_XM + (size_t)2 * HSEQ * DM * 2;
constexpr size_t WS_W2A   = WS_W13A + (size_t)2 * DFF * DM * 2;
constexpr size_t WS_W13B  = WS_W2A + (size_t)DM * DFF * 2;
constexpr size_t WS_W2B   = WS_W13B + (size_t)2 * DFF * DM * 2;
constexpr size_t WS_WIN   = WS_W2B + (size_t)DM * DFF * 2;
constexpr size_t WS_WFT   = WS_WIN + (size_t)DIN * DM * 2;
constexpr int KBR = 2560;
constexpr size_t WS_WBR   = WS_WFT + (size_t)1024 * DM * 2;
constexpr size_t WS_WKV   = WS_WBR + (size_t)DM * KBR * 2;
constexpr size_t WS_WOUT  = WS_WKV + (size_t)1024 * DM * 2;
constexpr size_t WS_BIAST = WS_WOUT + (size_t)DM * DM * 2;
constexpr size_t WS_STATS = WS_BIAST + 4096;
constexpr size_t WS_BAR   = WS_STATS + (size_t)NTOK * 8;
constexpr size_t WS_UH    = WS_BAR + 16384;
constexpr size_t WS_KK    = WS_UH + 4096;
constexpr size_t WS_VT    = WS_KK + (size_t)512 * 512 * 2;
constexpr size_t WS_MIX   = WS_VT + (size_t)512 * 512 * 2;
constexpr size_t WS_G     = WS_MIX;
constexpr size_t WS_GLU   = WS_G + (size_t)NTOK * 6144 * 2;
constexpr size_t WS_TT    = WS_GLU + (size_t)NTOK * 1024 * 2;
constexpr size_t WS_MG    = WS_GLU;
constexpr size_t WS_Q     = WS_TT + (size_t)1024 * NTOK * 2;
constexpr size_t WS_BR    = WS_Q + (size_t)NTOK * 512 * 2;
constexpr size_t WS_END   = WS_BR + (size_t)NTOK * KBR * 2;
constexpr size_t WS_H     = WS_MIX;
static_assert((size_t)NTOK * DFF * 2 <= WS_END - WS_MIX, "H must fit the union region");

constexpr int LDS_BYTES = 131072 + 4096;

DI int ltid() { int t = threadIdx.x; asm volatile("" : "+v"(t)); return t; }
DI unsigned pk2(float a, float b) { f32x2 v = {a, b}; bf16x2_t r = __builtin_convertvector(v, bf16x2_t); return __builtin_bit_cast(unsigned, r); }
DI bf16_t f2bf(float a) { return (bf16_t)(pk2(a, 0.f) & 0xffffu); }
DI float sigmoidf_fast(float x) { return __builtin_amdgcn_rcpf(1.0f + __expf(-x)); }
DI float wave_sum(float v) {
#pragma unroll
    for (int o = 1; o < 64; o <<= 1) v += __shfl_xor(v, o);
    return v;
}
template <int O> DI float shx(float v) { return __shfl_xor(v, O); }
DI u32x4 pack8(const f32x4 v0, const f32x4 v1) { u32x4 w; w.x = pk2(v0[0], v0[1]); w.y = pk2(v0[2], v0[3]); w.z = pk2(v1[0], v1[1]); w.w = pk2(v1[2], v1[3]); return w; }
DI void unpack8(const u32x4 w, f32x4& v0, f32x4& v1) {
    v0[0] = __uint_as_float(w.x << 16); v0[1] = __uint_as_float(w.x & 0xffff0000u); v0[2] = __uint_as_float(w.y << 16); v0[3] = __uint_as_float(w.y & 0xffff0000u);
    v1[0] = __uint_as_float(w.z << 16); v1[1] = __uint_as_float(w.z & 0xffff0000u); v1[2] = __uint_as_float(w.w << 16); v1[3] = __uint_as_float(w.w & 0xffff0000u);
}

constexpr int BK = 64, HALF = 128, HTB = HALF * BK * 2;
DI int lds_byte(int r, int c) { const int st = (r >> 4) * 2 + (c >> 5), rr = r & 15, cc = c & 31, ob = rr * 64 + cc * 2; return st * 1024 + (ob ^ (((ob >> 9) & 1) << 5)); }
DI void stage_rc(int b, int& R, int& C) { const int st = b / 1024, sb = b % 1024, swz = sb ^ (((sb >> 9) & 1) << 5); R = (st >> 1) * 16 + swz / 64; C = (st & 1) * 32 + (swz % 64) / 2; }
DI int perm32(int rho) { const int n = rho >> 4, i = rho & 15; return 8 * (i >> 2) + 4 * n + (i & 3); }

struct Unit { const char* A; const char* B0; const char* B1; int kind, pm, pn; };

DI void tile_decode(int wgid, int nM, int nN, int& pm, int& pn) {
    const int nwg = nM * nN;
    { const int q = nwg / 8, r = nwg % 8, xcd = wgid % 8, off = wgid / 8; wgid = (xcd < r ? xcd * (q + 1) : r * (q + 1) + (xcd - r) * q) + off; }
    const int nig = 8 * nN, gid = wgid / nig, fm = gid * 8, gsz = (nM - fm) < 8 ? (nM - fm) : 8;
    pm = fm + ((wgid % nig) % gsz); pn = (wgid % nig) / gsz;
}

template <class Epi, class Sched>
DI void gemm_phase(LAS unsigned char* lds, const int K, const int lda, const int ldb, const Sched& S, const Epi& E) {
    const int tid = ltid(), wid = __builtin_amdgcn_readfirstlane(tid >> 6), lane = tid & 63, wr = wid >> 2, wc = wid & 3, fr = lane & 15, fq = lane >> 4;
    const int nt = K / BK;
    unsigned voffA[2], voffB[2];
#pragma unroll
    for (int i = 0; i < 2; ++i) { int R, C; stage_rc(tid * 16 + i * 8192, R, C); const int Rb = Epi::PERM ? ((R & ~31) + perm32(R & 31)) : R;
        voffA[i] = (unsigned)(R * lda + C) * 2u; voffB[i] = (unsigned)(Rb * ldb + C) * 2u; }
    const size_t kstep = (size_t)(BK * 2);
    const size_t hstepA = (size_t)HALF * lda * 2;
    const unsigned ldsw = (unsigned)wid * 1024u;
    const int aoff = lds_byte(wr * 64 + fr, fq * 8), boff = lds_byte(wc * 32 + fr, fq * 8);
#define G_SA(b, h) (((b) * 2 + (h)) * HTB)
#define G_SB(b, h) ((4 + (b) * 2 + (h)) * HTB)
#define G_STAGE(bufoff, gbase, voff) do { _Pragma("unroll") for (int _i = 0; _i < 2; ++_i) \
        __builtin_amdgcn_global_load_lds((const unsigned*)((const char*)(gbase) + (voff)[_i]), (LAS unsigned*)(lds + (bufoff) + ldsw + _i * 8192), 16, 0, 0); } while (0)
#define G_LDA(dst, b, h) do { _Pragma("unroll") for (int m = 0; m < 4; ++m) _Pragma("unroll") for (int k = 0; k < 2; ++k) dst[m][k] = *(const LAS bf16x8*)(lds + G_SA(b, h) + aoff + m * 2048 + k * 1024); } while (0)
#define G_LDB(dst, b, h) do { _Pragma("unroll") for (int n = 0; n < 2; ++n) _Pragma("unroll") for (int k = 0; k < 2; ++k) dst[n][k] = *(const LAS bf16x8*)(lds + G_SB(b, h) + boff + n * 2048 + k * 1024); } while (0)
#define G_MMA(ai, bj, At, Bt) do { __builtin_amdgcn_s_setprio(1); _Pragma("unroll") for (int m = 0; m < 4; ++m) _Pragma("unroll") for (int n = 0; n < 2; ++n) _Pragma("unroll") for (int k = 0; k < 2; ++k) \
        acc[ai][bj][m][n] = __builtin_amdgcn_mfma_f32_16x16x32_bf16(Bt[n][k], At[m][k], acc[ai][bj][m][n], 0, 0, 0); __builtin_amdgcn_s_setprio(0); } while (0)
#define G_WAIT_V(n) asm volatile("s_waitcnt vmcnt(" #n ")" ::: "memory")
#define G_WAIT_L(n) asm volatile("s_waitcnt lgkmcnt(" #n ")" ::: "memory")
#define G_BAR __builtin_amdgcn_s_barrier()
#define G_SCHED __builtin_amdgcn_sched_barrier(0)
    Unit cur, nxt; int ui = 0;
    if (!S.next(0, cur)) return;
    f32x4 acc[2][2][4][2];
#pragma unroll
    for (int a = 0; a < 2; ++a)
#pragma unroll
        for (int b = 0; b < 2; ++b)
#pragma unroll
            for (int m = 0; m < 4; ++m)
#pragma unroll
                for (int n = 0; n < 2; ++n) acc[a][b][m][n] = (f32x4){0.f, 0.f, 0.f, 0.f};
    bf16x8 At[4][2], B0[2][2], B1[2][2];
    const char* cA = cur.A; const char* cB0 = cur.B0; const char* cB1 = cur.B1;
    G_STAGE(G_SB(0, 0), cB0, voffB); G_STAGE(G_SA(0, 0), cA, voffA); G_STAGE(G_SB(0, 1), cB1, voffB); G_STAGE(G_SA(0, 1), cA + hstepA, voffA);
    if (wr == 1) G_BAR;
    G_WAIT_V(4); G_BAR;
    G_STAGE(G_SB(1, 0), cB0 + kstep, voffB); G_STAGE(G_SA(1, 0), cA + kstep, voffA); G_STAGE(G_SB(1, 1), cB1 + kstep, voffB);
    G_WAIT_V(6); G_BAR;
    for (;;) {
        const bool has_next = S.next(ui + 1, nxt);
        const char* nA = has_next ? nxt.A : cA; const char* nB0 = has_next ? nxt.B0 : cB0; const char* nB1 = has_next ? nxt.B1 : cB1;
        for (int t = 0; t < nt; t += 2) {
            const bool last = (t == nt - 2);
            const char* a1 = cA + (size_t)(t + 1) * kstep;
            const char* a2 = last ? nA : cA + (size_t)(t + 2) * kstep;
            const char* b20 = last ? nB0 : cB0 + (size_t)(t + 2) * kstep;
            const char* b21 = last ? nB1 : cB1 + (size_t)(t + 2) * kstep;
            const char* a3 = a2 + kstep; const char* b30 = b20 + kstep; const char* b31 = b21 + kstep;
            if constexpr (Epi::NHOOK > 0) { if (t == Epi::HK1 || t == Epi::HK2) E.hook(acc, cur, t, wr, wc, fr, fq); }
            G_LDB(B0, 0, 0); G_SCHED; G_LDA(At, 0, 0); G_STAGE(G_SA(1, 1), a1 + hstepA, voffA);
            G_WAIT_L(8); G_BAR; G_WAIT_L(0); G_MMA(0, 0, At, B0); G_BAR; G_SCHED;
            G_LDB(B1, 0, 1); G_STAGE(G_SB(0, 0), b20, voffB);
            G_BAR; G_WAIT_L(0); G_MMA(0, 1, At, B1); G_BAR;
            G_LDA(At, 0, 1); G_STAGE(G_SA(0, 0), a2, voffA);
            G_BAR; G_WAIT_L(0); G_MMA(1, 0, At, B0); G_BAR; G_SCHED;
            G_STAGE(G_SB(0, 1), b21, voffB);
            G_WAIT_V(6); G_BAR; G_MMA(1, 1, At, B1); G_BAR;
            G_LDB(B0, 1, 0); G_SCHED; G_LDA(At, 1, 0); G_STAGE(G_SA(0, 1), a2 + hstepA, voffA);
            G_WAIT_L(8); G_BAR; G_WAIT_L(0); G_MMA(0, 0, At, B0); G_BAR; G_SCHED;
            G_LDB(B1, 1, 1); G_STAGE(G_SB(1, 0), b30, voffB);
            G_BAR; G_WAIT_L(0); G_MMA(0, 1, At, B1); G_BAR;
            G_LDA(At, 1, 1); G_STAGE(G_SA(1, 0), a3, voffA);
            G_BAR; G_WAIT_L(0); G_MMA(1, 0, At, B0); G_BAR; G_SCHED;
            G_STAGE(G_SB(1, 1), b31, voffB);
            G_WAIT_V(6); G_BAR; G_MMA(1, 1, At, B1); G_BAR;
        }
        E(acc, cur, wr, wc, fr, fq);
        if (!has_next) break;
#pragma unroll
        for (int a = 0; a < 2; ++a)
#pragma unroll
            for (int b = 0; b < 2; ++b)
#pragma unroll
                for (int m = 0; m < 4; ++m)
#pragma unroll
                    for (int n = 0; n < 2; ++n) acc[a][b][m][n] = (f32x4){0.f, 0.f, 0.f, 0.f};
        cur = nxt; cA = nA; cB0 = nB0; cB1 = nB1; ++ui;
    }
    G_WAIT_V(0);
    if (wr == 0) G_BAR;
    G_BAR;
#undef G_SA
#undef G_SB
#undef G_STAGE
#undef G_LDA
#undef G_LDB
#undef G_MMA
#undef G_WAIT_V
#undef G_WAIT_L
#undef G_BAR
#undef G_SCHED
}

constexpr size_t ROWB = (size_t)DM * 2;
struct SchedFfnUp {
    const char* A; const char* B; int G, c;
    DI bool next(int i, Unit& u) const { const int L = i * G + c; if (L >= 64 * 44) return false; int pm, pn; tile_decode(L, 64, 44, pm, pn);
        u.A = A + (size_t)pm * 256 * ROWB; u.B0 = B + (size_t)pn * 128 * ROWB; u.B1 = u.B0 + (size_t)DFF * ROWB; u.kind = 0; u.pm = pm; u.pn = pn; return true; }
};
struct SchedPlain {
    const char* A; const char* B; int nM, nN; size_t astep, bstep; int G, c;
    DI bool next(int i, Unit& u) const { const int L = i * G + c; if (L >= nM * nN) return false; int pm, pn;
        if (nN == 8 && G == 256 && (nM & 31) == 0) { const int x = c & 7, r = c >> 3; pm = 32 * i + 4 * x + (r >> 3); pn = r & 7; }
        else tile_decode(L, nM, nN, pm, pn);
        u.A = A + (size_t)pm * astep; u.B0 = B + (size_t)pn * bstep; u.B1 = u.B0 + (bstep >> 1); u.kind = 0; u.pm = pm; u.pn = pn; return true; }
};
struct SchedWin {
    const char* xb; const char* win; const char* wft; const char* xp; const char* xm; int G, c;
    DI bool next(int i, Unit& u) const {
        int L = i * G + c; int pm, pn;
        if (L < 2176) { tile_decode(L, 64, 34, pm, pn); u.A = xb + (size_t)pm * 256 * ROWB; u.pm = pm;
            if (pn < 8) { u.kind = 0; u.pn = pn; u.B0 = win + (size_t)(pn * 128) * ROWB; u.B1 = win + (size_t)(1024 + pn * 128) * ROWB; }
            else if (pn < 10) { u.kind = 1; u.pn = pn - 8; u.B0 = win + (size_t)(2560 + 256 * (pn - 8)) * ROWB; u.B1 = u.B0 + 128 * ROWB; }
            else { u.kind = 2; u.pn = pn - 10; u.B0 = win + (size_t)(3072 + 256 * (pn - 10)) * ROWB; u.B1 = u.B0 + 128 * ROWB; }
            return true; }
        L -= 2176;
        if (L < 128) { tile_decode(L, 4, 32, pm, pn); u.kind = 3; u.pm = pm; u.pn = pn; u.A = wft + (size_t)pm * 256 * ROWB;
            u.B0 = (pm < 2 ? xp : xm) + (size_t)pn * 256 * ROWB; u.B1 = u.B0 + 128 * ROWB; return true; }
        return false;
    }
};
struct SchedKV {
    const char* memb; const char* wkv; int c;
    DI bool next(int i, Unit& u) const {
        if (i > 0 || c >= 8) return false; int pm, pn; tile_decode(c & 3, 2, 2, pm, pn); u.pm = pm; u.pn = pn;
        if (c < 4) { u.kind = 4; u.A = memb + (size_t)pm * 256 * ROWB; u.B0 = wkv + (size_t)pn * 256 * ROWB; }
        else { u.kind = 5; u.A = wkv + (size_t)(512 + pm * 256) * ROWB; u.B0 = memb + (size_t)pn * 256 * ROWB; }
        u.B1 = u.B0 + 128 * ROWB; return true; }
};
struct SchedDft {
    const char* cm; const char* tt; int G, c;
    DI bool next(int i, Unit& u) const { const int L = i * G + c; if (L >= 128) return false; int pm, pn8; tile_decode(L, 16, 8, pm, pn8);
        const int b = pn8 >> 2, p = (pn8 >> 1) & 1, pn = pn8 & 1;
        u.A = cm + (size_t)p * CM_HALF + (size_t)pm * 256 * HSEQ * 2; u.B0 = tt + ((size_t)(p * 512 + pn * 256) * SEQ + (size_t)b * HSEQ) * 2; u.B1 = u.B0 + (size_t)128 * SEQ * 2;
        u.kind = p; u.pm = b * 32 + pm; u.pn = p * 2 + pn; return true; }
};

template <int ACT>
DI void store_tile_bf16(const f32x4 (&acc)[2][2][4][2], bf16_t* out, size_t ld, int row0, int col0, const float* colbias, const float* rowbias, float scale, float cbs = 1.0f) {
    f32x4 cb[2][2];
#pragma unroll
    for (int bj = 0; bj < 2; ++bj)
#pragma unroll
        for (int n = 0; n < 2; ++n) cb[bj][n] = colbias ? *(const f32x4*)(colbias + col0 + bj * HALF + 4 * n) * cbs : (f32x4){0.f, 0.f, 0.f, 0.f};
#pragma unroll
    for (int ai = 0; ai < 2; ++ai)
#pragma unroll
        for (int m = 0; m < 4; ++m) { const int row = row0 + ai * HALF + m * 16; const float rb = rowbias ? rowbias[row] : 0.f; bf16_t* rp = out + (size_t)row * ld + col0;
#pragma unroll
            for (int bj = 0; bj < 2; ++bj) { f32x4 v0 = (acc[ai][bj][m][0] + cb[bj][0] + rb) * scale, v1 = (acc[ai][bj][m][1] + cb[bj][1] + rb) * scale;
                if (ACT == 1) {
#pragma unroll
                    for (int j = 0; j < 4; ++j) { v0[j] = sigmoidf_fast(v0[j]); v1[j] = sigmoidf_fast(v1[j]); } }
                *(u32x4*)(rp + bj * HALF) = pack8(v0, v1); } }
}
struct EpiSwiGLU {
    static constexpr bool PERM = true; static constexpr int NHOOK = 0; bf16_t* H;
    DI void operator()(const f32x4 (&acc)[2][2][4][2], const Unit& u, int wr, int wc, int fr, int fq) const {
        const int row0 = u.pm * 256 + wr * 64 + fr, col0 = u.pn * 128 + wc * 32 + 8 * fq;
#pragma unroll
        for (int ai = 0; ai < 2; ++ai)
#pragma unroll
            for (int m = 0; m < 4; ++m) { f32x4 v[2];
#pragma unroll
                for (int n = 0; n < 2; ++n) { const f32x4 a = acc[ai][0][m][n], g = acc[ai][1][m][n];
#pragma unroll
                    for (int j = 0; j < 4; ++j) v[n][j] = a[j] * g[j] * sigmoidf_fast(g[j]); }
                *(u32x4*)(H + (size_t)(row0 + ai * HALF + m * 16) * DFF + col0) = pack8(v[0], v[1]); }
    }
};
template <bool LNSRC, int BETA2> struct EpiResid {
    static constexpr bool PERM = false; static constexpr int NHOOK = 0; static constexpr float alpha = DN_ALPHA, beta = 0.5f * BETA2; const float* src; float* dst; const float* stats; const float* lng; const float* lnb;
    DI void operator()(const f32x4 (&acc)[2][2][4][2], const Unit& u, int wr, int wc, int fr, int fq) const {
        const int row0 = u.pm * 256 + wr * 64 + fr, col0 = u.pn * 256 + wc * 32 + 4 * fq;
        if constexpr (LNSRC) {
            const f32x4 g00 = *(const f32x4*)(lng + col0) * alpha, g01 = *(const f32x4*)(lng + col0 + 16) * alpha, g10 = *(const f32x4*)(lng + col0 + HALF) * alpha, g11 = *(const f32x4*)(lng + col0 + HALF + 16) * alpha;
            const f32x4 b00 = *(const f32x4*)(lnb + col0) * alpha, b01 = *(const f32x4*)(lnb + col0 + 16) * alpha, b10 = *(const f32x4*)(lnb + col0 + HALF) * alpha, b11 = *(const f32x4*)(lnb + col0 + HALF + 16) * alpha;
#pragma unroll
            for (int ai = 0; ai < 2; ++ai)
#pragma unroll
                for (int mp = 0; mp < 2; ++mp) { f32x4 sv[2][4]; float mean[2], rstd[2];
#pragma unroll
                    for (int mm = 0; mm < 2; ++mm) { const int row = row0 + ai * HALF + (2 * mp + mm) * 16; const size_t off = (size_t)row * DM + col0;
                        mean[mm] = stats[2 * row]; rstd[mm] = stats[2 * row + 1];
                        sv[mm][0] = *(const f32x4*)(src + off); sv[mm][1] = *(const f32x4*)(src + off + 16); sv[mm][2] = *(const f32x4*)(src + off + HALF); sv[mm][3] = *(const f32x4*)(src + off + HALF + 16); }
#pragma unroll
                    for (int mm = 0; mm < 2; ++mm) { const int m = 2 * mp + mm; const size_t off = (size_t)(row0 + ai * HALF + m * 16) * DM + col0;
                        *(f32x4*)(dst + off) = (sv[mm][0] - mean[mm]) * rstd[mm] * g00 + b00 + acc[ai][0][m][0] * beta;
                        *(f32x4*)(dst + off + 16) = (sv[mm][1] - mean[mm]) * rstd[mm] * g01 + b01 + acc[ai][0][m][1] * beta;
                        *(f32x4*)(dst + off + HALF) = (sv[mm][2] - mean[mm]) * rstd[mm] * g10 + b10 + acc[ai][1][m][0] * beta;
                        *(f32x4*)(dst + off + HALF + 16) = (sv[mm][3] - mean[mm]) * rstd[mm] * g11 + b11 + acc[ai][1][m][1] * beta; }
                    asm volatile("" ::: "memory"); }
        } else {
#pragma unroll
            for (int ai = 0; ai < 2; ++ai)
#pragma unroll
                for (int m = 0; m < 4; ++m) { const size_t off = (size_t)(row0 + ai * HALF + m * 16) * DM + col0;
#pragma unroll
                    for (int bj = 0; bj < 2; ++bj)
#pragma unroll
                        for (int n = 0; n < 2; ++n) { const f32x4 sv = *(const f32x4*)(src + off + bj * HALF + n * 16); *(f32x4*)(dst + off + bj * HALF + n * 16) = sv * alpha + acc[ai][bj][m][n] * beta; }
                    asm volatile("" ::: "memory"); }
        }
    }
};
struct EpiWin {
    static constexpr bool PERM = true; static constexpr int NHOOK = 0;
    const float* bin; const float* biasT; bf16_t *GLU, *Q, *Gt, *TT;
    DI void operator()(const f32x4 (&acc)[2][2][4][2], const Unit& u, int wr, int wc, int fr, int fq) const {
        const int row0 = u.pm * 256 + wr * 64 + fr, cin = wc * 32 + 8 * fq;
        if (u.kind == 0) {
            const int col0 = u.pn * 128 + cin; f32x4 bv[2], bg[2];
#pragma unroll
            for (int n = 0; n < 2; ++n) { bv[n] = *(const f32x4*)(bin + col0 + 4 * n); bg[n] = *(const f32x4*)(bin + 1024 + col0 + 4 * n); }
#pragma unroll
            for (int ai = 0; ai < 2; ++ai)
#pragma unroll
                for (int m = 0; m < 4; ++m) { f32x4 v[2];
#pragma unroll
                    for (int n = 0; n < 2; ++n) { const f32x4 a = acc[ai][0][m][n] + bv[n], g = acc[ai][1][m][n] + bg[n];
#pragma unroll
                        for (int j = 0; j < 4; ++j) v[n][j] = a[j] * sigmoidf_fast(g[j]); }
                    *(u32x4*)(GLU + (size_t)(row0 + ai * HALF + m * 16) * 1024 + col0) = pack8(v[0], v[1]); }
        } else if (u.kind == 1) store_tile_bf16<0>(acc, Q, 512, row0, u.pn * 256 + cin, bin + 2560, nullptr, 0.08838834764831845f);
        else if (u.kind == 2) store_tile_bf16<1>(acc, Gt, 6144, row0, u.pn * 256 + cin, bin + 3072, nullptr, 1.0f);
        else {
            const bool cosr = u.pm < 2; const int col0 = u.pn * 256 + cin;
#pragma unroll
            for (int ai = 0; ai < 2; ++ai)
#pragma unroll
                for (int m = 0; m < 4; ++m) { const int row = row0 + ai * HALF + m * 16; const float rb = cosr ? biasT[row] : 0.f;
#pragma unroll
                    for (int bj = 0; bj < 2; ++bj) { f32x4 v0 = acc[ai][bj][m][0] + 2.0f * rb, v1 = acc[ai][bj][m][1] + 2.0f * rb;
                        if (((col0 + bj * HALF) & (HSEQ - 1)) == 0) v0[0] -= rb;
                        *(u32x4*)(TT + (size_t)row * SEQ + col0 + bj * HALF) = pack8(v0, v1); } }
        }
    }
};
struct EpiKV {
    static constexpr bool PERM = true; static constexpr int NHOOK = 0; bf16_t *KK, *VT;
    DI void operator()(const f32x4 (&acc)[2][2][4][2], const Unit& u, int wr, int wc, int fr, int fq) const {
        store_tile_bf16<0>(acc, u.kind == 4 ? KK : VT, 512, u.pm * 256 + wr * 64 + fr, u.pn * 256 + wc * 32 + 8 * fq, nullptr, nullptr, 1.0f);
    }
};
struct EpiDft {
    static constexpr bool PERM = true; static constexpr int NHOOK = 0; bf16_t* out; const float* uh;
    DI void operator()(const f32x4 (&acc)[2][2][4][2], const Unit& u, int wr, int wc, int fr, int fq) const {
        const int b = u.pm >> 5, k0 = (u.pm & 31) * 256 + wr * 64 + fr, col0 = u.pn * 256 + wc * 32 + 8 * fq;
        const float sgn = (fr & 1) ? -1.0f : 1.0f; const unsigned flip = u.kind ? 0x80008000u : 0u;
        f32x4 cb[2][2];
#pragma unroll
        for (int bj = 0; bj < 2; ++bj)
#pragma unroll
            for (int n = 0; n < 2; ++n) cb[bj][n] = (u.kind == 0) ? *(const f32x4*)(uh + b * 512 + col0 + bj * HALF + 4 * n) * sgn : (f32x4){0.f, 0.f, 0.f, 0.f};
#pragma unroll
        for (int ai = 0; ai < 2; ++ai)
#pragma unroll
            for (int m = 0; m < 4; ++m) { const int k = k0 + ai * HALF + m * 16;
                bf16_t* rp = out + (size_t)(b * SEQ + k) * KBR + col0; bf16_t* rq = out + (size_t)(b * SEQ + SEQ - k) * KBR + col0;
#pragma unroll
                for (int bj = 0; bj < 2; ++bj) { u32x4 w = pack8(acc[ai][bj][m][0] + cb[bj][0], acc[ai][bj][m][1] + cb[bj][1]);
                    *(u32x4*)(rp + bj * HALF) = w;
                    if (k != 0) { w.x ^= flip; w.y ^= flip; w.z ^= flip; w.w ^= flip; *(u32x4*)(rq + bj * HALF) = w; } } }
    }
};
struct EpiPlainBf16 {
    static constexpr bool PERM = true; static constexpr int NHOOK = 0; bf16_t* out; int ld;
    DI void operator()(const f32x4 (&acc)[2][2][4][2], const Unit& u, int wr, int wc, int fr, int fq) const {
        store_tile_bf16<0>(acc, out, (size_t)ld, u.pm * 256 + wr * 64 + fr, u.pn * 256 + wc * 32 + 8 * fq, nullptr, nullptr, 1.0f);
    }
};
struct EpiBranchFused {
    static constexpr bool PERM = true; static constexpr int NHOOK = 2, HK1 = 16, HK2 = 32; const bf16_t* Gt; bf16_t* MG;
    DI void hook(f32x4 (&acc)[2][2][4][2], const Unit& u, int t, int wr, int wc, int fr, int fq) const {
        const int sgm = (t == HK1) ? 0 : 1;
        asm volatile("" : "+v"(fr), "+v"(fq));
        const int row0 = u.pm * 256 + wr * 64 + fr, col0 = u.pn * 256 + wc * 32 + 8 * fq;
#pragma unroll
        for (int ai = 0; ai < 2; ++ai) {
            u32x4 ga[4][2], gb[4][2];
#pragma unroll
            for (int m = 0; m < 4; ++m) { const bf16_t* gp = Gt + (size_t)(row0 + ai * HALF + m * 16) * 6144 + sgm * DM + col0;
#pragma unroll
                for (int bj = 0; bj < 2; ++bj) { ga[m][bj] = *(const u32x4*)(gp + bj * HALF); gb[m][bj] = *(const u32x4*)(gp + DM + bj * HALF); } }
#pragma unroll
            for (int m = 0; m < 4; ++m)
#pragma unroll
                for (int bj = 0; bj < 2; ++bj) { f32x4 a0, a1, b0, b1; unpack8(ga[m][bj], a0, a1); unpack8(gb[m][bj], b0, b1);
#pragma unroll
                    for (int j = 0; j < 4; ++j) { acc[ai][bj][m][0][j] *= a0[j] * __builtin_amdgcn_rcpf(b0[j]); acc[ai][bj][m][1][j] *= a1[j] * __builtin_amdgcn_rcpf(b1[j]); } }
            asm volatile("" ::: "memory");
        }
    }
    DI void operator()(const f32x4 (&acc)[2][2][4][2], const Unit& u, int wr, int wc, int fr, int fq) const {
        const int row0 = u.pm * 256 + wr * 64 + fr, col0 = u.pn * 256 + wc * 32 + 8 * fq;
#pragma unroll
        for (int ai = 0; ai < 2; ++ai) {
            u32x4 gg[4][2];
#pragma unroll
            for (int m = 0; m < 4; ++m)
#pragma unroll
                for (int bj = 0; bj < 2; ++bj) gg[m][bj] = *(const u32x4*)(Gt + (size_t)(row0 + ai * HALF + m * 16) * 6144 + 2 * DM + col0 + bj * HALF);
#pragma unroll
            for (int m = 0; m < 4; ++m)
#pragma unroll
                for (int bj = 0; bj < 2; ++bj) { f32x4 g0, g1; unpack8(gg[m][bj], g0, g1);
                    *(u32x4*)(MG + (size_t)(row0 + ai * HALF + m * 16) * DM + col0 + bj * HALF) = pack8(g0 * acc[ai][bj][m][0], g1 * acc[ai][bj][m][1]); }
            asm volatile("" ::: "memory");
        }
    }
};

DI void transpose_item(const float* W, int N, bf16_t* WT, int ldo, int row_off, int koff, LAS float* scr, int item, int lane) {
    const int nblk = N / 32, kb = item / nblk, nb = item % nblk, k0 = 64 * kb, n0 = 32 * nb;
    f32x4 v[8];
    { const float* wp = W + (size_t)(k0 + (lane >> 3)) * N + n0 + 4 * (lane & 7);
#pragma unroll
      for (int i = 0; i < 8; ++i) v[i] = *(const f32x4*)(wp + (size_t)(8 * i) * N); }
#pragma unroll
    for (int i = 0; i < 8; ++i) { LAS float* d = scr + (8 * i + (lane >> 3)) * 33 + 4 * (lane & 7); d[0] = v[i][0]; d[1] = v[i][1]; d[2] = v[i][2]; d[3] = v[i][3]; }
    asm volatile("s_waitcnt lgkmcnt(0)" ::: "memory");
    const int c = lane & 7;
#pragma unroll
    for (int j = 0; j < 4; ++j) { const int n = (lane >> 3) + 8 * j; const LAS float* s = scr + (8 * c) * 33 + n;
        u32x4 o; o.x = pk2(s[0 * 33], s[1 * 33]); o.y = pk2(s[2 * 33], s[3 * 33]); o.z = pk2(s[4 * 33], s[5 * 33]); o.w = pk2(s[6 * 33], s[7 * 33]);
        *(u32x4*)(WT + (size_t)(row_off + n0 + n) * ldo + koff + k0 + 8 * c) = o; }
    asm volatile("s_waitcnt lgkmcnt(0)" ::: "memory");
}

struct Params { const float* in[23]; float* out; unsigned char* ws; int ph_lo, ph_hi; };

DI void convert_weights(const Params& P, int l, LAS unsigned char* lds) {
    const int tid = ltid(), lane = tid & 63, wid = tid >> 6;
    unsigned char* ws = P.ws;
    LAS float* scr = (LAS float*)(lds + wid * 8448);
    const int gw = blockIdx.x * 8 + wid, NGW = gridDim.x * 8;
    constexpr int I13 = 32 * 352, I2 = 88 * 64, IIN = 32 * 288, ICO = 16 * 64, IF = 8 * 64, IKV = 32 * 32, IO = 8 * 64, IOUT = 32 * 64;
    constexpr int NITEMS = 2 * I13 + 2 * I2 + IIN + ICO + 2 * IF + IKV + IO + IOUT;
    const float* w13a = P.in[2] + (size_t)l * DM * 2 * DFF; const float* w2a = P.in[3] + (size_t)l * DFF * DM;
    const float* win = P.in[6] + (size_t)l * DM * DIN; const float* wco = P.in[12] + (size_t)l * 1024 * DM; const float* wf = P.in[13] + (size_t)l * 512 * DM;
    const float* wkv = P.in[14] + (size_t)l * DM * 1024; const float* wo = P.in[15] + (size_t)l * 512 * DM; const float* wout = P.in[16] + (size_t)l * DM * DM;
    const float* w13b = P.in[19] + (size_t)l * DM * 2 * DFF; const float* w2b = P.in[20] + (size_t)l * DFF * DM;
    for (int it = gw; it < NITEMS; it += NGW) {
        int r = it;
        if (r < I13) { transpose_item(w13a, 2 * DFF, (bf16_t*)(ws + WS_W13A), DM, 0, 0, scr, r, lane); continue; } r -= I13;
        if (r < I13) { transpose_item(w13b, 2 * DFF, (bf16_t*)(ws + WS_W13B), DM, 0, 0, scr, r, lane); continue; } r -= I13;
        if (r < I2) { transpose_item(w2a, DM, (bf16_t*)(ws + WS_W2A), DFF, 0, 0, scr, r, lane); continue; } r -= I2;
        if (r < I2) { transpose_item(w2b, DM, (bf16_t*)(ws + WS_W2B), DFF, 0, 0, scr, r, lane); continue; } r -= I2;
        if (r < IIN) { transpose_item(win, DIN, (bf16_t*)(ws + WS_WIN), DM, 0, 0, scr, r, lane); continue; } r -= IIN;
        if (r < ICO) { transpose_item(wco, DM, (bf16_t*)(ws + WS_WBR), KBR, 0, 0, scr, r, lane); continue; } r -= ICO;
        if (r < IF) { transpose_item(wf, DM, (bf16_t*)(ws + WS_WBR), KBR, 0, 1024, scr, r, lane); continue; } r -= IF;
        if (r < IF) { transpose_item(wf, DM, (bf16_t*)(ws + WS_WBR), KBR, 0, 1536, scr, r, lane); continue; } r -= IF;
        if (r < IKV) { transpose_item(wkv, 1024, (bf16_t*)(ws + WS_WKV), DM, 0, 0, scr, r, lane); continue; } r -= IKV;
        if (r < IO) { transpose_item(wo, DM, (bf16_t*)(ws + WS_WBR), KBR, 0, 2048, scr, r, lane); continue; } r -= IO;
        transpose_item(wout, DM, (bf16_t*)(ws + WS_WOUT), DM, 0, 0, scr, r, lane);
    }
    __syncthreads();
    {
        LAS float* tile = (LAS float*)lds;
        LAS float* tabc = tile + 32 * 129; LAS float* tabs = tabc + 128;
        const float* bin = P.in[7] + (size_t)l * DIN;
        bf16_t* WFT = (bf16_t*)(ws + WS_WFT); float* biasT = (float*)(ws + WS_BIAST);
        if (tid < 128) { float sn, cs; sincospif((float)tid * (1.0f / 64.0f), &sn, &cs); tabc[tid] = cs * 0.08838834764831845f; tabs[tid] = sn * 0.08838834764831845f; }
        for (int item = blockIdx.x; item < 256; item += gridDim.x) {
            const int kb = item >> 2, g = item & 3;
            __syncthreads();
            for (int idx = tid; idx < 32 * 128; idx += 512) { const int kk = idx >> 7, j = idx & 127; tile[kk * 129 + j] = win[(size_t)(kb * 32 + kk) * DIN + 2048 + g * 128 + j]; }
            __syncthreads();
            const int k = tid & 31, ccb = (tid >> 5) * 8;
            float ac[8], as[8];
#pragma unroll
            for (int c8 = 0; c8 < 8; ++c8) { ac[c8] = 0.f; as[c8] = 0.f; }
            for (int j = 0; j < 128; ++j) { const float w = tile[k * 129 + j];
#pragma unroll
                for (int c8 = 0; c8 < 8; ++c8) { const int idx = (j * (ccb + c8)) & 127; ac[c8] += w * tabc[idx]; as[c8] += w * tabs[idx]; } }
#pragma unroll
            for (int c8 = 0; c8 < 8; ++c8) { WFT[(size_t)(g * 128 + ccb + c8) * DM + kb * 32 + k] = f2bf(ac[c8]); WFT[(size_t)(512 + g * 128 + ccb + c8) * DM + kb * 32 + k] = f2bf(as[c8]); }
            if (kb == 0 && tid < 128) { float bc = 0.f, bs = 0.f;
                for (int j = 0; j < 128; ++j) { const float w = bin[2048 + g * 128 + j]; const int idx = (j * tid) & 127; bc += w * tabc[idx]; bs += w * tabs[idx]; }
                biasT[g * 128 + tid] = bc; biasT[512 + g * 128 + tid] = bs; }
        }
        __syncthreads();
    }
}

DI void setup_phase(const Params& P, LAS unsigned char* lds) {
    const int tid = ltid(); unsigned char* ws = P.ws;
    const size_t gt = (size_t)blockIdx.x * 512 + tid, ngt = (size_t)gridDim.x * 512;
    { const f32x4* src = (const f32x4*)P.in[0]; u32x4* dst = (u32x4*)(ws + WS_XB);
      for (size_t i = gt; i < (size_t)NTOK * DM / 8; i += ngt) dst[i] = pack8(src[2 * i], src[2 * i + 1]); }
    { const f32x4* src = (const f32x4*)P.in[1]; u32x4* dst = (u32x4*)(ws + WS_MEMB);
      for (size_t i = gt; i < (size_t)512 * DM / 8; i += ngt) dst[i] = pack8(src[2 * i], src[2 * i + 1]); }
    bf16_t* cm0 = (bf16_t*)(ws + WS_CM); bf16_t* cm1 = (bf16_t*)(ws + WS_CM + CM_HALF);
    for (int j = blockIdx.x; j < HSEQ; j += gridDim.x) {
        f32x4 c0, c1, s0, s1;
#pragma unroll
        for (int e = 0; e < 8; ++e) { const float x = (float)((j * (tid * 8 + e)) & (SEQ - 1)) * (1.0f / 8192.0f);
            const float cv = __builtin_amdgcn_cosf(x) * 0.011048543456039806f, sv = __builtin_amdgcn_sinf(x) * -0.011048543456039806f;
            if (e < 4) { c0[e] = cv; s0[e] = sv; } else { c1[e - 4] = cv; s1[e - 4] = sv; } }
        *(u32x4*)(cm0 + (size_t)j * HSEQ + tid * 8) = pack8(c0, c1); *(u32x4*)(cm1 + (size_t)j * HSEQ + tid * 8) = pack8(s0, s1);
    }
}

DI void ln_phase(float* X, bf16_t* XB, float* stats, const float* g, const float* bta, bool final_out) {
    const int tid = ltid(), lane = tid & 63, gw = blockIdx.x * 8 + (tid >> 6), ngw = gridDim.x * 8;
    f32x4 gv[8], bv[8];
#pragma unroll
    for (int j = 0; j < 8; ++j) { gv[j] = ((const f32x4*)g)[64 * j + lane]; bv[j] = ((const f32x4*)bta)[64 * j + lane]; }
    f32x4 na[8], nb[8];
    { const f32x4* xa = (const f32x4*)(X + (size_t)gw * DM) + lane; const f32x4* xq = (const f32x4*)(X + (size_t)(gw + ngw) * DM) + lane;
#pragma unroll
      for (int j = 0; j < 8; ++j) { na[j] = xa[64 * j]; nb[j] = xq[64 * j]; } }
    for (int row = gw; row < NTOK; row += 2 * ngw) {
        const int rowb = row + ngw;
        f32x4 va[8], vb[8];
#pragma unroll
        for (int j = 0; j < 8; ++j) { va[j] = na[j]; vb[j] = nb[j]; }
        if (row + 2 * ngw < NTOK) { const f32x4* xa = (const f32x4*)(X + (size_t)(row + 2 * ngw) * DM) + lane; const f32x4* xq = (const f32x4*)(X + (size_t)(row + 3 * ngw) * DM) + lane;
#pragma unroll
            for (int j = 0; j < 8; ++j) { na[j] = xa[64 * j]; nb[j] = xq[64 * j]; } }
        float sa = 0.f, sb = 0.f;
#pragma unroll
        for (int j = 0; j < 8; ++j) { sa += (va[j][0] + va[j][1]) + (va[j][2] + va[j][3]); sb += (vb[j][0] + vb[j][1]) + (vb[j][2] + vb[j][3]); }
        sa += shx<1>(sa); sb += shx<1>(sb); sa += shx<2>(sa); sb += shx<2>(sb); sa += shx<4>(sa); sb += shx<4>(sb);
        sa += shx<8>(sa); sb += shx<8>(sb); sa += shx<16>(sa); sb += shx<16>(sb); sa += shx<32>(sa); sb += shx<32>(sb);
        const float ma = sa * (1.0f / DM), mb = sb * (1.0f / DM); float qa = 0.f, qb = 0.f;
#pragma unroll
        for (int j = 0; j < 8; ++j) { va[j] = va[j] - ma; vb[j] = vb[j] - mb;
            qa += (va[j][0] * va[j][0] + va[j][1] * va[j][1]) + (va[j][2] * va[j][2] + va[j][3] * va[j][3]); qb += (vb[j][0] * vb[j][0] + vb[j][1] * vb[j][1]) + (vb[j][2] * vb[j][2] + vb[j][3] * vb[j][3]); }
        qa += shx<1>(qa); qb += shx<1>(qb); qa += shx<2>(qa); qb += shx<2>(qb); qa += shx<4>(qa); qb += shx<4>(qb);
        qa += shx<8>(qa); qb += shx<8>(qb); qa += shx<16>(qa); qb += shx<16>(qb); qa += shx<32>(qa); qb += shx<32>(qb);
        const float ra = 1.0f / sqrtf(qa * (1.0f / DM) + LN_EPS), rb = 1.0f / sqrtf(qb * (1.0f / DM) + LN_EPS);
        if (final_out) {
            f32x4* xa = (f32x4*)(X + (size_t)row * DM) + lane; f32x4* xq = (f32x4*)(X + (size_t)rowb * DM) + lane;
#pragma unroll
            for (int j = 0; j < 8; ++j) { xa[64 * j] = va[j] * ra * gv[j] + bv[j]; xq[64 * j] = vb[j] * rb * gv[j] + bv[j]; }
        } else {
            if (lane == 0) { f32x2 st = {ma, ra}; *(f32x2*)(stats + 2 * row) = st; st[0] = mb; st[1] = rb; *(f32x2*)(stats + 2 * rowb) = st; }
            u32x2* oa = (u32x2*)(XB + (size_t)row * DM) + lane; u32x2* ob = (u32x2*)(XB + (size_t)rowb * DM) + lane;
#pragma unroll
            for (int j = 0; j < 8; ++j) { const f32x4 ya = va[j] * ra * gv[j] + bv[j], yb = vb[j] * rb * gv[j] + bv[j]; u32x2 w; w.x = pk2(ya[0], ya[1]); w.y = pk2(ya[2], ya[3]); oa[64 * j] = w; w.x = pk2(yb[0], yb[1]); w.y = pk2(yb[2], yb[3]); ob[64 * j] = w; }
        }
    }
}

DI void ln_row(f32x4 (&v)[8], const f32x4 (&gv)[8], const f32x4 (&bv)[8], float* stats, int row, bf16_t* XB, int lane) {
    float s = 0.f;
#pragma unroll
    for (int j = 0; j < 8; ++j) s += (v[j][0] + v[j][1]) + (v[j][2] + v[j][3]);
    const float mean = wave_sum(s) * (1.0f / DM); float s2 = 0.f;
#pragma unroll
    for (int j = 0; j < 8; ++j) { v[j] = v[j] - mean; s2 += (v[j][0] * v[j][0] + v[j][1] * v[j][1]) + (v[j][2] * v[j][2] + v[j][3] * v[j][3]); }
    const float rstd = 1.0f / sqrtf(wave_sum(s2) * (1.0f / DM) + LN_EPS);
    if (lane == 0) { f32x2 st = {mean, rstd}; *(f32x2*)(stats + 2 * row) = st; }
    u32x2* ob = (u32x2*)(XB + (size_t)row * DM) + lane;
#pragma unroll
    for (int j = 0; j < 8; ++j) { v[j] = v[j] * rstd * gv[j] + bv[j]; u32x2 w; w.x = pk2(v[j][0], v[j][1]); w.y = pk2(v[j][2], v[j][3]); ob[64 * j] = w; }
}
DI void ln_fold_phase(const float* X, bf16_t* XB, bf16_t* XP, bf16_t* XM, float* stats, const float* g, const float* bta, int vb) {
    const int tid = ltid(), lane = tid & 63, wv = (vb - 8) * 8 + (tid >> 6), nwv = ((int)gridDim.x - 8) * 8;
    f32x4 gv[8], bv[8];
#pragma unroll
    for (int j = 0; j < 8; ++j) { gv[j] = ((const f32x4*)g)[64 * j + lane]; bv[j] = ((const f32x4*)bta)[64 * j + lane]; }
    for (int it = wv; it < 2 * (HSEQ + 1); it += nwv) {
        const int b = it / (HSEQ + 1), i = it - b * (HSEQ + 1);
        const bool pair = (i != 0) && (i != HSEQ);
        const int rowA = b * SEQ + i, rowB = b * SEQ + (SEQ - i);
        f32x4 va[8], vb[8];
        { const f32x4* xa = (const f32x4*)(X + (size_t)rowA * DM) + lane;
#pragma unroll
          for (int j = 0; j < 8; ++j) va[j] = xa[64 * j]; }
        if (pair) { const f32x4* xq = (const f32x4*)(X + (size_t)rowB * DM) + lane;
#pragma unroll
            for (int j = 0; j < 8; ++j) vb[j] = xq[64 * j]; }
        else {
#pragma unroll
            for (int j = 0; j < 8; ++j) vb[j] = (f32x4){0.f, 0.f, 0.f, 0.f}; }
        ln_row(va, gv, bv, stats, rowA, XB, lane);
        if (pair) ln_row(vb, gv, bv, stats, rowB, XB, lane);
        if (i != HSEQ) {
            u32x2* op = (u32x2*)(XP + (size_t)(b * HSEQ + i) * DM) + lane; u32x2* om = (u32x2*)(XM + (size_t)(b * HSEQ + i) * DM) + lane;
#pragma unroll
            for (int j = 0; j < 8; ++j) { f32x4 p = va[j], m = {0.f, 0.f, 0.f, 0.f}; if (pair) { p = va[j] + vb[j]; m = va[j] - vb[j]; }
                u32x2 w; w.x = pk2(p[0], p[1]); w.y = pk2(p[2], p[3]); op[64 * j] = w; w.x = pk2(m[0], m[1]); w.y = pk2(m[2], m[3]); om[64 * j] = w; }
        }
    }
}

constexpr int CT = 16, CROWS = CT + 30;
DI void conv_tile(const bf16_t* GLU, bf16_t* CV, const float* cw, const float* cb, const float* lg, const float* lb, int tile, LAS unsigned char* lds) {
    const int tid = ltid(), lane = tid & 63, wid = __builtin_amdgcn_readfirstlane(tid >> 6);
    const int tok0 = tile * CT, b = tok0 >> 13, s0 = tok0 & (SEQ - 1);
    LAS unsigned char* ldst = lds + tid * 4;
    asm volatile("" : "+v"(ldst));
    asm volatile("" : "+s"(GLU), "+s"(CV), "+s"(cw), "+s"(cb), "+s"(lg), "+s"(lb));
    __syncthreads();
    for (int idx = tid; idx < CROWS * 128; idx += 512) { const int rr = idx >> 7, c16 = idx & 127, s = s0 - 15 + rr; u32x4 v = {0u, 0u, 0u, 0u};
        if (s >= 0 && s < SEQ) v = *(const u32x4*)(GLU + ((size_t)(b * SEQ + s)) * 1024 + c16 * 8);
        *(LAS u32x4*)(lds + rr * 2048 + c16 * 16) = v; }
    __syncthreads();
    float w0[31], w1[31];
#pragma unroll
    for (int j = 0; j < 31; ++j) { const f32x2 w = *(const f32x2*)(cw + j * 1024 + 2 * tid); w0[j] = w[0]; w1[j] = w[1]; }
    float a0[CT], a1[CT];
#pragma unroll
    for (int t = 0; t < CT; ++t) { a0[t] = 0.f; a1[t] = 0.f; }
    unsigned vnext = *(const LAS unsigned*)ldst;
#pragma unroll
    for (int rr = 0; rr < CROWS; ++rr) { const unsigned v = vnext; if (rr + 1 < CROWS) vnext = *(const LAS unsigned*)(ldst + (rr + 1) * 2048);
        asm volatile("" ::: "memory");
        const float x0 = __uint_as_float(v << 16), x1 = __uint_as_float(v & 0xffff0000u);
#pragma unroll
        for (int t = 0; t < CT; ++t) { const int j = rr - t; if (j >= 0 && j <= 30) { a0[t] += x0 * w0[j]; a1[t] += x1 * w1[j]; } } }
    const f32x2 cbv = *(const f32x2*)(cb + 2 * tid);
    __syncthreads();
    { LAS float* yw = (LAS float*)lds + 2 * tid;
      asm volatile("" : "+v"(yw));
#pragma unroll
      for (int t = 0; t < CT; ++t) { f32x2 y = {a0[t] + cbv[0], a1[t] + cbv[1]}; *(LAS f32x2*)(yw + t * 1024) = y; } }
    __syncthreads();
    {
        f32x4 gv[4], bv[4];
#pragma unroll
        for (int i = 0; i < 4; ++i) { gv[i] = *(const f32x4*)(lg + 4 * lane + 256 * i); bv[i] = *(const f32x4*)(lb + 4 * lane + 256 * i); }
#pragma unroll
        for (int tt = 0; tt < 2; ++tt) { const int t = 2 * wid + tt; const LAS float* yr = (const LAS float*)lds + t * 1024 + 4 * lane;
            f32x4 v[4]; float s = 0.f;
#pragma unroll
            for (int i = 0; i < 4; ++i) { v[i] = *(const LAS f32x4*)(yr + 256 * i); s += (v[i][0] + v[i][1]) + (v[i][2] + v[i][3]); }
            const float mean = wave_sum(s) * (1.0f / 1024.0f); float s2 = 0.f;
#pragma unroll
            for (int i = 0; i < 4; ++i) { v[i] = v[i] - mean; s2 += (v[i][0] * v[i][0] + v[i][1] * v[i][1]) + (v[i][2] * v[i][2] + v[i][3] * v[i][3]); }
            const float rstd = 1.0f / sqrtf(wave_sum(s2) * (1.0f / 1024.0f) + LN_EPS);
            bf16_t* op = CV + (size_t)(tok0 + t) * KBR + 4 * lane;
#pragma unroll
            for (int i = 0; i < 4; ++i) { f32x4 y = v[i] * rstd * gv[i] + bv[i];
#pragma unroll
                for (int j = 0; j < 4; ++j) y[j] *= sigmoidf_fast(y[j]);
                u32x2 w; w.x = pk2(y[0], y[1]); w.y = pk2(y[2], y[3]); *(u32x2*)(op + 256 * i) = w; } }
    }
}

DI void attn_unit(const bf16_t* Q, const bf16_t* KK, const bf16_t* VT, bf16_t* OO, int b, int h, int qt, LAS unsigned char* lds) {
    const int tid = ltid(), lane = tid & 63, wid = __builtin_amdgcn_readfirstlane(tid >> 6), r = lane & 31, h2 = lane >> 5;
    const int tok0 = b * SEQ + qt * 256 + wid * 32;
    asm volatile("" : "+s"(Q), "+s"(KK), "+s"(VT), "+s"(OO));
    LAS unsigned char* ldsK = lds; LAS unsigned char* ldsV = lds + 65536;
    __syncthreads();
#pragma unroll
    for (int i = 0; i < 8; ++i) { const int id = i * 512 + tid, row = id >> 4, ch = id & 15;
        const u32x4 v = *(const u32x4*)(KK + (size_t)(b * 256 + row) * 512 + h * 128 + ch * 8);
        *(LAS u32x4*)(ldsK + row * 256 + ((ch ^ (row & 15)) << 4)) = v; }
#pragma unroll
    for (int i = 0; i < 8; ++i) { const int id = i * 512 + tid, row = id >> 5, ch = id & 31;
        const u32x4 v = *(const u32x4*)(VT + (size_t)(h * 128 + row) * 512 + b * 256 + ch * 8);
        *(LAS u32x4*)(ldsV + row * 512 + ((ch ^ (row & 31)) << 4)) = v; }
    bf16x8 qf[8];
    { const bf16_t* qp = Q + (size_t)(tok0 + r) * 512 + h * 128 + 8 * h2;
#pragma unroll
      for (int s = 0; s < 8; ++s) qf[s] = *(const bf16x8*)(qp + 16 * s); }
    __syncthreads();
    f32x16 sacc[8];
    { const LAS unsigned char* kbase = ldsK + r * 256; const int rx = r & 15;
#pragma unroll
      for (int kb = 0; kb < 8; ++kb) {
#pragma unroll
        for (int i = 0; i < 16; ++i) sacc[kb][i] = 0.f;
#pragma unroll
        for (int s = 0; s < 8; ++s) { const bf16x8 kf = *(const LAS bf16x8*)(kbase + kb * 8192 + (((2 * s + h2) ^ rx) << 4)); sacc[kb] = __builtin_amdgcn_mfma_f32_32x32x16_bf16(kf, qf[s], sacc[kb], 0, 0, 0); }
      } }
    float mx = -3.0e38f;
#pragma unroll
    for (int kb = 0; kb < 8; ++kb)
#pragma unroll
        for (int i = 0; i < 16; ++i) mx = fmaxf(mx, sacc[kb][i]);
    mx = fmaxf(mx, __shfl_xor(mx, 32));
    float sum = 0.f;
#pragma unroll
    for (int kb = 0; kb < 8; ++kb)
#pragma unroll
        for (int i = 0; i < 16; ++i) { const float p = __expf(sacc[kb][i] - mx); sacc[kb][i] = p; sum += p; }
    sum += __shfl_xor(sum, 32);
    const float inv = 1.0f / sum;
    f32x16 oacc[4];
#pragma unroll
    for (int db = 0; db < 4; ++db)
#pragma unroll
        for (int i = 0; i < 16; ++i) oacc[db][i] = 0.f;
    { const LAS unsigned char* vbase = ldsV + r * 512 + h2 * 8;
#pragma unroll
      for (int kb = 0; kb < 8; ++kb)
#pragma unroll
        for (int s2 = 0; s2 < 2; ++s2) {
            u32x4 pw; pw.x = pk2(sacc[kb][8 * s2 + 0], sacc[kb][8 * s2 + 1]); pw.y = pk2(sacc[kb][8 * s2 + 2], sacc[kb][8 * s2 + 3]);
            pw.z = pk2(sacc[kb][8 * s2 + 4], sacc[kb][8 * s2 + 5]); pw.w = pk2(sacc[kb][8 * s2 + 6], sacc[kb][8 * s2 + 7]);
            const bf16x8 pf = __builtin_bit_cast(bf16x8, pw);
            const int c0 = 4 * kb + 2 * s2;
#pragma unroll
            for (int db = 0; db < 4; ++db) {
                const u32x2 lo = *(const LAS u32x2*)(vbase + db * 16384 + ((c0 ^ r) << 4)), hi = *(const LAS u32x2*)(vbase + db * 16384 + (((c0 + 1) ^ r) << 4));
                u32x4 vw; vw.x = lo.x; vw.y = lo.y; vw.z = hi.x; vw.w = hi.y;
                oacc[db] = __builtin_amdgcn_mfma_f32_32x32x16_bf16(__builtin_bit_cast(bf16x8, vw), pf, oacc[db], 0, 0, 0);
            }
        } }
    bf16_t* op = OO + (size_t)(tok0 + r) * KBR + h * 128 + 4 * h2;
#pragma unroll
    for (int db = 0; db < 4; ++db)
#pragma unroll
        for (int g = 0; g < 4; ++g) { u32x2 w; w.x = pk2(oacc[db][4 * g] * inv, oacc[db][4 * g + 1] * inv); w.y = pk2(oacc[db][4 * g + 2] * inv, oacc[db][4 * g + 3] * inv);
            *(u32x2*)(op + db * 32 + 8 * g) = w; }
}

#define XB_TMO      128
#define XB_XCNT(j)  (256  + 64 * (j))
#define XB_XSUB(j)  (1280 + 64 * (j))
#define XB_XGEN(j)  (2304 + 64 * (j))
#define XB_TOP      3328
#define XB_TOPGEN   3392
#define XCD_BAR_WORDS 3456
#define XB_SPIN_CAP (1u << 18)

__device__ __forceinline__ unsigned xb_ld(unsigned* p)              { return __hip_atomic_load(p, __ATOMIC_RELAXED, __HIP_MEMORY_SCOPE_AGENT); }
__device__ __forceinline__ unsigned xb_add(unsigned* p, unsigned v) { return __hip_atomic_fetch_add(p, v, __ATOMIC_RELAXED, __HIP_MEMORY_SCOPE_AGENT); }
__device__ __forceinline__ unsigned xb_xcc_id() { return (unsigned)__builtin_amdgcn_s_getreg((3 << 11) | 20) & 0xFu; }
#define XB_SPIN(cond, bar) do { unsigned _sp = 0; while (cond) { __builtin_amdgcn_s_sleep(1); \
    if ((++_sp & 255u) == 0u) { if (xb_ld(&(bar)[XB_TMO])) break; if (_sp > XB_SPIN_CAP) { atomicAdd(&(bar)[XB_TMO], 1u); break; } } } } while (0)

struct XcdBarrier {
    unsigned* bar; unsigned x;
    volatile LAS unsigned* st;
};

__device__ __forceinline__ XcdBarrier xcd_barrier_post(unsigned* bar, volatile LAS unsigned* st) {
    XcdBarrier b; b.bar = bar; b.x = xb_xcc_id(); b.st = st;
    if (threadIdx.x == 0) (void)xb_add(&bar[XB_XCNT(b.x)], 1u);
    return b;
}
__device__ __forceinline__ void xcd_barrier_complete(unsigned* bar, unsigned x, unsigned& nloc, unsigned& nx) {
    const unsigned G = gridDim.x * gridDim.y * gridDim.z;
    unsigned sum, cnt, mine, sp = 0u;
    for (;;) {
        sum = 0u; cnt = 0u; mine = 0u;
#pragma unroll
        for (unsigned j = 0; j < 16; ++j) { const unsigned c = xb_ld(&bar[XB_XCNT(j)]); sum += c; cnt += (c > 0u) ? 1u : 0u; mine = (j == x) ? c : mine; }
        if (sum == G) break;
        __builtin_amdgcn_s_sleep(1);
        if ((++sp & 255u) == 0u) { if (xb_ld(&bar[XB_TMO])) break; if (sp > XB_SPIN_CAP) { atomicAdd(&bar[XB_TMO], 1u); break; } }
    }
    nloc = mine > 0u ? mine : 1u; nx = cnt > 0u ? cnt : 1u;
}

__device__ __forceinline__ void xcd_barrier(const XcdBarrier& b) {
    asm volatile("s_waitcnt vmcnt(0)" ::: "memory");
    __syncthreads();
    if (threadIdx.x == 0) {
        unsigned* bar = b.bar;
        __builtin_amdgcn_s_waitcnt(0);
        unsigned nloc = b.st[0], nx = b.st[1];
        if (nloc == 0u) { xcd_barrier_complete(bar, b.x, nloc, nx); b.st[0] = nloc; b.st[1] = nx; }
        const unsigned old = xb_add(&bar[XB_XSUB(b.x)], 1u);
        const unsigned gen = old / nloc;
        if (old + 1u == (gen + 1u) * nloc) {
            __builtin_amdgcn_fence(__ATOMIC_RELEASE, "agent");
            asm volatile("s_waitcnt vmcnt(0)" ::: "memory");
            const unsigned og = xb_add(&bar[XB_TOP], 1u);
            const unsigned tg = og / nx;
            if (og + 1u == (tg + 1u) * nx) xb_add(&bar[XB_TOPGEN], 1u);
            else XB_SPIN(xb_ld(&bar[XB_TOPGEN]) == tg, bar);
            __builtin_amdgcn_fence(__ATOMIC_ACQUIRE, "agent");
            xb_add(&bar[XB_XGEN(b.x)], 1u);
            asm volatile("s_waitcnt vmcnt(0)" ::: "memory");
        } else {
            XB_SPIN(xb_ld(&bar[XB_XGEN(b.x)]) == gen, bar);
            __builtin_amdgcn_fence(__ATOMIC_ACQUIRE, "agent");
            asm volatile("s_waitcnt vmcnt(0)" ::: "memory");
        }
    }
    __syncthreads();
}


constexpr int NPHASE = 1 + 11 * NLAYER;

__global__ void __launch_bounds__(512, 2) fwd_mega(Params P) {
    extern __shared__ __attribute__((aligned(16))) unsigned char lds_raw[];
    LAS unsigned char* lds = (LAS unsigned char*)lds_raw;
    const int G = gridDim.x;
    if (threadIdx.x == 0) {
        unsigned vc = blockIdx.x;
#if ONE_LAUNCH
        unsigned* cen = (unsigned*)(P.ws + WS_BAR);
        const unsigned x = xb_xcc_id(), rank = xb_add(cen + 8 * x, 1u);
        unsigned sum = 0, base = 0, sp = 0;
        for (;;) { sum = 0; base = 0;
#pragma unroll
            for (unsigned j = 0; j < 16; ++j) { const unsigned cj = xb_ld(cen + 8 * j); sum += cj; base += (j < x) ? cj : 0u; }
            if (sum == (unsigned)G) break;
            __builtin_amdgcn_s_sleep(1);
            if (++sp > XB_SPIN_CAP) break; }
        const unsigned cp = base + rank, per = (unsigned)G / 8u;
        if (sum == (unsigned)G && (G % 8) == 0 && cp < (unsigned)G) vc = (cp % per) * 8u + cp / per;
#endif
        *(volatile LAS unsigned*)(lds + LDS_BYTES - 8) = vc;
    }
    __syncthreads();
    const int c = __builtin_amdgcn_readfirstlane((int)*(volatile LAS unsigned*)(lds + LDS_BYTES - 8));
    volatile LAS unsigned* bar_st = (volatile LAS unsigned*)(lds + LDS_BYTES - 16);
    if (threadIdx.x == 0) { bar_st[0] = 0u; bar_st[1] = 0u; }
    __syncthreads();
    XcdBarrier gbar = xcd_barrier_post((unsigned*)(P.ws + WS_BAR), bar_st);
#ifdef PROBE_MASK
    unsigned long long pr_acc = 0, pr_t0 = 0;
#endif
    for (int ph = P.ph_lo; ph < P.ph_hi; ++ph) {
#ifdef PROBE_MASK
        if ((PROBE_MASK >> ph) & 1) pr_t0 = wall_clock64();
#endif
        unsigned char* ws = P.ws;
        asm volatile("" : "+s"(ws));
        const char* xb = (const char*)(ws + WS_XB);
        if (ph == 0) {
            if (PHON(0)) setup_phase(P, lds);
            if (PHON(1)) convert_weights(P, 0, lds);
        } else {
            const int l = (ph - 1) / 11, sp = (ph - 1) % 11;
            if (PHON(2) && (sp == 0 || sp == 8)) {
                SchedFfnUp S{xb, (const char*)(ws + (sp == 0 ? WS_W13A : WS_W13B)), G, c};
                EpiSwiGLU E{(bf16_t*)(ws + WS_H)};
                gemm_phase(lds, DM, DM, DM, S, E);
            } else if (PHON(3) && (sp == 1 || sp == 9)) {
                SchedPlain S{(const char*)(ws + WS_H), (const char*)(ws + (sp == 1 ? WS_W2A : WS_W2B)), 64, 8, (size_t)256 * DFF * 2, (size_t)256 * DFF * 2, G, c};
                const float* stats = (const float*)(ws + WS_STATS);
                if (l == 0 && sp == 1) { EpiResid<false, 1> E{P.in[0], P.out, stats, nullptr, nullptr}; gemm_phase(lds, DFF, DFF, DFF, S, E); }
                else {
                    const float* lg = (sp == 1) ? P.in[21] + (size_t)(l - 1) * DM : P.in[17] + (size_t)l * DM;
                    const float* lb = (sp == 1) ? P.in[22] + (size_t)(l - 1) * DM : P.in[18] + (size_t)l * DM;
                    asm volatile("" : "+s"(lg), "+s"(lb), "+s"(stats));
                    EpiResid<true, 1> E{P.out, P.out, stats, lg, lb}; gemm_phase(lds, DFF, DFF, DFF, S, E); }
            } else if (PHON(4) && (sp == 2 || sp == 7 || sp == 10)) {
                const int gi = sp == 2 ? 4 : (sp == 7 ? 17 : 21);
                if (sp == 2) {
                    if (c < 8) { SchedKV S{(const char*)(ws + WS_MEMB), (const char*)(ws + WS_WKV), c}; EpiKV E{(bf16_t*)(ws + WS_KK), (bf16_t*)(ws + WS_VT)}; gemm_phase(lds, DM, DM, DM, S, E); }
                    else ln_fold_phase(P.out, (bf16_t*)(ws + WS_XB), (bf16_t*)(ws + WS_XP), (bf16_t*)(ws + WS_XM), (float*)(ws + WS_STATS), P.in[4] + (size_t)l * DM, P.in[5] + (size_t)l * DM, c);
                } else
                ln_phase(P.out, (bf16_t*)(ws + WS_XB), (float*)(ws + WS_STATS), P.in[gi] + (size_t)l * DM, P.in[gi + 1] + (size_t)l * DM, sp == 10 && l == NLAYER - 1);
                if (PHON(1) && sp == 10 && l + 1 < NLAYER) convert_weights(P, l + 1, lds);
            } else if (PHON(5) && sp == 3) {
                {
                    const int tid = ltid(), lane = tid & 63, gwv = c * 8 + (tid >> 6);
                    if (gwv < 1024) { const int bb = gwv >> 9, ch = gwv & 511;
                        const u32x4* xr = (const u32x4*)(xb + ((size_t)(bb * SEQ + HSEQ)) * ROWB) + lane; const u32x4* wrow = (const u32x4*)(ws + WS_WFT + (size_t)ch * ROWB) + lane; float sdot = 0.f;
#pragma unroll
                        for (int i = 0; i < 4; ++i) { f32x4 x0, x1, w0, w1; unpack8(xr[64 * i], x0, x1); unpack8(wrow[64 * i], w0, w1);
                            sdot += (x0[0] * w0[0] + x0[1] * w0[1]) + (x0[2] * w0[2] + x0[3] * w0[3]) + (x1[0] * w1[0] + x1[1] * w1[1]) + (x1[2] * w1[2] + x1[3] * w1[3]); }
                        sdot = wave_sum(sdot);
                        if (lane == 0) ((float*)(ws + WS_UH))[gwv] = (sdot + ((const float*)(ws + WS_BIAST))[ch]) * 0.011048543456039806f; }
                }
                SchedWin S{xb, (const char*)(ws + WS_WIN), (const char*)(ws + WS_WFT), (const char*)(ws + WS_XP), (const char*)(ws + WS_XM), G, c};
                EpiWin E{P.in[7] + (size_t)l * DIN, (const float*)(ws + WS_BIAST), (bf16_t*)(ws + WS_GLU), (bf16_t*)(ws + WS_Q), (bf16_t*)(ws + WS_G), (bf16_t*)(ws + WS_TT)};
                gemm_phase(lds, DM, DM, DM, S, E);
            } else if (sp == 4) {
                if (PHON(6)) { SchedDft S{(const char*)(ws + WS_CM), (const char*)(ws + WS_TT), G, c};
                  EpiDft E{(bf16_t*)(ws + WS_BR) + 1024, (const float*)(ws + WS_UH)};
                  gemm_phase(lds, HSEQ, HSEQ, SEQ, S, E); }
                const int half = G >> 1, hi = (c >= half) ? 1 : 0, cc = c - hi * half;
                if (hi) {
                    const int tid = ltid(), lane = tid & 63, gwv = cc * 8 + (tid >> 6);
                    if (gwv < 1024) { const int bb = gwv >> 9, ch = gwv & 511;
                        const u32x4* tr = (const u32x4*)(ws + WS_TT + ((size_t)ch * SEQ + (size_t)bb * HSEQ) * 2) + lane; float sa = 0.f;
#pragma unroll
                        for (int i = 0; i < 8; ++i) { f32x4 x0, x1; unpack8(tr[64 * i], x0, x1); sa += (x0[0] - x0[1]) + (x0[2] - x0[3]) + (x1[0] - x1[1]) + (x1[2] - x1[3]); }
                        sa = wave_sum(sa);
                        if (lane == 0) { bf16_t* orow = (bf16_t*)(ws + WS_BR) + (size_t)(bb * SEQ + HSEQ) * KBR; orow[1024 + ch] = f2bf(sa * 0.011048543456039806f + ((const float*)(ws + WS_UH))[gwv]); orow[1536 + ch] = 0; } }
                }
                if (PHON(7)) { const int nct = hi ? 6 : 2, ct0 = hi ? 2 * half : 0;
                    for (int j = 0; j < nct; ++j)
                        conv_tile((const bf16_t*)(ws + WS_GLU), (bf16_t*)(ws + WS_BR), P.in[8] + (size_t)l * 31 * 1024, P.in[9] + (size_t)l * 1024, P.in[10] + (size_t)l * 1024, P.in[11] + (size_t)l * 1024, ct0 + cc + half * j, lds); }
                if (PHON(8) && hi) for (int j = 0; j < 2; ++j) { const int t = cc + half * j;
                    attn_unit((const bf16_t*)(ws + WS_Q), (const bf16_t*)(ws + WS_KK), (const bf16_t*)(ws + WS_VT), (bf16_t*)(ws + WS_BR) + 2048, t >> 7, (t >> 5) & 3, t & 31, lds); }
                __syncthreads();
            } else if (PHON(9) && sp == 5) {
                SchedPlain S{(const char*)(ws + WS_BR), (const char*)(ws + WS_WBR), 64, 8, (size_t)256 * KBR * 2, (size_t)256 * KBR * 2, G, c};
                EpiBranchFused E{(const bf16_t*)(ws + WS_G), (bf16_t*)(ws + WS_MG)};
                gemm_phase(lds, KBR, KBR, KBR, S, E);
            } else if (PHON(10) && sp == 6) {
                SchedPlain S{(const char*)(ws + WS_MG), (const char*)(ws + WS_WOUT), 64, 8, (size_t)256 * DM * 2, (size_t)256 * DM * 2, G, c};
                const float* stats = (const float*)(ws + WS_STATS); const float* lg = P.in[4] + (size_t)l * DM; const float* lb = P.in[5] + (size_t)l * DM;
                asm volatile("" : "+s"(lg), "+s"(lb), "+s"(stats));
                EpiResid<true, 2> E{P.out, P.out, stats, lg, lb};
                gemm_phase(lds, DM, DM, DM, S, E);
            }
        }
        if (ph + 1 < P.ph_hi) { if (P.ph_lo < 0) cg::this_grid().sync(); else xcd_barrier(gbar); }
#ifdef PROBE_MASK
        if ((PROBE_MASK >> ph) & 1) pr_acc += wall_clock64() - pr_t0;
#endif
    }
#ifdef PROBE_MASK
    if (c == 0) { const unsigned long long t0 = wall_clock64(); while (wall_clock64() - t0 < (unsigned long long)PROBE_MULT * pr_acc) __builtin_amdgcn_s_sleep(32); }
#endif
}

extern "C" void kernel_launch(void* const* d_in, const int* in_sizes, int n_in, void* d_out, int out_size, void* d_ws, size_t ws_size, hipStream_t stream) {
    static int grid = 0;
    if (grid == 0) {
        if (n_in != 23 || out_size != NTOK * DM || ws_size < WS_END) { fprintf(stderr, "kernel_launch: unexpected shapes (n_in %d, out %d, ws %zu < %zu)\n", n_in, out_size, ws_size, (size_t)WS_END); grid = -1; return; }
        int dev = 0, cus = 0, per_cu = 0;
        hipGetDevice(&dev);
        hipDeviceGetAttribute(&cus, hipDeviceAttributeMultiprocessorCount, dev);
        hipFuncSetAttribute((const void*)fwd_mega, hipFuncAttributeMaxDynamicSharedMemorySize, LDS_BYTES);
        hipOccupancyMaxActiveBlocksPerMultiprocessor(&per_cu, (const void*)fwd_mega, 512, LDS_BYTES);
        if (per_cu < 1) { fprintf(stderr, "kernel_launch: occupancy query says %d blocks per CU\n", per_cu); per_cu = 1; }
        (void)hipGetLastError();
        grid = cus;
    }
    if (grid < 0) return;
    Params p{};
    for (int i = 0; i < 23; ++i) p.in[i] = (const float*)d_in[i];
    p.out = (float*)d_out; p.ws = (unsigned char*)d_ws;
#if ONE_LAUNCH
    hipMemsetAsync((unsigned char*)d_ws + WS_BAR, 0, XCD_BAR_WORDS * sizeof(unsigned), stream);
    p.ph_lo = 0; p.ph_hi = NPHASE;
    void* args[] = {&p};
    hipError_t e = hipLaunchCooperativeKernel((const void*)fwd_mega, dim3(grid), dim3(512), args, LDS_BYTES, stream);
    if (e != hipSuccess) fprintf(stderr, "cooperative launch failed: %s (grid %d)\n", hipGetErrorString(e), grid);
#else
    for (int ph = 0; ph < NPHASE; ++ph) { p.ph_lo = ph; p.ph_hi = ph + 1; hipLaunchKernelGGL(fwd_mega, dim3(grid), dim3(512), LDS_BYTES, stream, p); }
#endif
}
```

```cpp
#include <hip/hip_runtime.h>
#include <hip/hip_cooperative_groups.h>
#include <cstdio>
namespace cg = cooperative_groups;

#ifndef PH_MASK
#define PH_MASK 0xFFFF
#endif
#define PHON(k) ((PH_MASK >> (k)) & 1)
#ifndef ONE_LAUNCH
#define ONE_LAUNCH 1
#endif

#define LAS __attribute__((address_space(3)))
#define DI __device__ __forceinline__
typedef unsigned short bf16_t;
typedef short bf16x8 __attribute__((ext_vector_type(8)));
typedef float f32x4 __attribute__((ext_vector_type(4)));
typedef float f32x2 __attribute__((ext_vector_type(2)));
typedef float f32x16 __attribute__((ext_vector_type(16)));
typedef unsigned u32x4 __attribute__((ext_vector_type(4)));
typedef unsigned u32x2 __attribute__((ext_vector_type(2)));
typedef __bf16 bf16x2_t __attribute__((ext_vector_type(2)));

constexpr int NTOK = 16384, DM = 2048, DFF = 5632, DIN = 9216, SEQ = 8192, NLAYER = 2;
constexpr float DN_ALPHA = 1.4142135623730951f;
constexpr float LN_EPS = 1e-5f;

constexpr int HSEQ = SEQ / 2;
constexpr size_t WS_CM    = 0;
constexpr size_t CM_HALF  = (size_t)HSEQ * HSEQ * 2;
constexpr size_t WS_XB    = WS_CM + 2 * CM_HALF;
constexpr size_t WS_MEMB  = WS_XB + (size_t)NTOK * DM * 2;
constexpr size_t WS_XP    = WS_MEMB + (size_t)512 * DM * 2;
constexpr size_t WS_XM    = WS_XP + (size_t)2 * HSEQ * DM * 2;
constexpr size_t WS_W13A  = WS_XM + (size_t)2 * HSEQ * DM * 2;
constexpr size_t WS_W2A   = WS_W13A + (size_t)2 * DFF * DM * 2;
constexpr size_t WS_W13B  = WS_W2A + (size_t)DM * DFF * 2;
constexpr size_t WS_W2B   = WS_W13B + (size_t)2 * DFF * DM * 2;
constexpr size_t WS_WIN   = WS_W2B + (size_t)DM * DFF * 2;
constexpr size_t WS_WFT   = WS_WIN + (size_t)DIN * DM * 2;
constexpr int KBR = 2560;
constexpr size_t WS_WBR   = WS_WFT + (size_t)1024 * DM * 2;
constexpr size_t WS_WKV   = WS_WBR + (size_t)DM * KBR * 2;
constexpr size_t WS_WOUT  = WS_WKV + (size_t)1024 * DM * 2;
constexpr size_t WS_BIAST = WS_WOUT + (size_t)DM * DM * 2;
constexpr size_t WS_STATS = WS_BIAST + 4096;
constexpr size_t WS_BAR   = WS_STATS + (size_t)NTOK * 8;
constexpr size_t WS_UH    = WS_BAR + 16384;
constexpr size_t WS_KK    = WS_UH + 4096;
constexpr size_t WS_VT    = WS_KK + (size_t)512 * 512 * 2;
constexpr size_t WS_MIX   = WS_VT + (size_t)512 * 512 * 2;
constexpr size_t WS_G     = WS_MIX;
constexpr size_t WS_GLU   = WS_G + (size_t)NTOK * 6144 * 2;
constexpr size_t WS_TT    = WS_GLU + (size_t)NTOK * 1024 * 2;
constexpr size_t WS_MG    = WS_GLU;
constexpr size_t WS_Q     = WS_TT + (size_t)1024 * NTOK * 2;
constexpr size_t WS_BR    = WS_Q + (size_t)NTOK * 512 * 2;
constexpr size_t WS_END   = WS_BR + (size_t)NTOK * KBR * 2;
constexpr size_t WS_H     = WS_MIX;
static_assert((size_t)NTOK * DFF * 2 <= WS_END - WS_MIX, "H must fit the union region");

constexpr int LDS_BYTES = 131072 + 4096;

DI int ltid() { int t = threadIdx.x; asm volatile("" : "+v"(t)); return t; }
DI unsigned pk2(float a, float b) { f32x2 v = {a, b}; bf16x2_t r = __builtin_convertvector(v, bf16x2_t); return __builtin_bit_cast(unsigned, r); }
DI bf16_t f2bf(float a) { return (bf16_t)(pk2(a, 0.f) & 0xffffu); }
DI float sigmoidf_fast(float x) { return __builtin_amdgcn_rcpf(1.0f + __expf(-x)); }
DI float wave_sum(float v) {
#pragma unroll
    for (int o = 1; o < 64; o <<= 1) v += __shfl_xor(v, o);
    return v;
}
template <int O> DI float shx(float v) { return __shfl_xor(v, O); }
DI u32x4 pack8(const f32x4 v0, const f32x4 v1) { u32x4 w; w.x = pk2(v0[0], v0[1]); w.y = pk2(v0[2], v0[3]); w.z = pk2(v1[0], v1[1]); w.w = pk2(v1[2], v1[3]); return w; }
DI void unpack8(const u32x4 w, f32x4& v0, f32x4& v1) {
    v0[0] = __uint_as_float(w.x << 16); v0[1] = __uint_as_float(w.x & 0xffff0000u); v0[2] = __uint_as_float(w.y << 16); v0[3] = __uint_as_float(w.y & 0xffff0000u);
    v1[0] = __uint_as_float(w.z << 16); v1[1] = __uint_as_float(w.z & 0xffff0000u); v1[2] = __uint_as_float(w.w << 16); v1[3] = __uint_as_float(w.w & 0xffff0000u);
}

constexpr int BK = 64, HALF = 128, HTB = HALF * BK * 2;
DI int lds_byte(int r, int c) { const int st = (r >> 4) * 2 + (c >> 5), rr = r & 15, cc = c & 31, ob = rr * 64 + cc * 2; return st * 1024 + (ob ^ (((ob >> 9) & 1) << 5)); }
DI void stage_rc(int b, int& R, int& C) { const int st = b / 1024, sb = b % 1024, swz = sb ^ (((sb >> 9) & 1) << 5); R = (st >> 1) * 16 + swz / 64; C = (st & 1) * 32 + (swz % 64) / 2; }
DI int perm32(int rho) { const int n = rho >> 4, i = rho & 15; return 8 * (i >> 2) + 4 * n + (i & 3); }

struct Unit { const char* A; const char* B0; const char* B1; int kind, pm, pn; };

DI void tile_decode(int wgid, int nM, int nN, int& pm, int& pn) {
    const int nwg = nM * nN;
    { const int q = nwg / 8, r = nwg % 8, xcd = wgid % 8, off = wgid / 8; wgid = (xcd < r ? xcd * (q + 1) : r * (q + 1) + (xcd - r) * q) + off; }
    const int nig = 8 * nN, gid = wgid / nig, fm = gid * 8, gsz = (nM - fm) < 8 ? (nM - fm) : 8;
    pm = fm + ((wgid % nig) % gsz); pn = (wgid % nig) / gsz;
}

template <class Epi, class Sched>
DI void gemm_phase(LAS unsigned char* lds, const int K, const int lda, const int ldb, const Sched& S, const Epi& E) {
    const int tid = ltid(), wid = __builtin_amdgcn_readfirstlane(tid >> 6), lane = tid & 63, wr = wid >> 2, wc = wid & 3, fr = lane & 15, fq = lane >> 4;
    const int nt = K / BK;
    unsigned voffA[2], voffB[2];
#pragma unroll
    for (int i = 0; i < 2; ++i) { int R, C; stage_rc(tid * 16 + i * 8192, R, C); const int Rb = Epi::PERM ? ((R & ~31) + perm32(R & 31)) : R;
        voffA[i] = (unsigned)(R * lda + C) * 2u; voffB[i] = (unsigned)(Rb * ldb + C) * 2u; }
    const size_t kstep = (size_t)(BK * 2);
    const size_t hstepA = (size_t)HALF * lda * 2;
    const unsigned ldsw = (unsigned)wid * 1024u;
    const int aoff = lds_byte(wr * 64 + fr, fq * 8), boff = lds_byte(wc * 32 + fr, fq * 8);
#define G_SA(b, h) (((b) * 2 + (h)) * HTB)
#define G_SB(b, h) ((4 + (b) * 2 + (h)) * HTB)
#define G_STAGE(bufoff, gbase, voff) do { _Pragma("unroll") for (int _i = 0; _i < 2; ++_i) \
        __builtin_amdgcn_global_load_lds((const unsigned*)((const char*)(gbase) + (voff)[_i]), (LAS unsigned*)(lds + (bufoff) + ldsw + _i * 8192), 16, 0, 0); } while (0)
#define G_LDA(dst, b, h) do { _Pragma("unroll") for (int m = 0; m < 4; ++m) _Pragma("unroll") for (int k = 0; k < 2; ++k) dst[m][k] = *(const LAS bf16x8*)(lds + G_SA(b, h) + aoff + m * 2048 + k * 1024); } while (0)
#define G_LDB(dst, b, h) do { _Pragma("unroll") for (int n = 0; n < 2; ++n) _Pragma("unroll") for (int k = 0; k < 2; ++k) dst[n][k] = *(const LAS bf16x8*)(lds + G_SB(b, h) + boff + n * 2048 + k * 1024); } while (0)
#define G_MMA(ai, bj, At, Bt) do { __builtin_amdgcn_s_setprio(1); _Pragma("unroll") for (int m = 0; m < 4; ++m) _Pragma("unroll") for (int n = 0; n < 2; ++n) _Pragma("unroll") for (int k = 0; k < 2; ++k) \
        acc[ai][bj][m][n] = __builtin_amdgcn_mfma_f32_16x16x32_bf16(Bt[n][k], At[m][k], acc[ai][bj][m][n], 0, 0, 0); __builtin_amdgcn_s_setprio(0); } while (0)
#define G_WAIT_V(n) asm volatile("s_waitcnt vmcnt(" #n ")" ::: "memory")
#define G_WAIT_L(n) asm volatile("s_waitcnt lgkmcnt(" #n ")" ::: "memory")
#define G_BAR __builtin_amdgcn_s_barrier()
#define G_SCHED __builtin_amdgcn_sched_barrier(0)
    Unit cur, nxt; int ui = 0;
    if (!S.next(0, cur)) return;
    f32x4 acc[2][2][4][2];
#pragma unroll
    for (int a = 0; a < 2; ++a)
#pragma unroll
        for (int b = 0; b < 2; ++b)
#pragma unroll
            for (int m = 0; m < 4; ++m)
#pragma unroll
                for (int n = 0; n < 2; ++n) acc[a][b][m][n] = (f32x4){0.f, 0.f, 0.f, 0.f};
    bf16x8 At[4][2], B0[2][2], B1[2][2];
    const char* cA = cur.A; const char* cB0 = cur.B0; const char* cB1 = cur.B1;
    G_STAGE(G_SB(0, 0), cB0, voffB); G_STAGE(G_SA(0, 0), cA, voffA); G_STAGE(G_SB(0, 1), cB1, voffB); G_STAGE(G_SA(0, 1), cA + hstepA, voffA);
    if (wr == 1) G_BAR;
    G_WAIT_V(4); G_BAR;
    G_STAGE(G_SB(1, 0), cB0 + kstep, voffB); G_STAGE(G_SA(1, 0), cA + kstep, voffA); G_STAGE(G_SB(1, 1), cB1 + kstep, voffB);
    G_WAIT_V(6); G_BAR;
    for (;;) {
        const bool has_next = S.next(ui + 1, nxt);
        const char* nA = has_next ? nxt.A : cA; const char* nB0 = has_next ? nxt.B0 : cB0; const char* nB1 = has_next ? nxt.B1 : cB1;
        for (int t = 0; t < nt; t += 2) {
            const bool last = (t == nt - 2);
            const char* a1 = cA + (size_t)(t + 1) * kstep;
            const char* a2 = last ? nA : cA + (size_t)(t + 2) * kstep;
            const char* b20 = last ? nB0 : cB0 + (size_t)(t + 2) * kstep;
            const char* b21 = last ? nB1 : cB1 + (size_t)(t + 2) * kstep;
            const char* a3 = a2 + kstep; const char* b30 = b20 + kstep; const char* b31 = b21 + kstep;
            if constexpr (Epi::NHOOK > 0) { if (t == Epi::HK1 || t == Epi::HK2) E.hook(acc, cur, t, wr, wc, fr, fq); }
            G_LDB(B0, 0, 0); G_SCHED; G_LDA(At, 0, 0); G_STAGE(G_SA(1, 1), a1 + hstepA, voffA);
            G_WAIT_L(8); G_BAR; G_WAIT_L(0); G_MMA(0, 0, At, B0); G_BAR; G_SCHED;
            G_LDB(B1, 0, 1); G_STAGE(G_SB(0, 0), b20, voffB);
            G_BAR; G_WAIT_L(0); G_MMA(0, 1, At, B1); G_BAR;
            G_LDA(At, 0, 1); G_STAGE(G_SA(0, 0), a2, voffA);
            G_BAR; G_WAIT_L(0); G_MMA(1, 0, At, B0); G_BAR; G_SCHED;
            G_STAGE(G_SB(0, 1), b21, voffB);
            G_WAIT_V(6); G_BAR; G_MMA(1, 1, At, B1); G_BAR;
            G_LDB(B0, 1, 0); G_SCHED; G_LDA(At, 1, 0); G_STAGE(G_SA(0, 1), a2 + hstepA, voffA);
            G_WAIT_L(8); G_BAR; G_WAIT_L(0); G_MMA(0, 0, At, B0); G_BAR; G_SCHED;
            G_LDB(B1, 1, 1); G_STAGE(G_SB(1, 0), b30, voffB);
            G_BAR; G_WAIT_L(0); G_MMA(0, 1, At, B1); G_BAR;
            G_LDA(At, 1, 1); G_STAGE(G_SA(1, 0), a3, voffA);
            G_BAR; G_WAIT_L(0); G_MMA(1, 0, At, B0); G_BAR; G_SCHED;
            G_STAGE(G_SB(1, 1), b31, voffB);
            G_WAIT_V(6); G_BAR; G_MMA(1, 1, At, B1); G_BAR;
        }
        E(acc, cur, wr, wc, fr, fq);
        if (!has_next) break;
#pragma unroll
        for (int a = 0; a < 2; ++a)
#pragma unroll
            for (int b = 0; b < 2; ++b)
#pragma unroll
                for (int m = 0; m < 4; ++m)
#pragma unroll
                    for (int n = 0; n < 2; ++n) acc[a][b][m][n] = (f32x4){0.f, 0.f, 0.f, 0.f};
        cur = nxt; cA = nA; cB0 = nB0; cB1 = nB1; ++ui;
    }
    G_WAIT_V(0);
    if (wr == 0) G_BAR;
    G_BAR;
#undef G_SA
#undef G_SB
#undef G_STAGE
#undef G_LDA
#undef G_LDB
#undef G_MMA
#undef G_WAIT_V
#undef G_WAIT_L
#undef G_BAR
#undef G_SCHED
}

constexpr size_t ROWB = (size_t)DM * 2;
struct SchedFfnUp {
    const char* A; const char* B; int G, c;
    DI bool next(int i, Unit& u) const { const int L = i * G + c; if (L >= 64 * 44) return false; int pm, pn; tile_decode(L, 64, 44, pm, pn);
        u.A = A + (size_t)pm * 256 * ROWB; u.B0 = B + (size_t)pn * 128 * ROWB; u.B1 = u.B0 + (size_t)DFF * ROWB; u.kind = 0; u.pm = pm; u.pn = pn; return true; }
};
struct SchedPlain {
    const char* A; const char* B; int nM, nN; size_t astep, bstep; int G, c;
    DI bool next(int i, Unit& u) const { const int L = i * G + c; if (L >= nM * nN) return false; int pm, pn;
        if (nN == 8 && G == 256 && (nM & 31) == 0) { const int x = c & 7, r = c >> 3; pm = 32 * i + 4 * x + (r >> 3); pn = r & 7; }
        else tile_decode(L, nM, nN, pm, pn);
        u.A = A + (size_t)pm * astep; u.B0 = B + (size_t)pn * bstep; u.B1 = u.B0 + (bstep >> 1); u.kind = 0; u.pm = pm; u.pn = pn; return true; }
};
struct SchedWin {
    const char* xb; const char* win; const char* wft; const char* xp; const char* xm; int G, c;
    DI bool next(int i, Unit& u) const {
        int L = i * G + c; int pm, pn;
        if (L < 2176) { tile_decode(L, 64, 34, pm, pn); u.A = xb + (size_t)pm * 256 * ROWB; u.pm = pm;
            if (pn < 8) { u.kind = 0; u.pn = pn; u.B0 = win + (size_t)(pn * 128) * ROWB; u.B1 = win + (size_t)(1024 + pn * 128) * ROWB; }
            else if (pn < 10) { u.kind = 1; u.pn = pn - 8; u.B0 = win + (size_t)(2560 + 256 * (pn - 8)) * ROWB; u.B1 = u.B0 + 128 * ROWB; }
            else { u.kind = 2; u.pn = pn - 10; u.B0 = win + (size_t)(3072 + 256 * (pn - 10)) * ROWB; u.B1 = u.B0 + 128 * ROWB; }
            return true; }
        L -= 2176;
        if (L < 128) { tile_decode(L, 4, 32, pm, pn); u.kind = 3; u.pm = pm; u.pn = pn; u.A = wft + (size_t)pm * 256 * ROWB;
            u.B0 = (pm < 2 ? xp : xm) + (size_t)pn * 256 * ROWB; u.B1 = u.B0 + 128 * ROWB; return true; }
        return false;
    }
};
struct SchedKV {
    const char* memb; const char* wkv; int c;
    DI bool next(int i, Unit& u) const {
        if (i > 0 || c >= 8) return false; int pm, pn; tile_decode(c & 3, 2, 2, pm, pn); u.pm = pm; u.pn = pn;
        if (c < 4) { u.kind = 4; u.A = memb + (size_t)pm * 256 * ROWB; u.B0 = wkv + (size_t)pn * 256 * ROWB; }
        else { u.kind = 5; u.A = wkv + (size_t)(512 + pm * 256) * ROWB; u.B0 = memb + (size_t)pn * 256 * ROWB; }
        u.B1 = u.B0 + 128 * ROWB; return true; }
};
struct SchedDft {
    const char* cm; const char* tt; int G, c;
    DI bool next(int i, Unit& u) const { const int L = i * G + c; if (L >= 128) return false; int pm, pn8; tile_decode(L, 16, 8, pm, pn8);
        const int b = pn8 >> 2, p = (pn8 >> 1) & 1, pn = pn8 & 1;
        u.A = cm + (size_t)p * CM_HALF + (size_t)pm * 256 * HSEQ * 2; u.B0 = tt + ((size_t)(p * 512 + pn * 256) * SEQ + (size_t)b * HSEQ) * 2; u.B1 = u.B0 + (size_t)128 * SEQ * 2;
        u.kind = p; u.pm = b * 32 + pm; u.pn = p * 2 + pn; return true; }
};

template <int ACT>
DI void store_tile_bf16(const f32x4 (&acc)[2][2][4][2], bf16_t* out, size_t ld, int row0, int col0, const float* colbias, const float* rowbias, float scale, float cbs = 1.0f) {
    f32x4 cb[2][2];
#pragma unroll
    for (int bj = 0; bj < 2; ++bj)
#pragma unroll
        for (int n = 0; n < 2; ++n) cb[bj][n] = colbias ? *(const f32x4*)(colbias + col0 + bj * HALF + 4 * n) * cbs : (f32x4){0.f, 0.f, 0.f, 0.f};
#pragma unroll
    for (int ai = 0; ai < 2; ++ai)
#pragma unroll
        for (int m = 0; m < 4; ++m) { const int row = row0 + ai * HALF + m * 16; const float rb = rowbias ? rowbias[row] : 0.f; bf16_t* rp = out + (size_t)row * ld + col0;
#pragma unroll
            for (int bj = 0; bj < 2; ++bj) { f32x4 v0 = (acc[ai][bj][m][0] + cb[bj][0] + rb) * scale, v1 = (acc[ai][bj][m][1] + cb[bj][1] + rb) * scale;
                if (ACT == 1) {
#pragma unroll
                    for (int j = 0; j < 4; ++j) { v0[j] = sigmoidf_fast(v0[j]); v1[j] = sigmoidf_fast(v1[j]); } }
                *(u32x4*)(rp + bj * HALF) = pack8(v0, v1); } }
}
struct EpiSwiGLU {
    static constexpr bool PERM = true; static constexpr int NHOOK = 0; bf16_t* H;
    DI void operator()(const f32x4 (&acc)[2][2][4][2], const Unit& u, int wr, int wc, int fr, int fq) const {
        const int row0 = u.pm * 256 + wr * 64 + fr, col0 = u.pn * 128 + wc * 32 + 8 * fq;
#pragma unroll
        for (int ai = 0; ai < 2; ++ai)
#pragma unroll
            for (int m = 0; m < 4; ++m) { f32x4 v[2];
#pragma unroll
                for (int n = 0; n < 2; ++n) { const f32x4 a = acc[ai][0][m][n], g = acc[ai][1][m][n];
#pragma unroll
                    for (int j = 0; j < 4; ++j) v[n][j] = a[j] * g[j] * sigmoidf_fast(g[j]); }
                *(u32x4*)(H + (size_t)(row0 + ai * HALF + m * 16) * DFF + col0) = pack8(v[0], v[1]); }
    }
};
template <bool LNSRC, int BETA2> struct EpiResid {
    static constexpr bool PERM = false; static constexpr int NHOOK = 0; static constexpr float alpha = DN_ALPHA, beta = 0.5f * BETA2; const float* src; float* dst; const float* stats; const float* lng; const float* lnb;
    DI void operator()(const f32x4 (&acc)[2][2][4][2], const Unit& u, int wr, int wc, int fr, int fq) const {
        const int row0 = u.pm * 256 + wr * 64 + fr, col0 = u.pn * 256 + wc * 32 + 4 * fq;
        if constexpr (LNSRC) {
            const f32x4 g00 = *(const f32x4*)(lng + col0) * alpha, g01 = *(const f32x4*)(lng + col0 + 16) * alpha, g10 = *(const f32x4*)(lng + col0 + HALF) * alpha, g11 = *(const f32x4*)(lng + col0 + HALF + 16) * alpha;
            const f32x4 b00 = *(const f32x4*)(lnb + col0) * alpha, b01 = *(const f32x4*)(lnb + col0 + 16) * alpha, b10 = *(const f32x4*)(lnb + col0 + HALF) * alpha, b11 = *(const f32x4*)(lnb + col0 + HALF + 16) * alpha;
#pragma unroll
            for (int ai = 0; ai < 2; ++ai)
#pragma unroll
                for (int mp = 0; mp < 2; ++mp) { f32x4 sv[2][4]; float mean[2], rstd[2];
#pragma unroll
                    for (int mm = 0; mm < 2; ++mm) { const int row = row0 + ai * HALF + (2 * mp + mm) * 16; const size_t off = (size_t)row * DM + col0;
                        mean[mm] = stats[2 * row]; rstd[mm] = stats[2 * row + 1];
                        sv[mm][0] = *(const f32x4*)(src + off); sv[mm][1] = *(const f32x4*)(src + off + 16); sv[mm][2] = *(const f32x4*)(src + off + HALF); sv[mm][3] = *(const f32x4*)(src + off + HALF + 16); }
#pragma unroll
                    for (int mm = 0; mm < 2; ++mm) { const int m = 2 * mp + mm; const size_t off = (size_t)(row0 + ai * HALF + m * 16) * DM + col0;
                        *(f32x4*)(dst + off) = (sv[mm][0] - mean[mm]) * rstd[mm] * g00 + b00 + acc[ai][0][m][0] * beta;
                        *(f32x4*)(dst + off + 16) = (sv[mm][1] - mean[mm]) * rstd[mm] * g01 + b01 + acc[ai][0][m][1] * beta;
                        *(f32x4*)(dst + off + HALF) = (sv[mm][2] - mean[mm]) * rstd[mm] * g10 + b10 + acc[ai][1][m][0] * beta;
                        *(f32x4*)(dst + off + HALF + 16) = (sv[mm][3] - mean[mm]) * rstd[mm] * g11 + b11 + acc[ai][1][m][1] * beta; }
                    asm volatile("" ::: "memory"); }
        } else {
#pragma unroll
            for (int ai = 0; ai < 2; ++ai)
#pragma unroll
                for (int m = 0; m < 4; ++m) { const size_t off = (size_t)(row0 + ai * HALF + m * 16) * DM + col0;
#pragma unroll
                    for (int bj = 0; bj < 2; ++bj)
#pragma unroll
                        for (int n = 0; n < 2; ++n) { const f32x4 sv = *(const f32x4*)(src + off + bj * HALF + n * 16); *(f32x4*)(dst + off + bj * HALF + n * 16) = sv * alpha + acc[ai][bj][m][n] * beta; }
                    asm volatile("" ::: "memory"); }
        }
    }
};
struct EpiWin {
    static constexpr bool PERM = true; static constexpr int NHOOK = 0;
    const float* bin; const float* biasT; bf16_t *GLU, *Q, *Gt, *TT;
    DI void operator()(const f32x4 (&acc)[2][2][4][2], const Unit& u, int wr, int wc, int fr, int fq) const {
        const int row0 = u.pm * 256 + wr * 64 + fr, cin = wc * 32 + 8 * fq;
        if (u.kind == 0) {
            const int col0 = u.pn * 128 + cin; f32x4 bv[2], bg[2];
#pragma unroll
            for (int n = 0; n < 2; ++n) { bv[n] = *(const f32x4*)(bin + col0 + 4 * n); bg[n] = *(const f32x4*)(bin + 1024 + col0 + 4 * n); }
#pragma unroll
            for (int ai = 0; ai < 2; ++ai)
#pragma unroll
                for (int m = 0; m < 4; ++m) { f32x4 v[2];
#pragma unroll
                    for (int n = 0; n < 2; ++n) { const f32x4 a = acc[ai][0][m][n] + bv[n], g = acc[ai][1][m][n] + bg[n];
#pragma unroll
                        for (int j = 0; j < 4; ++j) v[n][j] = a[j] * sigmoidf_fast(g[j]); }
                    *(u32x4*)(GLU + (size_t)(row0 + ai * HALF + m * 16) * 1024 + col0) = pack8(v[0], v[1]); }
        } else if (u.kind == 1) store_tile_bf16<0>(acc, Q, 512, row0, u.pn * 256 + cin, bin + 2560, nullptr, 0.08838834764831845f);
        else if (u.kind == 2) store_tile_bf16<1>(acc, Gt, 6144, row0, u.pn * 256 + cin, bin + 3072, nullptr, 1.0f);
        else {
            const bool cosr = u.pm < 2; const int col0 = u.pn * 256 + cin;
#pragma unroll
            for (int ai = 0; ai < 2; ++ai)
#pragma unroll
                for (int m = 0; m < 4; ++m) { const int row = row0 + ai * HALF + m * 16; const float rb = cosr ? biasT[row] : 0.f;
#pragma unroll
                    for (int bj = 0; bj < 2; ++bj) { f32x4 v0 = acc[ai][bj][m][0] + 2.0f * rb, v1 = acc[ai][bj][m][1] + 2.0f * rb;
                        if (((col0 + bj * HALF) & (HSEQ - 1)) == 0) v0[0] -= rb;
                        *(u32x4*)(TT + (size_t)row * SEQ + col0 + bj * HALF) = pack8(v0, v1); } }
        }
    }
};
struct EpiKV {
    static constexpr bool PERM = true; static constexpr int NHOOK = 0; bf16_t *KK, *VT;
    DI void operator()(const f32x4 (&acc)[2][2][4][2], const Unit& u, int wr, int wc, int fr, int fq) const {
        store_tile_bf16<0>(acc, u.kind == 4 ? KK : VT, 512, u.pm * 256 + wr * 64 + fr, u.pn * 256 + wc * 32 + 8 * fq, nullptr, nullptr, 1.0f);
    }
};
struct EpiDft {
    static constexpr bool PERM = true; static constexpr int NHOOK = 0; bf16_t* out; const float* uh;
    DI void operator()(const f32x4 (&acc)[2][2][4][2], const Unit& u, int wr, int wc, int fr, int fq) const {
        const int b = u.pm >> 5, k0 = (u.pm & 31) * 256 + wr * 64 + fr, col0 = u.pn * 256 + wc * 32 + 8 * fq;
        const float sgn = (fr & 1) ? -1.0f : 1.0f; const unsigned flip = u.kind ? 0x80008000u : 0u;
        f32x4 cb[2][2];
#pragma unroll
        for (int bj = 0; bj < 2; ++bj)
#pragma unroll
            for (int n = 0; n < 2; ++n) cb[bj][n] = (u.kind == 0) ? *(const f32x4*)(uh + b * 512 + col0 + bj * HALF + 4 * n) * sgn : (f32x4){0.f, 0.f, 0.f, 0.f};
#pragma unroll
        for (int ai = 0; ai < 2; ++ai)
#pragma unroll
            for (int m = 0; m < 4; ++m) { const int k = k0 + ai * HALF + m * 16;
                bf16_t* rp = out + (size_t)(b * SEQ + k) * KBR + col0; bf16_t* rq = out + (size_t)(b * SEQ + SEQ - k) * KBR + col0;
#pragma unroll
                for (int bj = 0; bj < 2; ++bj) { u32x4 w = pack8(acc[ai][bj][m][0] + cb[bj][0], acc[ai][bj][m][1] + cb[bj][1]);
                    *(u32x4*)(rp + bj * HALF) = w;
                    if (k != 0) { w.x ^= flip; w.y ^= flip; w.z ^= flip; w.w ^= flip; *(u32x4*)(rq + bj * HALF) = w; } } }
    }
};
struct EpiPlainBf16 {
    static constexpr bool PERM = true; static constexpr int NHOOK = 0; bf16_t* out; int ld;
    DI void operator()(const f32x4 (&acc)[2][2][4][2], const Unit& u, int wr, int wc, int fr, int fq) const {
        store_tile_bf16<0>(acc, out, (size_t)ld, u.pm * 256 + wr * 64 + fr, u.pn * 256 + wc * 32 + 8 * fq, nullptr, nullptr, 1.0f);
    }
};
struct EpiBranchFused {
    static constexpr bool PERM = true; static constexpr int NHOOK = 2, HK1 = 16, HK2 = 32; const bf16_t* Gt; bf16_t* MG;
    DI void hook(f32x4 (&acc)[2][2][4][2], const Unit& u, int t, int wr, int wc, int fr, int fq) const {
        const int sgm = (t == HK1) ? 0 : 1;
        asm volatile("" : "+v"(fr), "+v"(fq));
        const int row0 = u.pm * 256 + wr * 64 + fr, col0 = u.pn * 256 + wc * 32 + 8 * fq;
#pragma unroll
        for (int ai = 0; ai < 2; ++ai) {
            u32x4 ga[4][2], gb[4][2];
#pragma unroll
            for (int m = 0; m < 4; ++m) { const bf16_t* gp = Gt + (size_t)(row0 + ai * HALF + m * 16) * 6144 + sgm * DM + col0;
#pragma unroll
                for (int bj = 0; bj < 2; ++bj) { ga[m][bj] = *(const u32x4*)(gp + bj * HALF); gb[m][bj] = *(const u32x4*)(gp + DM + bj * HALF); } }
#pragma unroll
            for (int m = 0; m < 4; ++m)
#pragma unroll
                for (int bj = 0; bj < 2; ++bj) { f32x4 a0, a1, b0, b1; unpack8(ga[m][bj], a0, a1); unpack8(gb[m][bj], b0, b1);
#pragma unroll
                    for (int j = 0; j < 4; ++j) { acc[ai][bj][m][0][j] *= a0[j] * __builtin_amdgcn_rcpf(b0[j]); acc[ai][bj][m][1][j] *= a1[j] * __builtin_amdgcn_rcpf(b1[j]); } }
            asm volatile("" ::: "memory");
        }
    }
    DI void operator()(const f32x4 (&acc)[2][2][4][2], const Unit& u, int wr, int wc, int fr, int fq) const {
        const int row0 = u.pm * 256 + wr * 64 + fr, col0 = u.pn * 256 + wc * 32 + 8 * fq;
#pragma unroll
        for (int ai = 0; ai < 2; ++ai) {
            u32x4 gg[4][2];
#pragma unroll
            for (int m = 0; m < 4; ++m)
#pragma unroll
                for (int bj = 0; bj < 2; ++bj) gg[m][bj] = *(const u32x4*)(Gt + (size_t)(row0 + ai * HALF + m * 16) * 6144 + 2 * DM + col0 + bj * HALF);
#pragma unroll
            for (int m = 0; m < 4; ++m)
#pragma unroll
                for (int bj = 0; bj < 2; ++bj) { f32x4 g0, g1; unpack8(gg[m][bj], g0, g1);
                    *(u32x4*)(MG + (size_t)(row0 + ai * HALF + m * 16) * DM + col0 + bj * HALF) = pack8(g0 * acc[ai][bj][m][0], g1 * acc[ai][bj][m][1]); }
            asm volatile("" ::: "memory");
        }
    }
};

DI void transpose_item(const float* W, int N, bf16_t* WT, int ldo, int row_off, int koff, LAS float* scr, int item, int lane) {
    const int nblk = N / 32, kb = item / nblk, nb = item % nblk, k0 = 64 * kb, n0 = 32 * nb;
    f32x4 v[8];
    { const float* wp = W + (size_t)(k0 + (lane >> 3)) * N + n0 + 4 * (lane & 7);
#pragma unroll
      for (int i = 0; i < 8; ++i) v[i] = *(const f32x4*)(wp + (size_t)(8 * i) * N); }
#pragma unroll
    for (int i = 0; i < 8; ++i) { LAS float* d = scr + (8 * i + (lane >> 3)) * 33 + 4 * (lane & 7); d[0] = v[i][0]; d[1] = v[i][1]; d[2] = v[i][2]; d[3] = v[i][3]; }
    asm volatile("s_waitcnt lgkmcnt(0)" ::: "memory");
    const int c = lane & 7;
#pragma unroll
    for (int j = 0; j < 4; ++j) { const int n = (lane >> 3) + 8 * j; const LAS float* s = scr + (8 * c) * 33 + n;
        u32x4 o; o.x = pk2(s[0 * 33], s[1 * 33]); o.y = pk2(s[2 * 33], s[3 * 33]); o.z = pk2(s[4 * 33], s[5 * 33]); o.w = pk2(s[6 * 33], s[7 * 33]);
        *(u32x4*)(WT + (size_t)(row_off + n0 + n) * ldo + koff + k0 + 8 * c) = o; }
    asm volatile("s_waitcnt lgkmcnt(0)" ::: "memory");
}

struct Params { const float* in[23]; float* out; unsigned char* ws; int ph_lo, ph_hi; };

DI void convert_weights(const Params& P, int l, LAS unsigned char* lds) {
    const int tid = ltid(), lane = tid & 63, wid = tid >> 6;
    unsigned char* ws = P.ws;
    LAS float* scr = (LAS float*)(lds + wid * 8448);
    const int gw = blockIdx.x * 8 + wid, NGW = gridDim.x * 8;
    constexpr int I13 = 32 * 352, I2 = 88 * 64, IIN = 32 * 288, ICO = 16 * 64, IF = 8 * 64, IKV = 32 * 32, IO = 8 * 64, IOUT = 32 * 64;
    constexpr int NITEMS = 2 * I13 + 2 * I2 + IIN + ICO + 2 * IF + IKV + IO + IOUT;
    const float* w13a = P.in[2] + (size_t)l * DM * 2 * DFF; const float* w2a = P.in[3] + (size_t)l * DFF * DM;
    const float* win = P.in[6] + (size_t)l * DM * DIN; const float* wco = P.in[12] + (size_t)l * 1024 * DM; const float* wf = P.in[13] + (size_t)l * 512 * DM;
    const float* wkv = P.in[14] + (size_t)l * DM * 1024; const float* wo = P.in[15] + (size_t)l * 512 * DM; const float* wout = P.in[16] + (size_t)l * DM * DM;
    const float* w13b = P.in[19] + (size_t)l * DM * 2 * DFF; const float* w2b = P.in[20] + (size_t)l * DFF * DM;
    for (int it = gw; it < NITEMS; it += NGW) {
        int r = it;
        if (r < I13) { transpose_item(w13a, 2 * DFF, (bf16_t*)(ws + WS_W13A), DM, 0, 0, scr, r, lane); continue; } r -= I13;
        if (r < I13) { transpose_item(w13b, 2 * DFF, (bf16_t*)(ws + WS_W13B), DM, 0, 0, scr, r, lane); continue; } r -= I13;
        if (r < I2) { transpose_item(w2a, DM, (bf16_t*)(ws + WS_W2A), DFF, 0, 0, scr, r, lane); continue; } r -= I2;
        if (r < I2) { transpose_item(w2b, DM, (bf16_t*)(ws + WS_W2B), DFF, 0, 0, scr, r, lane); continue; } r -= I2;
        if (r < IIN) { transpose_item(win, DIN, (bf16_t*)(ws + WS_WIN), DM, 0, 0, scr, r, lane); continue; } r -= IIN;
        if (r < ICO) { transpose_item(wco, DM, (bf16_t*)(ws + WS_WBR), KBR, 0, 0, scr, r, lane); continue; } r -= ICO;
        if (r < IF) { transpose_item(wf, DM, (bf16_t*)(ws + WS_WBR), KBR, 0, 1024, scr, r, lane); continue; } r -= IF;
        if (r < IF) { transpose_item(wf, DM, (bf16_t*)(ws + WS_WBR), KBR, 0, 1536, scr, r, lane); continue; } r -= IF;
        if (r < IKV) { transpose_item(wkv, 1024, (bf16_t*)(ws + WS_WKV), DM, 0, 0, scr, r, lane); continue; } r -= IKV;
        if (r < IO) { transpose_item(wo, DM, (bf16_t*)(ws + WS_WBR), KBR, 0, 2048, scr, r, lane); continue; } r -= IO;
        transpose_item(wout, DM, (bf16_t*)(ws + WS_WOUT), DM, 0, 0, scr, r, lane);
    }
    __syncthreads();
    {
        LAS float* tile = (LAS float*)lds;
        LAS float* tabc = tile + 32 * 129; LAS float* tabs = tabc + 128;
        const float* bin = P.in[7] + (size_t)l * DIN;
        bf16_t* WFT = (bf16_t*)(ws + WS_WFT); float* biasT = (float*)(ws + WS_BIAST);
        if (tid < 128) { float sn, cs; sincospif((float)tid * (1.0f / 64.0f), &sn, &cs); tabc[tid] = cs * 0.08838834764831845f; tabs[tid] = sn * 0.08838834764831845f; }
        for (int item = blockIdx.x; item < 256; item += gridDim.x) {
            const int kb = item >> 2, g = item & 3;
            __syncthreads();
            for (int idx = tid; idx < 32 * 128; idx += 512) { const int kk = idx >> 7, j = idx & 127; tile[kk * 129 + j] = win[(size_t)(kb * 32 + kk) * DIN + 2048 + g * 128 + j]; }
            __syncthreads();
            const int k = tid & 31, ccb = (tid >> 5) * 8;
            float ac[8], as[8];
#pragma unroll
            for (int c8 = 0; c8 < 8; ++c8) { ac[c8] = 0.f; as[c8] = 0.f; }
            for (int j = 0; j < 128; ++j) { const float w = tile[k * 129 + j];
#pragma unroll
                for (int c8 = 0; c8 < 8; ++c8) { const int idx = (j * (ccb + c8)) & 127; ac[c8] += w * tabc[idx]; as[c8] += w * tabs[idx]; } }
#pragma unroll
            for (int c8 = 0; c8 < 8; ++c8) { WFT[(size_t)(g * 128 + ccb + c8) * DM + kb * 32 + k] = f2bf(ac[c8]); WFT[(size_t)(512 + g * 128 + ccb + c8) * DM + kb * 32 + k] = f2bf(as[c8]); }
            if (kb == 0 && tid < 128) { float bc = 0.f, bs = 0.f;
                for (int j = 0; j < 128; ++j) { const float w = bin[2048 + g * 128 + j]; const int idx = (j * tid) & 127; bc += w * tabc[idx]; bs += w * tabs[idx]; }
                biasT[g * 128 + tid] = bc; biasT[512 + g * 128 + tid] = bs; }
        }
        __syncthreads();
    }
}

DI void setup_phase(const Params& P, LAS unsigned char* lds) {
    const int tid = ltid(); unsigned char* ws = P.ws;
    const size_t gt = (size_t)blockIdx.x * 512 + tid, ngt = (size_t)gridDim.x * 512;
    { const f32x4* src = (const f32x4*)P.in[0]; u32x4* dst = (u32x4*)(ws + WS_XB);
      for (size_t i = gt; i < (size_t)NTOK * DM / 8; i += ngt) dst[i] = pack8(src[2 * i], src[2 * i + 1]); }
    { const f32x4* src = (const f32x4*)P.in[1]; u32x4* dst = (u32x4*)(ws + WS_MEMB);
      for (size_t i = gt; i < (size_t)512 * DM / 8; i += ngt) dst[i] = pack8(src[2 * i], src[2 * i + 1]); }
    bf16_t* cm0 = (bf16_t*)(ws + WS_CM); bf16_t* cm1 = (bf16_t*)(ws + WS_CM + CM_HALF);
    for (int j = blockIdx.x; j < HSEQ; j += gridDim.x) {
        f32x4 c0, c1, s0, s1;
#pragma unroll
        for (int e = 0; e < 8; ++e) { const float x = (float)((j * (tid * 8 + e)) & (SEQ - 1)) * (1.0f / 8192.0f);
            const float cv = __builtin_amdgcn_cosf(x) * 0.011048543456039806f, sv = __builtin_amdgcn_sinf(x) * -0.011048543456039806f;
            if (e < 4) { c0[e] = cv; s0[e] = sv; } else { c1[e - 4] = cv; s1[e - 4] = sv; } }
        *(u32x4*)(cm0 + (size_t)j * HSEQ + tid * 8) = pack8(c0, c1); *(u32x4*)(cm1 + (size_t)j * HSEQ + tid * 8) = pack8(s0, s1);
    }
}

DI void ln_phase(float* X, bf16_t* XB, float* stats, const float* g, const float* bta, bool final_out) {
    const int tid = ltid(), lane = tid & 63, gw = blockIdx.x * 8 + (tid >> 6), ngw = gridDim.x * 8;
    f32x4 gv[8], bv[8];
#pragma unroll
    for (int j = 0; j < 8; ++j) { gv[j] = ((const f32x4*)g)[64 * j + lane]; bv[j] = ((const f32x4*)bta)[64 * j + lane]; }
    f32x4 na[8], nb[8];
    { const f32x4* xa = (const f32x4*)(X + (size_t)gw * DM) + lane; const f32x4* xq = (const f32x4*)(X + (size_t)(gw + ngw) * DM) + lane;
#pragma unroll
      for (int j = 0; j < 8; ++j) { na[j] = xa[64 * j]; nb[j] = xq[64 * j]; } }
    for (int row = gw; row < NTOK; row += 2 * ngw) {
        const int rowb = row + ngw;
        f32x4 va[8], vb[8];
#pragma unroll
        for (int j = 0; j < 8; ++j) { va[j] = na[j]; vb[j] = nb[j]; }
        if (row + 2 * ngw < NTOK) { const f32x4* xa = (const f32x4*)(X + (size_t)(row + 2 * ngw) * DM) + lane; const f32x4* xq = (const f32x4*)(X + (size_t)(row + 3 * ngw) * DM) + lane;
#pragma unroll
            for (int j = 0; j < 8; ++j) { na[j] = xa[64 * j]; nb[j] = xq[64 * j]; } }
        float sa = 0.f, sb = 0.f;
#pragma unroll
        for (int j = 0; j < 8; ++j) { sa += (va[j][0] + va[j][1]) + (va[j][2] + va[j][3]); sb += (vb[j][0] + vb[j][1]) + (vb[j][2] + vb[j][3]); }
        sa += shx<1>(sa); sb += shx<1>(sb); sa += shx<2>(sa); sb += shx<2>(sb); sa += shx<4>(sa); sb += shx<4>(sb);
        sa += shx<8>(sa); sb += shx<8>(sb); sa += shx<16>(sa); sb += shx<16>(sb); sa += shx<32>(sa); sb += shx<32>(sb);
        const float ma = sa * (1.0f / DM), mb = sb * (1.0f / DM); float qa = 0.f, qb = 0.f;
#pragma unroll
        for (int j = 0; j < 8; ++j) { va[j] = va[j] - ma; vb[j] = vb[j] - mb;
            qa += (va[j][0] * va[j][0] + va[j][1] * va[j][1]) + (va[j][2] * va[j][2] + va[j][3] * va[j][3]); qb += (vb[j][0] * vb[j][0] + vb[j][1] * vb[j][1]) + (vb[j][2] * vb[j][2] + vb[j][3] * vb[j][3]); }
        qa += shx<1>(qa); qb += shx<1>(qb); qa += shx<2>(qa); qb += shx<2>(qb); qa += shx<4>(qa); qb += shx<4>(qb);
        qa += shx<8>(qa); qb += shx<8>(qb); qa += shx<16>(qa); qb += shx<16>(qb); qa += shx<32>(qa); qb += shx<32>(qb);
        const float ra = 1.0f / sqrtf(qa * (1.0f / DM) + LN_EPS), rb = 1.0f / sqrtf(qb * (1.0f / DM) + LN_EPS);
        if (final_out) {
            f32x4* xa = (f32x4*)(X + (size_t)row * DM) + lane; f32x4* xq = (f32x4*)(X + (size_t)rowb * DM) + lane;
#pragma unroll
            for (int j = 0; j < 8; ++j) { xa[64 * j] = va[j] * ra * gv[j] + bv[j]; xq[64 * j] = vb[j] * rb * gv[j] + bv[j]; }
        } else {
            if (lane == 0) { f32x2 st = {ma, ra}; *(f32x2*)(stats + 2 * row) = st; st[0] = mb; st[1] = rb; *(f32x2*)(stats + 2 * rowb) = st; }
            u32x2* oa = (u32x2*)(XB + (size_t)row * DM) + lane; u32x2* ob = (u32x2*)(XB + (size_t)rowb * DM) + lane;
#pragma unroll
            for (int j = 0; j < 8; ++j) { const f32x4 ya = va[j] * ra * gv[j] + bv[j], yb = vb[j] * rb * gv[j] + bv[j]; u32x2 w; w.x = pk2(ya[0], ya[1]); w.y = pk2(ya[2], ya[3]); oa[64 * j] = w; w.x = pk2(yb[0], yb[1]); w.y = pk2(yb[2], yb[3]); ob[64 * j] = w; }
        }
    }
}

DI void ln_row(f32x4 (&v)[8], const f32x4 (&gv)[8], const f32x4 (&bv)[8], float* stats, int row, bf16_t* XB, int lane) {
    float s = 0.f;
#pragma unroll
    for (int j = 0; j < 8; ++j) s += (v[j][0] + v[j][1]) + (v[j][2] + v[j][3]);
    const float mean = wave_sum(s) * (1.0f / DM); float s2 = 0.f;
#pragma unroll
    for (int j = 0; j < 8; ++j) { v[j] = v[j] - mean; s2 += (v[j][0] * v[j][0] + v[j][1] * v[j][1]) + (v[j][2] * v[j][2] + v[j][3] * v[j][3]); }
    const float rstd = 1.0f / sqrtf(wave_sum(s2) * (1.0f / DM) + LN_EPS);
    if (lane == 0) { f32x2 st = {mean, rstd}; *(f32x2*)(stats + 2 * row) = st; }
    u32x2* ob = (u32x2*)(XB + (size_t)row * DM) + lane;
#pragma unroll
    for (int j = 0; j < 8; ++j) { v[j] = v[j] * rstd * gv[j] + bv[j]; u32x2 w; w.x = pk2(v[j][0], v[j][1]); w.y = pk2(v[j][2], v[j][3]); ob[64 * j] = w; }
}
DI void ln_fold_phase(const float* X, bf16_t* XB, bf16_t* XP, bf16_t* XM, float* stats, const float* g, const float* bta, int vb) {
    const int tid = ltid(), lane = tid & 63, wv = (vb - 8) * 8 + (tid >> 6), nwv = ((int)gridDim.x - 8) * 8;
    f32x4 gv[8], bv[8];
#pragma unroll
    for (int j = 0; j < 8; ++j) { gv[j] = ((const f32x4*)g)[64 * j + lane]; bv[j] = ((const f32x4*)bta)[64 * j + lane]; }
    for (int it = wv; it < 2 * (HSEQ + 1); it += nwv) {
        const int b = it / (HSEQ + 1), i = it - b * (HSEQ + 1);
        const bool pair = (i != 0) && (i != HSEQ);
        const int rowA = b * SEQ + i, rowB = b * SEQ + (SEQ - i);
        f32x4 va[8], vb[8];
        { const f32x4* xa = (const f32x4*)(X + (size_t)rowA * DM) + lane;
#pragma unroll
          for (int j = 0; j < 8; ++j) va[j] = xa[64 * j]; }
        if (pair) { const f32x4* xq = (const f32x4*)(X + (size_t)rowB * DM) + lane;
#pragma unroll
            for (int j = 0; j < 8; ++j) vb[j] = xq[64 * j]; }
        else {
#pragma unroll
            for (int j = 0; j < 8; ++j) vb[j] = (f32x4){0.f, 0.f, 0.f, 0.f}; }
        ln_row(va, gv, bv, stats, rowA, XB, lane);
        if (pair) ln_row(vb, gv, bv, stats, rowB, XB, lane);
        if (i != HSEQ) {
            u32x2* op = (u32x2*)(XP + (size_t)(b * HSEQ + i) * DM) + lane; u32x2* om = (u32x2*)(XM + (size_t)(b * HSEQ + i) * DM) + lane;
#pragma unroll
            for (int j = 0; j < 8; ++j) { f32x4 p = va[j], m = {0.f, 0.f, 0.f, 0.f}; if (pair) { p = va[j] + vb[j]; m = va[j] - vb[j]; }
                u32x2 w; w.x = pk2(p[0], p[1]); w.y = pk2(p[2], p[3]); op[64 * j] = w; w.x = pk2(m[0], m[1]); w.y = pk2(m[2], m[3]); om[64 * j] = w; }
        }
    }
}

constexpr int CT = 16, CROWS = CT + 30;
DI void conv_tile(const bf16_t* GLU, bf16_t* CV, const float* cw, const float* cb, const float* lg, const float* lb, int tile, LAS unsigned char* lds) {
    const int tid = ltid(), lane = tid & 63, wid = __builtin_amdgcn_readfirstlane(tid >> 6);
    const int tok0 = tile * CT, b = tok0 >> 13, s0 = tok0 & (SEQ - 1);
    LAS unsigned char* ldst = lds + tid * 4;
    asm volatile("" : "+v"(ldst));
    asm volatile("" : "+s"(GLU), "+s"(CV), "+s"(cw), "+s"(cb), "+s"(lg), "+s"(lb));
    constexpr int NLD = (CROWS * 128 + 511) / 512;
    u32x4 rv[NLD];
#pragma unroll
    for (int i = 0; i < NLD; ++i) { const int idx = i * 512 + tid, rr = idx >> 7, c16 = idx & 127, s = s0 - 15 + rr; rv[i] = (u32x4){0u, 0u, 0u, 0u};
        if (idx < CROWS * 128 && s >= 0 && s < SEQ) rv[i] = *(const u32x4*)(GLU + ((size_t)(b * SEQ + s)) * 1024 + c16 * 8); }
    float w0[31], w1[31];
#pragma unroll
    for (int j = 0; j < 31; ++j) { const f32x2 w = *(const f32x2*)(cw + j * 1024 + 2 * tid); w0[j] = w[0]; w1[j] = w[1]; }
    __syncthreads();
#pragma unroll
    for (int i = 0; i < NLD; ++i) { const int idx = i * 512 + tid, rr = idx >> 7, c16 = idx & 127; if (idx < CROWS * 128) *(LAS u32x4*)(lds + rr * 2048 + c16 * 16) = rv[i]; }
    __syncthreads();
    float a0[CT], a1[CT];
#pragma unroll
    for (int t = 0; t < CT; ++t) { a0[t] = 0.f; a1[t] = 0.f; }
    unsigned vq[4];
#pragma unroll
    for (int q = 0; q < 4; ++q) vq[q] = *(const LAS unsigned*)(ldst + q * 2048);
#pragma unroll
    for (int rr = 0; rr < CROWS; ++rr) { const unsigned v = vq[rr & 3]; if (rr + 4 < CROWS) vq[rr & 3] = *(const LAS unsigned*)(ldst + (rr + 4) * 2048);
        if ((rr & 3) == 3) asm volatile("" ::: "memory");
        const float x0 = __uint_as_float(v << 16), x1 = __uint_as_float(v & 0xffff0000u);
#pragma unroll
        for (int t = 0; t < CT; ++t) { const int j = rr - t; if (j >= 0 && j <= 30) { a0[t] += x0 * w0[j]; a1[t] += x1 * w1[j]; } } }
    const f32x2 cbv = *(const f32x2*)(cb + 2 * tid);
    __syncthreads();
    { LAS float* yw = (LAS float*)lds + 2 * tid;
      asm volatile("" : "+v"(yw));
#pragma unroll
      for (int t = 0; t < CT; ++t) { f32x2 y = {a0[t] + cbv[0], a1[t] + cbv[1]}; *(LAS f32x2*)(yw + t * 1024) = y; } }
    __syncthreads();
    {
        f32x4 gv[4], bv[4];
#pragma unroll
        for (int i = 0; i < 4; ++i) { gv[i] = *(const f32x4*)(lg + 4 * lane + 256 * i); bv[i] = *(const f32x4*)(lb + 4 * lane + 256 * i); }
#pragma unroll
        for (int tt = 0; tt < 2; ++tt) { const int t = 2 * wid + tt; const LAS float* yr = (const LAS float*)lds + t * 1024 + 4 * lane;
            f32x4 v[4]; float s = 0.f;
#pragma unroll
            for (int i = 0; i < 4; ++i) { v[i] = *(const LAS f32x4*)(yr + 256 * i); s += (v[i][0] + v[i][1]) + (v[i][2] + v[i][3]); }
            const float mean = wave_sum(s) * (1.0f / 1024.0f); float s2 = 0.f;
#pragma unroll
            for (int i = 0; i < 4; ++i) { v[i] = v[i] - mean; s2 += (v[i][0] * v[i][0] + v[i][1] * v[i][1]) + (v[i][2] * v[i][2] + v[i][3] * v[i][3]); }
            const float rstd = 1.0f / sqrtf(wave_sum(s2) * (1.0f / 1024.0f) + LN_EPS);
            bf16_t* op = CV + (size_t)(tok0 + t) * KBR + 4 * lane;
#pragma unroll
            for (int i = 0; i < 4; ++i) { f32x4 y = v[i] * rstd * gv[i] + bv[i];
#pragma unroll
                for (int j = 0; j < 4; ++j) y[j] *= sigmoidf_fast(y[j]);
                u32x2 w; w.x = pk2(y[0], y[1]); w.y = pk2(y[2], y[3]); *(u32x2*)(op + 256 * i) = w; } }
    }
}

DI void attn_unit(const bf16_t* Q, const bf16_t* KK, const bf16_t* VT, bf16_t* OO, int b, int h, int qt, LAS unsigned char* lds) {
    const int tid = ltid(), lane = tid & 63, wid = __builtin_amdgcn_readfirstlane(tid >> 6), r = lane & 31, h2 = lane >> 5;
    const int tok0 = b * SEQ + qt * 256 + wid * 32;
    asm volatile("" : "+s"(Q), "+s"(KK), "+s"(VT), "+s"(OO));
    LAS unsigned char* ldsK = lds; LAS unsigned char* ldsV = lds + 65536;
    __syncthreads();
#pragma unroll
    for (int i = 0; i < 8; ++i) { const int id = i * 512 + tid, row = id >> 4, ch = id & 15;
        const u32x4 v = *(const u32x4*)(KK + (size_t)(b * 256 + row) * 512 + h * 128 + ch * 8);
        *(LAS u32x4*)(ldsK + row * 256 + ((ch ^ (row & 15)) << 4)) = v; }
#pragma unroll
    for (int i = 0; i < 8; ++i) { const int id = i * 512 + tid, row = id >> 5, ch = id & 31;
        const u32x4 v = *(const u32x4*)(VT + (size_t)(h * 128 + row) * 512 + b * 256 + ch * 8);
        *(LAS u32x4*)(ldsV + row * 512 + ((ch ^ (row & 31)) << 4)) = v; }
    bf16x8 qf[8];
    { const bf16_t* qp = Q + (size_t)(tok0 + r) * 512 + h * 128 + 8 * h2;
#pragma unroll
      for (int s = 0; s < 8; ++s) qf[s] = *(const bf16x8*)(qp + 16 * s); }
    __syncthreads();
    f32x16 sacc[8];
    { const LAS unsigned char* kbase = ldsK + r * 256; const int rx = r & 15;
#pragma unroll
      for (int kb = 0; kb < 8; ++kb) {
#pragma unroll
        for (int i = 0; i < 16; ++i) sacc[kb][i] = 0.f;
#pragma unroll
        for (int s = 0; s < 8; ++s) { const bf16x8 kf = *(const LAS bf16x8*)(kbase + kb * 8192 + (((2 * s + h2) ^ rx) << 4)); sacc[kb] = __builtin_amdgcn_mfma_f32_32x32x16_bf16(kf, qf[s], sacc[kb], 0, 0, 0); }
      } }
    float mx = -3.0e38f;
#pragma unroll
    for (int kb = 0; kb < 8; ++kb)
#pragma unroll
        for (int i = 0; i < 16; ++i) mx = fmaxf(mx, sacc[kb][i]);
    mx = fmaxf(mx, __shfl_xor(mx, 32));
    float sum = 0.f;
#pragma unroll
    for (int kb = 0; kb < 8; ++kb)
#pragma unroll
        for (int i = 0; i < 16; ++i) { const float p = __expf(sacc[kb][i] - mx); sacc[kb][i] = p; sum += p; }
    sum += __shfl_xor(sum, 32);
    const float inv = 1.0f / sum;
    f32x16 oacc[4];
#pragma unroll
    for (int db = 0; db < 4; ++db)
#pragma unroll
        for (int i = 0; i < 16; ++i) oacc[db][i] = 0.f;
    { const LAS unsigned char* vbase = ldsV + r * 512 + h2 * 8;
#pragma unroll
      for (int kb = 0; kb < 8; ++kb)
#pragma unroll
        for (int s2 = 0; s2 < 2; ++s2) {
            u32x4 pw; pw.x = pk2(sacc[kb][8 * s2 + 0], sacc[kb][8 * s2 + 1]); pw.y = pk2(sacc[kb][8 * s2 + 2], sacc[kb][8 * s2 + 3]);
            pw.z = pk2(sacc[kb][8 * s2 + 4], sacc[kb][8 * s2 + 5]); pw.w = pk2(sacc[kb][8 * s2 + 6], sacc[kb][8 * s2 + 7]);
            const bf16x8 pf = __builtin_bit_cast(bf16x8, pw);
            const int c0 = 4 * kb + 2 * s2;
#pragma unroll
            for (int db = 0; db < 4; ++db) {
                const u32x2 lo = *(const LAS u32x2*)(vbase + db * 16384 + ((c0 ^ r) << 4)), hi = *(const LAS u32x2*)(vbase + db * 16384 + (((c0 + 1) ^ r) << 4));
                u32x4 vw; vw.x = lo.x; vw.y = lo.y; vw.z = hi.x; vw.w = hi.y;
                oacc[db] = __builtin_amdgcn_mfma_f32_32x32x16_bf16(__builtin_bit_cast(bf16x8, vw), pf, oacc[db], 0, 0, 0);
            }
        } }
    bf16_t* op = OO + (size_t)(tok0 + r) * KBR + h * 128 + 4 * h2;
#pragma unroll
    for (int db = 0; db < 4; ++db)
#pragma unroll
        for (int g = 0; g < 4; ++g) { u32x2 w; w.x = pk2(oacc[db][4 * g] * inv, oacc[db][4 * g + 1] * inv); w.y = pk2(oacc[db][4 * g + 2] * inv, oacc[db][4 * g + 3] * inv);
            *(u32x2*)(op + db * 32 + 8 * g) = w; }
}

#define XB_TMO      128
#define XB_XCNT(j)  (256  + 64 * (j))
#define XB_XSUB(j)  (1280 + 64 * (j))
#define XB_XGEN(j)  (2304 + 64 * (j))
#define XB_TOP      3328
#define XB_TOPGEN   3392
#define XCD_BAR_WORDS 3456
#define XB_SPIN_CAP (1u << 18)

__device__ __forceinline__ unsigned xb_ld(unsigned* p)              { return __hip_atomic_load(p, __ATOMIC_RELAXED, __HIP_MEMORY_SCOPE_AGENT); }
__device__ __forceinline__ unsigned xb_add(unsigned* p, unsigned v) { return __hip_atomic_fetch_add(p, v, __ATOMIC_RELAXED, __HIP_MEMORY_SCOPE_AGENT); }
__device__ __forceinline__ unsigned xb_xcc_id() { return (unsigned)__builtin_amdgcn_s_getreg((3 << 11) | 20) & 0xFu; }
#define XB_SPIN(cond, bar) do { unsigned _sp = 0; while (cond) { __builtin_amdgcn_s_sleep(1); \
    if ((++_sp & 255u) == 0u) { if (xb_ld(&(bar)[XB_TMO])) break; if (_sp > XB_SPIN_CAP) { atomicAdd(&(bar)[XB_TMO], 1u); break; } } } } while (0)

struct XcdBarrier {
    unsigned* bar; unsigned x;
    volatile LAS unsigned* st;
};

__device__ __forceinline__ XcdBarrier xcd_barrier_post(unsigned* bar, volatile LAS unsigned* st) {
    XcdBarrier b; b.bar = bar; b.x = xb_xcc_id(); b.st = st;
    if (threadIdx.x == 0) (void)xb_add(&bar[XB_XCNT(b.x)], 1u);
    return b;
}
__device__ __forceinline__ void xcd_barrier_complete(unsigned* bar, unsigned x, unsigned& nloc, unsigned& nx) {
    const unsigned G = gridDim.x * gridDim.y * gridDim.z;
    unsigned sum, cnt, mine, sp = 0u;
    for (;;) {
        sum = 0u; cnt = 0u; mine = 0u;
#pragma unroll
        for (unsigned j = 0; j < 16; ++j) { const unsigned c = xb_ld(&bar[XB_XCNT(j)]); sum += c; cnt += (c > 0u) ? 1u : 0u; mine = (j == x) ? c : mine; }
        if (sum == G) break;
        __builtin_amdgcn_s_sleep(1);
        if ((++sp & 255u) == 0u) { if (xb_ld(&bar[XB_TMO])) break; if (sp > XB_SPIN_CAP) { atomicAdd(&bar[XB_TMO], 1u); break; } }
    }
    nloc = mine > 0u ? mine : 1u; nx = cnt > 0u ? cnt : 1u;
}

__device__ __forceinline__ void xcd_barrier(const XcdBarrier& b) {
    asm volatile("s_waitcnt vmcnt(0)" ::: "memory");
    __syncthreads();
    if (threadIdx.x == 0) {
        unsigned* bar = b.bar;
        __builtin_amdgcn_s_waitcnt(0);
        unsigned nloc = b.st[0], nx = b.st[1];
        if (nloc == 0u) { xcd_barrier_complete(bar, b.x, nloc, nx); b.st[0] = nloc; b.st[1] = nx; }
        const unsigned old = xb_add(&bar[XB_XSUB(b.x)], 1u);
        const unsigned gen = old / nloc;
        if (old + 1u == (gen + 1u) * nloc) {
            __builtin_amdgcn_fence(__ATOMIC_RELEASE, "agent");
            asm volatile("s_waitcnt vmcnt(0)" ::: "memory");
            const unsigned og = xb_add(&bar[XB_TOP], 1u);
            const unsigned tg = og / nx;
            if (og + 1u == (tg + 1u) * nx) xb_add(&bar[XB_TOPGEN], 1u);
            else XB_SPIN(xb_ld(&bar[XB_TOPGEN]) == tg, bar);
            __builtin_amdgcn_fence(__ATOMIC_ACQUIRE, "agent");
            xb_add(&bar[XB_XGEN(b.x)], 1u);
            asm volatile("s_waitcnt vmcnt(0)" ::: "memory");
        } else {
            XB_SPIN(xb_ld(&bar[XB_XGEN(b.x)]) == gen, bar);
            __builtin_amdgcn_fence(__ATOMIC_ACQUIRE, "agent");
            asm volatile("s_waitcnt vmcnt(0)" ::: "memory");
        }
    }
    __syncthreads();
}


constexpr int NPHASE = 1 + 11 * NLAYER;

__global__ void __launch_bounds__(512, 2) fwd_mega(Params P) {
    extern __shared__ __attribute__((aligned(16))) unsigned char lds_raw[];
    LAS unsigned char* lds = (LAS unsigned char*)lds_raw;
    const int G = gridDim.x;
    if (threadIdx.x == 0) {
        unsigned vc = blockIdx.x;
#if ONE_LAUNCH
        unsigned* cen = (unsigned*)(P.ws + WS_BAR);
        const unsigned x = xb_xcc_id(), rank = xb_add(cen + 8 * x, 1u);
        unsigned sum = 0, base = 0, sp = 0;
        for (;;) { sum = 0; base = 0;
#pragma unroll
            for (unsigned j = 0; j < 16; ++j) { const unsigned cj = xb_ld(cen + 8 * j); sum += cj; base += (j < x) ? cj : 0u; }
            if (sum == (unsigned)G) break;
            __builtin_amdgcn_s_sleep(1);
            if (++sp > XB_SPIN_CAP) break; }
        const unsigned cp = base + rank, per = (unsigned)G / 8u;
        if (sum == (unsigned)G && (G % 8) == 0 && cp < (unsigned)G) vc = (cp % per) * 8u + cp / per;
#endif
        *(volatile LAS unsigned*)(lds + LDS_BYTES - 8) = vc;
    }
    __syncthreads();
    const int c = __builtin_amdgcn_readfirstlane((int)*(volatile LAS unsigned*)(lds + LDS_BYTES - 8));
    volatile LAS unsigned* bar_st = (volatile LAS unsigned*)(lds + LDS_BYTES - 16);
    if (threadIdx.x == 0) { bar_st[0] = 0u; bar_st[1] = 0u; }
    __syncthreads();
    XcdBarrier gbar = xcd_barrier_post((unsigned*)(P.ws + WS_BAR), bar_st);
#ifdef PROBE_MASK
    unsigned long long pr_acc = 0, pr_t0 = 0;
#endif
    for (int ph = P.ph_lo; ph < P.ph_hi; ++ph) {
#ifdef PROBE_MASK
        if ((PROBE_MASK >> ph) & 1) pr_t0 = wall_clock64();
#endif
        unsigned char* ws = P.ws;
        asm volatile("" : "+s"(ws));
        const char* xb = (const char*)(ws + WS_XB);
        if (ph == 0) {
            if (PHON(0)) setup_phase(P, lds);
            if (PHON(1)) convert_weights(P, 0, lds);
        } else {
            const int l = (ph - 1) / 11, sp = (ph - 1) % 11;
            if (PHON(2) && (sp == 0 || sp == 8)) {
                SchedFfnUp S{xb, (const char*)(ws + (sp == 0 ? WS_W13A : WS_W13B)), G, c};
                EpiSwiGLU E{(bf16_t*)(ws + WS_H)};
                gemm_phase(lds, DM, DM, DM, S, E);
            } else if (PHON(3) && (sp == 1 || sp == 9)) {
                SchedPlain S{(const char*)(ws + WS_H), (const char*)(ws + (sp == 1 ? WS_W2A : WS_W2B)), 64, 8, (size_t)256 * DFF * 2, (size_t)256 * DFF * 2, G, c};
                const float* stats = (const float*)(ws + WS_STATS);
                if (l == 0 && sp == 1) { EpiResid<false, 1> E{P.in[0], P.out, stats, nullptr, nullptr}; gemm_phase(lds, DFF, DFF, DFF, S, E); }
                else {
                    const float* lg = (sp == 1) ? P.in[21] + (size_t)(l - 1) * DM : P.in[17] + (size_t)l * DM;
                    const float* lb = (sp == 1) ? P.in[22] + (size_t)(l - 1) * DM : P.in[18] + (size_t)l * DM;
                    asm volatile("" : "+s"(lg), "+s"(lb), "+s"(stats));
                    EpiResid<true, 1> E{P.out, P.out, stats, lg, lb}; gemm_phase(lds, DFF, DFF, DFF, S, E); }
            } else if (PHON(4) && (sp == 2 || sp == 7 || sp == 10)) {
                const int gi = sp == 2 ? 4 : (sp == 7 ? 17 : 21);
                if (sp == 2) {
                    if (c < 8) { SchedKV S{(const char*)(ws + WS_MEMB), (const char*)(ws + WS_WKV), c}; EpiKV E{(bf16_t*)(ws + WS_KK), (bf16_t*)(ws + WS_VT)}; gemm_phase(lds, DM, DM, DM, S, E); }
                    else ln_fold_phase(P.out, (bf16_t*)(ws + WS_XB), (bf16_t*)(ws + WS_XP), (bf16_t*)(ws + WS_XM), (float*)(ws + WS_STATS), P.in[4] + (size_t)l * DM, P.in[5] + (size_t)l * DM, c);
                } else
                ln_phase(P.out, (bf16_t*)(ws + WS_XB), (float*)(ws + WS_STATS), P.in[gi] + (size_t)l * DM, P.in[gi + 1] + (size_t)l * DM, sp == 10 && l == NLAYER - 1);
                if (PHON(1) && sp == 10 && l + 1 < NLAYER) convert_weights(P, l + 1, lds);
            } else if (PHON(5) && sp == 3) {
                {
                    const int tid = ltid(), lane = tid & 63, gwv = c * 8 + (tid >> 6);
                    if (gwv < 1024) { const int bb = gwv >> 9, ch = gwv & 511;
                        const u32x4* xr = (const u32x4*)(xb + ((size_t)(bb * SEQ + HSEQ)) * ROWB) + lane; const u32x4* wrow = (const u32x4*)(ws + WS_WFT + (size_t)ch * ROWB) + lane; float sdot = 0.f;
#pragma unroll
                        for (int i = 0; i < 4; ++i) { f32x4 x0, x1, w0, w1; unpack8(xr[64 * i], x0, x1); unpack8(wrow[64 * i], w0, w1);
                            sdot += (x0[0] * w0[0] + x0[1] * w0[1]) + (x0[2] * w0[2] + x0[3] * w0[3]) + (x1[0] * w1[0] + x1[1] * w1[1]) + (x1[2] * w1[2] + x1[3] * w1[3]); }
                        sdot = wave_sum(sdot);
                        if (lane == 0) ((float*)(ws + WS_UH))[gwv] = (sdot + ((const float*)(ws + WS_BIAST))[ch]) * 0.011048543456039806f; }
                }
                SchedWin S{xb, (const char*)(ws + WS_WIN), (const char*)(ws + WS_WFT), (const char*)(ws + WS_XP), (const char*)(ws + WS_XM), G, c};
                EpiWin E{P.in[7] + (size_t)l * DIN, (const float*)(ws + WS_BIAST), (bf16_t*)(ws + WS_GLU), (bf16_t*)(ws + WS_Q), (bf16_t*)(ws + WS_G), (bf16_t*)(ws + WS_TT)};
                gemm_phase(lds, DM, DM, DM, S, E);
            } else if (sp == 4) {
                if (PHON(6)) { SchedDft S{(const char*)(ws + WS_CM), (const char*)(ws + WS_TT), G, c};
                  EpiDft E{(bf16_t*)(ws + WS_BR) + 1024, (const float*)(ws + WS_UH)};
                  gemm_phase(lds, HSEQ, HSEQ, SEQ, S, E); }
                const int half = G >> 1, hi = (c >= half) ? 1 : 0, cc = c - hi * half;
                if (hi) {
                    const int tid = ltid(), lane = tid & 63, gwv = cc * 8 + (tid >> 6);
                    if (gwv < 1024) { const int bb = gwv >> 9, ch = gwv & 511;
                        const u32x4* tr = (const u32x4*)(ws + WS_TT + ((size_t)ch * SEQ + (size_t)bb * HSEQ) * 2) + lane; float sa = 0.f;
#pragma unroll
                        for (int i = 0; i < 8; ++i) { f32x4 x0, x1; unpack8(tr[64 * i], x0, x1); sa += (x0[0] - x0[1]) + (x0[2] - x0[3]) + (x1[0] - x1[1]) + (x1[2] - x1[3]); }
                        sa = wave_sum(sa);
                        if (lane == 0) { bf16_t* orow = (bf16_t*)(ws + WS_BR) + (size_t)(bb * SEQ + HSEQ) * KBR; orow[1024 + ch] = f2bf(sa * 0.011048543456039806f + ((const float*)(ws + WS_UH))[gwv]); orow[1536 + ch] = 0; } }
                }
                if (PHON(7)) { const int nct = hi ? 6 : 2, ct0 = hi ? 2 * half : 0;
                    for (int j = 0; j < nct; ++j)
                        conv_tile((const bf16_t*)(ws + WS_GLU), (bf16_t*)(ws + WS_BR), P.in[8] + (size_t)l * 31 * 1024, P.in[9] + (size_t)l * 1024, P.in[10] + (size_t)l * 1024, P.in[11] + (size_t)l * 1024, ct0 + cc + half * j, lds); }
                if (PHON(8) && hi) for (int j = 0; j < 2; ++j) { const int t = cc + half * j;
                    attn_unit((const bf16_t*)(ws + WS_Q), (const bf16_t*)(ws + WS_KK), (const bf16_t*)(ws + WS_VT), (bf16_t*)(ws + WS_BR) + 2048, t >> 7, (t >> 5) & 3, t & 31, lds); }
                __syncthreads();
            } else if (PHON(9) && sp == 5) {
                SchedPlain S{(const char*)(ws + WS_BR), (const char*)(ws + WS_WBR), 64, 8, (size_t)256 * KBR * 2, (size_t)256 * KBR * 2, G, c};
                EpiBranchFused E{(const bf16_t*)(ws + WS_G), (bf16_t*)(ws + WS_MG)};
                gemm_phase(lds, KBR, KBR, KBR, S, E);
            } else if (PHON(10) && sp == 6) {
                SchedPlain S{(const char*)(ws + WS_MG), (const char*)(ws + WS_WOUT), 64, 8, (size_t)256 * DM * 2, (size_t)256 * DM * 2, G, c};
                const float* stats = (const float*)(ws + WS_STATS); const float* lg = P.in[4] + (size_t)l * DM; const float* lb = P.in[5] + (size_t)l * DM;
                asm volatile("" : "+s"(lg), "+s"(lb), "+s"(stats));
                EpiResid<true, 2> E{P.out, P.out, stats, lg, lb};
                gemm_phase(lds, DM, DM, DM, S, E);
            }
        }
        if (ph + 1 < P.ph_hi) { if (P.ph_lo < 0) cg::this_grid().sync(); else xcd_barrier(gbar); }
#ifdef PROBE_MASK
        if ((PROBE_MASK >> ph) & 1) pr_acc += wall_clock64() - pr_t0;
#endif
    }
#ifdef PROBE_MASK
    if (c == 0) { const unsigned long long t0 = wall_clock64(); while (wall_clock64() - t0 < (unsigned long long)PROBE_MULT * pr_acc) __builtin_amdgcn_s_sleep(32); }
#endif
}

extern "C" void kernel_launch(void* const* d_in, const int* in_sizes, int n_in, void* d_out, int out_size, void* d_ws, size_t ws_size, hipStream_t stream) {
    static int grid = 0;
    if (grid == 0) {
        if (n_in != 23 || out_size != NTOK * DM || ws_size < WS_END) { fprintf(stderr, "kernel_launch: unexpected shapes (n_in %d, out %d, ws %zu < %zu)\n", n_in, out_size, ws_size, (size_t)WS_END); grid = -1; return; }
        int dev = 0, cus = 0, per_cu = 0;
        hipGetDevice(&dev);
        hipDeviceGetAttribute(&cus, hipDeviceAttributeMultiprocessorCount, dev);
        hipFuncSetAttribute((const void*)fwd_mega, hipFuncAttributeMaxDynamicSharedMemorySize, LDS_BYTES);
        hipOccupancyMaxActiveBlocksPerMultiprocessor(&per_cu, (const void*)fwd_mega, 512, LDS_BYTES);
        if (per_cu < 1) { fprintf(stderr, "kernel_launch: occupancy query says %d blocks per CU\n", per_cu); per_cu = 1; }
        (void)hipGetLastError();
        grid = cus;
    }
    if (grid < 0) return;
    Params p{};
    for (int i = 0; i < 23; ++i) p.in[i] = (const float*)d_in[i];
    p.out = (float*)d_out; p.ws = (unsigned char*)d_ws;
#if ONE_LAUNCH
    hipMemsetAsync((unsigned char*)d_ws + WS_BAR, 0, XCD_BAR_WORDS * sizeof(unsigned), stream);
    p.ph_lo = 0; p.ph_hi = NPHASE;
    void* args[] = {&p};
    hipError_t e = hipLaunchCooperativeKernel((const void*)fwd_mega, dim3(grid), dim3(512), args, LDS_BYTES, stream);
    if (e != hipSuccess) fprintf(stderr, "cooperative launch failed: %s (grid %d)\n", hipGetErrorString(e), grid);
#else
    for (int ph = 0; ph < NPHASE; ++ph) { p.ph_lo = ph; p.ph_hi = ph + 1; hipLaunchKernelGGL(fwd_mega, dim3(grid), dim3(512), LDS_BYTES, stream, p); }
#endif
}
```

```cpp
#include <hip/hip_runtime.h>
#include <hip/hip_cooperative_groups.h>
#include <cstdio>
namespace cg = cooperative_groups;

#ifndef PH_MASK
#define PH_MASK 0xFFFF
#endif
#define PHON(k) ((PH_MASK >> (k)) & 1)
#ifndef ONE_LAUNCH
#define ONE_LAUNCH 1
#endif

#define LAS __attribute__((address_space(3)))
#define DI __device__ __forceinline__
typedef unsigned short bf16_t;
typedef short bf16x8 __attribute__((ext_vector_type(8)));
typedef float f32x4 __attribute__((ext_vector_type(4)));
typedef float f32x2 __attribute__((ext_vector_type(2)));
typedef float f32x16 __attribute__((ext_vector_type(16)));
typedef unsigned u32x4 __attribute__((ext_vector_type(4)));
typedef unsigned u32x2 __attribute__((ext_vector_type(2)));
typedef __bf16 bf16x2_t __attribute__((ext_vector_type(2)));

constexpr int NTOK = 16384, DM = 2048, DFF = 5632, DIN = 9216, SEQ = 8192, NLAYER = 2;
constexpr float DN_ALPHA = 1.4142135623730951f;
constexpr float LN_EPS = 1e-5f;

constexpr int HSEQ = SEQ / 2;
constexpr size_t WS_CM    = 0;
constexpr size_t CM_HALF  = (size_t)HSEQ * HSEQ * 2;
constexpr size_t WS_XB    = WS_CM + 2 * CM_HALF;
constexpr size_t WS_MEMB  = WS_XB + (size_t)NTOK * DM * 2;
constexpr size_t WS_XP    = WS_MEMB + (size_t)512 * DM * 2;
constexpr size_t WS_XM    = WS_XP + (size_t)2 * HSEQ * DM * 2;
constexpr size_t WS_W13A  = WS_XM + (size_t)2 * HSEQ * DM * 2;
constexpr size_t WS_W2A   = WS_W13A + (size_t)2 * DFF * DM * 2;
constexpr size_t WS_W13B  = WS_W2A + (size_t)DM * DFF * 2;
constexpr size_t WS_W2B   = WS_W13B + (size_t)2 * DFF * DM * 2;
constexpr size_t WS_WIN   = WS_W2B + (size_t)DM * DFF * 2;
constexpr size_t WS_WFT   = WS_WIN + (size_t)DIN * DM * 2;
constexpr int KBR = 2560;
constexpr size_t WS_WBR   = WS_WFT + (size_t)1024 * DM * 2;
constexpr size_t WS_WKV   = WS_WBR + (size_t)DM * KBR * 2;
constexpr size_t WS_WOUT  = WS_WKV + (size_t)1024 * DM * 2;
constexpr size_t WS_BIAST = WS_WOUT + (size_t)DM * DM * 2;
constexpr size_t WS_STATS = WS_BIAST + 4096;
constexpr size_t WS_BAR   = WS_STATS + (size_t)NTOK * 8;
constexpr size_t WS_UH    = WS_BAR + 16384;
constexpr size_t WS_KK    = WS_UH + 4096;
constexpr size_t WS_VT    = WS_KK + (size_t)512 * 512 * 2;
constexpr size_t WS_MIX   = WS_VT + (size_t)512 * 512 * 2;
constexpr size_t WS_G     = WS_MIX;
constexpr size_t WS_GLU   = WS_G + (size_t)NTOK * 6144 * 2;
constexpr size_t WS_TT    = WS_GLU + (size_t)NTOK * 1024 * 2;
constexpr size_t WS_MG    = WS_GLU;
constexpr size_t WS_Q     = WS_TT + (size_t)1024 * NTOK * 2;
constexpr size_t WS_BR    = WS_Q + (size_t)NTOK * 512 * 2;
constexpr size_t WS_END   = WS_BR + (size_t)NTOK * KBR * 2;
constexpr size_t WS_H     = WS_MIX;
static_assert((size_t)NTOK * DFF * 2 <= WS_END - WS_MIX, "H must fit the union region");

constexpr int LDS_BYTES = 131072 + 4096;

DI int ltid() { int t = threadIdx.x; asm volatile("" : "+v"(t)); return t; }
DI unsigned pk2(float a, float b) { f32x2 v = {a, b}; bf16x2_t r = __builtin_convertvector(v, bf16x2_t); return __builtin_bit_cast(unsigned, r); }
DI bf16_t f2bf(float a) { return (bf16_t)(pk2(a, 0.f) & 0xffffu); }
DI float sigmoidf_fast(float x) { return __builtin_amdgcn_rcpf(1.0f + __expf(-x)); }
DI float wave_sum(float v) {
#pragma unroll
    for (int o = 1; o < 64; o <<= 1) v += __shfl_xor(v, o);
    return v;
}
template <int O> DI float shx(float v) { return __shfl_xor(v, O); }
DI u32x4 pack8(const f32x4 v0, const f32x4 v1) { u32x4 w; w.x = pk2(v0[0], v0[1]); w.y = pk2(v0[2], v0[3]); w.z = pk2(v1[0], v1[1]); w.w = pk2(v1[2], v1[3]); return w; }
DI void unpack8(const u32x4 w, f32x4& v0, f32x4& v1) {
    v0[0] = __uint_as_float(w.x << 16); v0[1] = __uint_as_float(w.x & 0xffff0000u); v0[2] = __uint_as_float(w.y << 16); v0[3] = __uint_as_float(w.y & 0xffff0000u);
    v1[0] = __uint_as_float(w.z << 16); v1[1] = __uint_as_float(w.z & 0xffff0000u); v1[2] = __uint_as_float(w.w << 16); v1[3] = __uint_as_float(w.w & 0xffff0000u);
}

constexpr int BK = 64, HALF = 128, HTB = HALF * BK * 2;
DI int lds_byte(int r, int c) { const int st = (r >> 4) * 2 + (c >> 5), rr = r & 15, cc = c & 31, ob = rr * 64 + cc * 2; return st * 1024 + (ob ^ (((ob >> 9) & 1) << 5)); }
DI void stage_rc(int b, int& R, int& C) { const int st = b / 1024, sb = b % 1024, swz = sb ^ (((sb >> 9) & 1) << 5); R = (st >> 1) * 16 + swz / 64; C = (st & 1) * 32 + (swz % 64) / 2; }
DI int perm32(int rho) { const int n = rho >> 4, i = rho & 15; return 8 * (i >> 2) + 4 * n + (i & 3); }

struct Unit { const char* A; const char* B0; const char* B1; int kind, pm, pn; };

DI void tile_decode(int wgid, int nM, int nN, int& pm, int& pn) {
    const int nwg = nM * nN;
    { const int q = nwg / 8, r = nwg % 8, xcd = wgid % 8, off = wgid / 8; wgid = (xcd < r ? xcd * (q + 1) : r * (q + 1) + (xcd - r) * q) + off; }
    const int nig = 8 * nN, gid = wgid / nig, fm = gid * 8, gsz = (nM - fm) < 8 ? (nM - fm) : 8;
    pm = fm + ((wgid % nig) % gsz); pn = (wgid % nig) / gsz;
}

template <class Epi, class Sched>
DI void gemm_phase(LAS unsigned char* lds, const int K, const int lda, const int ldb, const Sched& S, const Epi& E) {
    const int tid = ltid(), wid = __builtin_amdgcn_readfirstlane(tid >> 6), lane = tid & 63, wr = wid >> 2, wc = wid & 3, fr = lane & 15, fq = lane >> 4;
    const int nt = K / BK;
    unsigned voffA[2], voffB[2];
#pragma unroll
    for (int i = 0; i < 2; ++i) { int R, C; stage_rc(tid * 16 + i * 8192, R, C); const int Rb = Epi::PERM ? ((R & ~31) + perm32(R & 31)) : R;
        voffA[i] = (unsigned)(R * lda + C) * 2u; voffB[i] = (unsigned)(Rb * ldb + C) * 2u; }
    const size_t kstep = (size_t)(BK * 2);
    const size_t hstepA = (size_t)HALF * lda * 2;
    const unsigned ldsw = (unsigned)wid * 1024u;
    const int aoff = lds_byte(wr * 64 + fr, fq * 8), boff = lds_byte(wc * 32 + fr, fq * 8);
#define G_SA(b, h) (((b) * 2 + (h)) * HTB)
#define G_SB(b, h) ((4 + (b) * 2 + (h)) * HTB)
#define G_STAGE(bufoff, gbase, voff) do { _Pragma("unroll") for (int _i = 0; _i < 2; ++_i) \
        __builtin_amdgcn_global_load_lds((const unsigned*)((const char*)(gbase) + (voff)[_i]), (LAS unsigned*)(lds + (bufoff) + ldsw + _i * 8192), 16, 0, 0); } while (0)
#define G_LDA(dst, b, h) do { _Pragma("unroll") for (int m = 0; m < 4; ++m) _Pragma("unroll") for (int k = 0; k < 2; ++k) dst[m][k] = *(const LAS bf16x8*)(lds + G_SA(b, h) + aoff + m * 2048 + k * 1024); } while (0)
#define G_LDB(dst, b, h) do { _Pragma("unroll") for (int n = 0; n < 2; ++n) _Pragma("unroll") for (int k = 0; k < 2; ++k) dst[n][k] = *(const LAS bf16x8*)(lds + G_SB(b, h) + boff + n * 2048 + k * 1024); } while (0)
#define G_MMA(ai, bj, At, Bt) do { __builtin_amdgcn_s_setprio(1); _Pragma("unroll") for (int m = 0; m < 4; ++m) _Pragma("unroll") for (int n = 0; n < 2; ++n) _Pragma("unroll") for (int k = 0; k < 2; ++k) \
        acc[ai][bj][m][n] = __builtin_amdgcn_mfma_f32_16x16x32_bf16(Bt[n][k], At[m][k], acc[ai][bj][m][n], 0, 0, 0); __builtin_amdgcn_s_setprio(0); } while (0)
#define G_WAIT_V(n) asm volatile("s_waitcnt vmcnt(" #n ")" ::: "memory")
#define G_WAIT_L(n) asm volatile("s_waitcnt lgkmcnt(" #n ")" ::: "memory")
#define G_BAR __builtin_amdgcn_s_barrier()
#define G_SCHED __builtin_amdgcn_sched_barrier(0)
    Unit cur, nxt; int ui = 0;
    if (!S.next(0, cur)) return;
    f32x4 acc[2][2][4][2];
#pragma unroll
    for (int a = 0; a < 2; ++a)
#pragma unroll
        for (int b = 0; b < 2; ++b)
#pragma unroll
            for (int m = 0; m < 4; ++m)
#pragma unroll
                for (int n = 0; n < 2; ++n) acc[a][b][m][n] = (f32x4){0.f, 0.f, 0.f, 0.f};
    bf16x8 At[4][2], B0[2][2], B1[2][2];
    const char* cA = cur.A; const char* cB0 = cur.B0; const char* cB1 = cur.B1;
    G_STAGE(G_SB(0, 0), cB0, voffB); G_STAGE(G_SA(0, 0), cA, voffA); G_STAGE(G_SB(0, 1), cB1, voffB); G_STAGE(G_SA(0, 1), cA + hstepA, voffA);
    if (wr == 1) G_BAR;
    G_WAIT_V(4); G_BAR;
    G_STAGE(G_SB(1, 0), cB0 + kstep, voffB); G_STAGE(G_SA(1, 0), cA + kstep, voffA); G_STAGE(G_SB(1, 1), cB1 + kstep, voffB);
    G_WAIT_V(6); G_BAR;
    for (;;) {
        const bool has_next = S.next(ui + 1, nxt);
        const char* nA = has_next ? nxt.A : cA; const char* nB0 = has_next ? nxt.B0 : cB0; const char* nB1 = has_next ? nxt.B1 : cB1;
        for (int t = 0; t < nt; t += 2) {
            const bool last = (t == nt - 2);
            const char* a1 = cA + (size_t)(t + 1) * kstep;
            const char* a2 = last ? nA : cA + (size_t)(t + 2) * kstep;
            const char* b20 = last ? nB0 : cB0 + (size_t)(t + 2) * kstep;
            const char* b21 = last ? nB1 : cB1 + (size_t)(t + 2) * kstep;
            const char* a3 = a2 + kstep; const char* b30 = b20 + kstep; const char* b31 = b21 + kstep;
            if constexpr (Epi::NHOOK > 0) { if (t == Epi::HK1 || t == Epi::HK2) E.hook(acc, cur, t, wr, wc, fr, fq); }
            G_LDB(B0, 0, 0); G_SCHED; G_LDA(At, 0, 0); G_STAGE(G_SA(1, 1), a1 + hstepA, voffA);
            G_WAIT_L(8); G_BAR; G_WAIT_L(0); G_MMA(0, 0, At, B0); G_BAR; G_SCHED;
            G_LDB(B1, 0, 1); G_STAGE(G_SB(0, 0), b20, voffB);
            G_BAR; G_WAIT_L(0); G_MMA(0, 1, At, B1); G_BAR;
            G_LDA(At, 0, 1); G_STAGE(G_SA(0, 0), a2, voffA);
            G_BAR; G_WAIT_L(0); G_MMA(1, 0, At, B0); G_BAR; G_SCHED;
            G_STAGE(G_SB(0, 1), b21, voffB);
            G_WAIT_V(6); G_BAR; G_MMA(1, 1, At, B1); G_BAR;
            G_LDB(B0, 1, 0); G_SCHED; G_LDA(At, 1, 0); G_STAGE(G_SA(0, 1), a2 + hstepA, voffA);
            G_WAIT_L(8); G_BAR; G_WAIT_L(0); G_MMA(0, 0, At, B0); G_BAR; G_SCHED;
            G_LDB(B1, 1, 1); G_STAGE(G_SB(1, 0), b30, voffB);
            G_BAR; G_WAIT_L(0); G_MMA(0, 1, At, B1); G_BAR;
            G_LDA(At, 1, 1); G_STAGE(G_SA(1, 0), a3, voffA);
            G_BAR; G_WAIT_L(0); G_MMA(1, 0, At, B0); G_BAR; G_SCHED;
            G_STAGE(G_SB(1, 1), b31, voffB);
            G_WAIT_V(6); G_BAR; G_MMA(1, 1, At, B1); G_BAR;
        }
        E(acc, cur, wr, wc, fr, fq);
        if (!has_next) break;
#pragma unroll
        for (int a = 0; a < 2; ++a)
#pragma unroll
            for (int b = 0; b < 2; ++b)
#pragma unroll
                for (int m = 0; m < 4; ++m)
#pragma unroll
                    for (int n = 0; n < 2; ++n) acc[a][b][m][n] = (f32x4){0.f, 0.f, 0.f, 0.f};
        cur = nxt; cA = nA; cB0 = nB0; cB1 = nB1; ++ui;
    }
    G_WAIT_V(0);
    if (wr == 0) G_BAR;
    G_BAR;
#undef G_SA
#undef G_SB
#undef G_STAGE
#undef G_LDA
#undef G_LDB
#undef G_MMA
#undef G_WAIT_V
#undef G_WAIT_L
#undef G_BAR
#undef G_SCHED
}

constexpr size_t ROWB = (size_t)DM * 2;
struct SchedFfnUp {
    const char* A; const char* B; int G, c;
    DI bool next(int i, Unit& u) const { const int L = i * G + c; if (L >= 64 * 44) return false; int pm, pn; tile_decode(L, 64, 44, pm, pn);
        u.A = A + (size_t)pm * 256 * ROWB; u.B0 = B + (size_t)pn * 128 * ROWB; u.B1 = u.B0 + (size_t)DFF * ROWB; u.kind = 0; u.pm = pm; u.pn = pn; return true; }
};
struct SchedPlain {
    const char* A; const char* B; int nM, nN; size_t astep, bstep; int G, c;
    DI bool next(int i, Unit& u) const { const int L = i * G + c; if (L >= nM * nN) return false; int pm, pn;
        if (nN == 8 && G == 256 && (nM & 31) == 0) { const int x = c & 7, r = c >> 3; pm = 32 * i + 4 * x + (r >> 3); pn = r & 7; }
        else tile_decode(L, nM, nN, pm, pn);
        u.A = A + (size_t)pm * astep; u.B0 = B + (size_t)pn * bstep; u.B1 = u.B0 + (bstep >> 1); u.kind = 0; u.pm = pm; u.pn = pn; return true; }
};
struct SchedWin {
    const char* xb; const char* win; const char* wft; const char* xp; const char* xm; int G, c;
    DI bool next(int i, Unit& u) const {
        int L = i * G + c; int pm, pn;
        if (L < 2176) { tile_decode(L, 64, 34, pm, pn); u.A = xb + (size_t)pm * 256 * ROWB; u.pm = pm;
            if (pn < 8) { u.kind = 0; u.pn = pn; u.B0 = win + (size_t)(pn * 128) * ROWB; u.B1 = win + (size_t)(1024 + pn * 128) * ROWB; }
            else if (pn < 10) { u.kind = 1; u.pn = pn - 8; u.B0 = win + (size_t)(2560 + 256 * (pn - 8)) * ROWB; u.B1 = u.B0 + 128 * ROWB; }
            else { u.kind = 2; u.pn = pn - 10; u.B0 = win + (size_t)(3072 + 256 * (pn - 10)) * ROWB; u.B1 = u.B0 + 128 * ROWB; }
            return true; }
        L -= 2176;
        if (L < 128) { tile_decode(L, 4, 32, pm, pn); u.kind = 3; u.pm = pm; u.pn = pn; u.A = wft + (size_t)pm * 256 * ROWB;
            u.B0 = (pm < 2 ? xp : xm) + (size_t)pn * 256 * ROWB; u.B1 = u.B0 + 128 * ROWB; return true; }
        return false;
    }
};
struct SchedKV {
    const char* memb; const char* wkv; int c;
    DI bool next(int i, Unit& u) const {
        if (i > 0 || c >= 8) return false; int pm, pn; tile_decode(c & 3, 2, 2, pm, pn); u.pm = pm; u.pn = pn;
        if (c < 4) { u.kind = 4; u.A = memb + (size_t)pm * 256 * ROWB; u.B0 = wkv + (size_t)pn * 256 * ROWB; }
        else { u.kind = 5; u.A = wkv + (size_t)(512 + pm * 256) * ROWB; u.B0 = memb + (size_t)pn * 256 * ROWB; }
        u.B1 = u.B0 + 128 * ROWB; return true; }
};
struct SchedDft {
    const char* cm; const char* tt; int G, c;
    DI bool next(int i, Unit& u) const { const int L = i * G + c; if (L >= 128) return false; int pm, pn8; tile_decode(L, 16, 8, pm, pn8);
        const int b = pn8 >> 2, p = (pn8 >> 1) & 1, pn = pn8 & 1;
        u.A = cm + (size_t)p * CM_HALF + (size_t)pm * 256 * HSEQ * 2; u.B0 = tt + ((size_t)(p * 512 + pn * 256) * SEQ + (size_t)b * HSEQ) * 2; u.B1 = u.B0 + (size_t)128 * SEQ * 2;
        u.kind = p; u.pm = b * 32 + pm; u.pn = p * 2 + pn; return true; }
};

template <int ACT>
DI void store_tile_bf16(const f32x4 (&acc)[2][2][4][2], bf16_t* out, size_t ld, int row0, int col0, const float* colbias, const float* rowbias, float scale, float cbs = 1.0f) {
    f32x4 cb[2][2];
#pragma unroll
    for (int bj = 0; bj < 2; ++bj)
#pragma unroll
        for (int n = 0; n < 2; ++n) cb[bj][n] = colbias ? *(const f32x4*)(colbias + col0 + bj * HALF + 4 * n) * cbs : (f32x4){0.f, 0.f, 0.f, 0.f};
#pragma unroll
    for (int ai = 0; ai < 2; ++ai)
#pragma unroll
        for (int m = 0; m < 4; ++m) { const int row = row0 + ai * HALF + m * 16; const float rb = rowbias ? rowbias[row] : 0.f; bf16_t* rp = out + (size_t)row * ld + col0;
#pragma unroll
            for (int bj = 0; bj < 2; ++bj) { f32x4 v0 = (acc[ai][bj][m][0] + cb[bj][0] + rb) * scale, v1 = (acc[ai][bj][m][1] + cb[bj][1] + rb) * scale;
                if (ACT == 1) {
#pragma unroll
                    for (int j = 0; j < 4; ++j) { v0[j] = sigmoidf_fast(v0[j]); v1[j] = sigmoidf_fast(v1[j]); } }
                *(u32x4*)(rp + bj * HALF) = pack8(v0, v1); } }
}
struct EpiSwiGLU {
    static constexpr bool PERM = true; static constexpr int NHOOK = 0; bf16_t* H;
    DI void operator()(const f32x4 (&acc)[2][2][4][2], const Unit& u, int wr, int wc, int fr, int fq) const {
        const int row0 = u.pm * 256 + wr * 64 + fr, col0 = u.pn * 128 + wc * 32 + 8 * fq;
#pragma unroll
        for (int ai = 0; ai < 2; ++ai)
#pragma unroll
            for (int m = 0; m < 4; ++m) { f32x4 v[2];
#pragma unroll
                for (int n = 0; n < 2; ++n) { const f32x4 a = acc[ai][0][m][n], g = acc[ai][1][m][n];
#pragma unroll
                    for (int j = 0; j < 4; ++j) v[n][j] = a[j] * g[j] * sigmoidf_fast(g[j]); }
                *(u32x4*)(H + (size_t)(row0 + ai * HALF + m * 16) * DFF + col0) = pack8(v[0], v[1]); }
    }
};
template <bool LNSRC, int BETA2> struct EpiResid {
    static constexpr bool PERM = false; static constexpr int NHOOK = 0; static constexpr float alpha = DN_ALPHA, beta = 0.5f * BETA2; const float* src; float* dst; const float* stats; const float* lng; const float* lnb;
    DI void operator()(const f32x4 (&acc)[2][2][4][2], const Unit& u, int wr, int wc, int fr, int fq) const {
        const int row0 = u.pm * 256 + wr * 64 + fr, col0 = u.pn * 256 + wc * 32 + 4 * fq;
        if constexpr (LNSRC) {
            const f32x4 g00 = *(const f32x4*)(lng + col0) * alpha, g01 = *(const f32x4*)(lng + col0 + 16) * alpha, g10 = *(const f32x4*)(lng + col0 + HALF) * alpha, g11 = *(const f32x4*)(lng + col0 + HALF + 16) * alpha;
            const f32x4 b00 = *(const f32x4*)(lnb + col0) * alpha, b01 = *(const f32x4*)(lnb + col0 + 16) * alpha, b10 = *(const f32x4*)(lnb + col0 + HALF) * alpha, b11 = *(const f32x4*)(lnb + col0 + HALF + 16) * alpha;
#pragma unroll
            for (int ai = 0; ai < 2; ++ai)
#pragma unroll
                for (int mp = 0; mp < 2; ++mp) { f32x4 sv[2][4]; float mean[2], rstd[2];
#pragma unroll
                    for (int mm = 0; mm < 2; ++mm) { const int row = row0 + ai * HALF + (2 * mp + mm) * 16; const size_t off = (size_t)row * DM + col0;
                        mean[mm] = stats[2 * row]; rstd[mm] = stats[2 * row + 1];
                        sv[mm][0] = *(const f32x4*)(src + off); sv[mm][1] = *(const f32x4*)(src + off + 16); sv[mm][2] = *(const f32x4*)(src + off + HALF); sv[mm][3] = *(const f32x4*)(src + off + HALF + 16); }
#pragma unroll
                    for (int mm = 0; mm < 2; ++mm) { const int m = 2 * mp + mm; const size_t off = (size_t)(row0 + ai * HALF + m * 16) * DM + col0;
                        *(f32x4*)(dst + off) = (sv[mm][0] - mean[mm]) * rstd[mm] * g00 + b00 + acc[ai][0][m][0] * beta;
                        *(f32x4*)(dst + off + 16) = (sv[mm][1] - mean[mm]) * rstd[mm] * g01 + b01 + acc[ai][0][m][1] * beta;
                        *(f32x4*)(dst + off + HALF) = (sv[mm][2] - mean[mm]) * rstd[mm] * g10 + b10 + acc[ai][1][m][0] * beta;
                        *(f32x4*)(dst + off + HALF + 16) = (sv[mm][3] - mean[mm]) * rstd[mm] * g11 + b11 + acc[ai][1][m][1] * beta; }
                    asm volatile("" ::: "memory"); }
        } else {
#pragma unroll
            for (int ai = 0; ai < 2; ++ai)
#pragma unroll
                for (int m = 0; m < 4; ++m) { const size_t off = (size_t)(row0 + ai * HALF + m * 16) * DM + col0;
#pragma unroll
                    for (int bj = 0; bj < 2; ++bj)
#pragma unroll
                        for (int n = 0; n < 2; ++n) { const f32x4 sv = *(const f32x4*)(src + off + bj * HALF + n * 16); *(f32x4*)(dst + off + bj * HALF + n * 16) = sv * alpha + acc[ai][bj][m][n] * beta; }
                    asm volatile("" ::: "memory"); }
        }
    }
};
struct EpiWin {
    static constexpr bool PERM = true; static constexpr int NHOOK = 0;
    const float* bin; const float* biasT; bf16_t *GLU, *Q, *Gt, *TT;
    DI void operator()(const f32x4 (&acc)[2][2][4][2], const Unit& u, int wr, int wc, int fr, int fq) const {
        const int row0 = u.pm * 256 + wr * 64 + fr, cin = wc * 32 + 8 * fq;
        if (u.kind == 0) {
            const int col0 = u.pn * 128 + cin; f32x4 bv[2], bg[2];
#pragma unroll
            for (int n = 0; n < 2; ++n) { bv[n] = *(const f32x4*)(bin + col0 + 4 * n); bg[n] = *(const f32x4*)(bin + 1024 + col0 + 4 * n); }
#pragma unroll
            for (int ai = 0; ai < 2; ++ai)
#pragma unroll
                for (int m = 0; m < 4; ++m) { f32x4 v[2];
#pragma unroll
                    for (int n = 0; n < 2; ++n) { const f32x4 a = acc[ai][0][m][n] + bv[n], g = acc[ai][1][m][n] + bg[n];
#pragma unroll
                        for (int j = 0; j < 4; ++j) v[n][j] = a[j] * sigmoidf_fast(g[j]); }
                    *(u32x4*)(GLU + (size_t)(row0 + ai * HALF + m * 16) * 1024 + col0) = pack8(v[0], v[1]); }
        } else if (u.kind == 1) store_tile_bf16<0>(acc, Q, 512, row0, u.pn * 256 + cin, bin + 2560, nullptr, 0.08838834764831845f);
        else if (u.kind == 2) store_tile_bf16<1>(acc, Gt, 6144, row0, u.pn * 256 + cin, bin + 3072, nullptr, 1.0f);
        else {
            const bool cosr = u.pm < 2; const int col0 = u.pn * 256 + cin;
#pragma unroll
            for (int ai = 0; ai < 2; ++ai)
#pragma unroll
                for (int m = 0; m < 4; ++m) { const int row = row0 + ai * HALF + m * 16; const float rb = cosr ? biasT[row] : 0.f;
#pragma unroll
                    for (int bj = 0; bj < 2; ++bj) { f32x4 v0 = acc[ai][bj][m][0] + 2.0f * rb, v1 = acc[ai][bj][m][1] + 2.0f * rb;
                        if (((col0 + bj * HALF) & (HSEQ - 1)) == 0) v0[0] -= rb;
                        *(u32x4*)(TT + (size_t)row * SEQ + col0 + bj * HALF) = pack8(v0, v1); } }
        }
    }
};
struct EpiKV {
    static constexpr bool PERM = true; static constexpr int NHOOK = 0; bf16_t *KK, *VT;
    DI void operator()(const f32x4 (&acc)[2][2][4][2], const Unit& u, int wr, int wc, int fr, int fq) const {
        store_tile_bf16<0>(acc, u.kind == 4 ? KK : VT, 512, u.pm * 256 + wr * 64 + fr, u.pn * 256 + wc * 32 + 8 * fq, nullptr, nullptr, 1.0f);
    }
};
struct EpiDft {
    static constexpr bool PERM = true; static constexpr int NHOOK = 0; bf16_t* out; const float* uh;
    DI void operator()(const f32x4 (&acc)[2][2][4][2], const Unit& u, int wr, int wc, int fr, int fq) const {
        const int b = u.pm >> 5, k0 = (u.pm & 31) * 256 + wr * 64 + fr, col0 = u.pn * 256 + wc * 32 + 8 * fq;
        const float sgn = (fr & 1) ? -1.0f : 1.0f; const unsigned flip = u.kind ? 0x80008000u : 0u;
        f32x4 cb[2][2];
#pragma unroll
        for (int bj = 0; bj < 2; ++bj)
#pragma unroll
            for (int n = 0; n < 2; ++n) cb[bj][n] = (u.kind == 0) ? *(const f32x4*)(uh + b * 512 + col0 + bj * HALF + 4 * n) * sgn : (f32x4){0.f, 0.f, 0.f, 0.f};
#pragma unroll
        for (int ai = 0; ai < 2; ++ai)
#pragma unroll
            for (int m = 0; m < 4; ++m) { const int k = k0 + ai * HALF + m * 16;
                bf16_t* rp = out + (size_t)(b * SEQ + k) * KBR + col0; bf16_t* rq = out + (size_t)(b * SEQ + SEQ - k) * KBR + col0;
#pragma unroll
                for (int bj = 0; bj < 2; ++bj) { u32x4 w = pack8(acc[ai][bj][m][0] + cb[bj][0], acc[ai][bj][m][1] + cb[bj][1]);
                    *(u32x4*)(rp + bj * HALF) = w;
                    if (k != 0) { w.x ^= flip; w.y ^= flip; w.z ^= flip; w.w ^= flip; *(u32x4*)(rq + bj * HALF) = w; } } }
    }
};
struct EpiPlainBf16 {
    static constexpr bool PERM = true; static constexpr int NHOOK = 0; bf16_t* out; int ld;
    DI void operator()(const f32x4 (&acc)[2][2][4][2], const Unit& u, int wr, int wc, int fr, int fq) const {
        store_tile_bf16<0>(acc, out, (size_t)ld, u.pm * 256 + wr * 64 + fr, u.pn * 256 + wc * 32 + 8 * fq, nullptr, nullptr, 1.0f);
    }
};
struct EpiBranchFused {
    static constexpr bool PERM = true; static constexpr int NHOOK = 2, HK1 = 16, HK2 = 32; const bf16_t* Gt; bf16_t* MG;
    DI void hook(f32x4 (&acc)[2][2][4][2], const Unit& u, int t, int wr, int wc, int fr, int fq) const {
        const int sgm = (t == HK1) ? 0 : 1;
        asm volatile("" : "+v"(fr), "+v"(fq));
        const int row0 = u.pm * 256 + wr * 64 + fr, col0 = u.pn * 256 + wc * 32 + 8 * fq;
#pragma unroll
        for (int ai = 0; ai < 2; ++ai) {
            u32x4 ga[4][2], gb[4][2];
#pragma unroll
            for (int m = 0; m < 4; ++m) { const bf16_t* gp = Gt + (size_t)(row0 + ai * HALF + m * 16) * 6144 + sgm * DM + col0;
#pragma unroll
                for (int bj = 0; bj < 2; ++bj) { ga[m][bj] = *(const u32x4*)(gp + bj * HALF); gb[m][bj] = *(const u32x4*)(gp + DM + bj * HALF); } }
#pragma unroll
            for (int m = 0; m < 4; ++m)
#pragma unroll
                for (int bj = 0; bj < 2; ++bj) { f32x4 a0, a1, b0, b1; unpack8(ga[m][bj], a0, a1); unpack8(gb[m][bj], b0, b1);
#pragma unroll
                    for (int j = 0; j < 4; ++j) { acc[ai][bj][m][0][j] *= a0[j] * __builtin_amdgcn_rcpf(b0[j]); acc[ai][bj][m][1][j] *= a1[j] * __builtin_amdgcn_rcpf(b1[j]); } }
            asm volatile("" ::: "memory");
        }
    }
    DI void operator()(const f32x4 (&acc)[2][2][4][2], const Unit& u, int wr, int wc, int fr, int fq) const {
        const int row0 = u.pm * 256 + wr * 64 + fr, col0 = u.pn * 256 + wc * 32 + 8 * fq;
#pragma unroll
        for (int ai = 0; ai < 2; ++ai) {
            u32x4 gg[4][2];
#pragma unroll
            for (int m = 0; m < 4; ++m)
#pragma unroll
                for (int bj = 0; bj < 2; ++bj) gg[m][bj] = *(const u32x4*)(Gt + (size_t)(row0 + ai * HALF + m * 16) * 6144 + 2 * DM + col0 + bj * HALF);
#pragma unroll
            for (int m = 0; m < 4; ++m)
#pragma unroll
                for (int bj = 0; bj < 2; ++bj) { f32x4 g0, g1; unpack8(gg[m][bj], g0, g1);
                    *(u32x4*)(MG + (size_t)(row0 + ai * HALF + m * 16) * DM + col0 + bj * HALF) = pack8(g0 * acc[ai][bj][m][0], g1 * acc[ai][bj][m][1]); }
            asm volatile("" ::: "memory");
        }
    }
};

DI void transpose_item(const float* W, int N, bf16_t* WT, int ldo, int row_off, int koff, LAS float* scr, int item, int lane) {
    const int nblk = N / 32, kb = item / nblk, nb = item % nblk, k0 = 64 * kb, n0 = 32 * nb;
    f32x4 v[8];
    { const float* wp = W + (size_t)(k0 + (lane >> 3)) * N + n0 + 4 * (lane & 7);
#pragma unroll
      for (int i = 0; i < 8; ++i) v[i] = *(const f32x4*)(wp + (size_t)(8 * i) * N); }
#pragma unroll
    for (int i = 0; i < 8; ++i) { LAS float* d = scr + (8 * i + (lane >> 3)) * 33 + 4 * (lane & 7); d[0] = v[i][0]; d[1] = v[i][1]; d[2] = v[i][2]; d[3] = v[i][3]; }
    asm volatile("s_waitcnt lgkmcnt(0)" ::: "memory");
    const int c = lane & 7;
#pragma unroll
    for (int j = 0; j < 4; ++j) { const int n = (lane >> 3) + 8 * j; const LAS float* s = scr + (8 * c) * 33 + n;
        u32x4 o; o.x = pk2(s[0 * 33], s[1 * 33]); o.y = pk2(s[2 * 33], s[3 * 33]); o.z = pk2(s[4 * 33], s[5 * 33]); o.w = pk2(s[6 * 33], s[7 * 33]);
        *(u32x4*)(WT + (size_t)(row_off + n0 + n) * ldo + koff + k0 + 8 * c) = o; }
    asm volatile("s_waitcnt lgkmcnt(0)" ::: "memory");
}

struct Params { const float* in[23]; float* out; unsigned char* ws; int ph_lo, ph_hi; };

DI void convert_weights(const Params& P, int l, LAS unsigned char* lds) {
    const int tid = ltid(), lane = tid & 63, wid = tid >> 6;
    unsigned char* ws = P.ws;
    LAS float* scr = (LAS float*)(lds + wid * 8448);
    const int gw = blockIdx.x * 8 + wid, NGW = gridDim.x * 8;
    constexpr int I13 = 32 * 352, I2 = 88 * 64, IIN = 32 * 288, ICO = 16 * 64, IF = 8 * 64, IKV = 32 * 32, IO = 8 * 64, IOUT = 32 * 64;
    constexpr int NITEMS = 2 * I13 + 2 * I2 + IIN + ICO + 2 * IF + IKV + IO + IOUT;
    const float* w13a = P.in[2] + (size_t)l * DM * 2 * DFF; const float* w2a = P.in[3] + (size_t)l * DFF * DM;
    const float* win = P.in[6] + (size_t)l * DM * DIN; const float* wco = P.in[12] + (size_t)l * 1024 * DM; const float* wf = P.in[13] + (size_t)l * 512 * DM;
    const float* wkv = P.in[14] + (size_t)l * DM * 1024; const float* wo = P.in[15] + (size_t)l * 512 * DM; const float* wout = P.in[16] + (size_t)l * DM * DM;
    const float* w13b = P.in[19] + (size_t)l * DM * 2 * DFF; const float* w2b = P.in[20] + (size_t)l * DFF * DM;
    for (int it = gw; it < NITEMS; it += NGW) {
        int r = it;
        if (r < I13) { transpose_item(w13a, 2 * DFF, (bf16_t*)(ws + WS_W13A), DM, 0, 0, scr, r, lane); continue; } r -= I13;
        if (r < I13) { transpose_item(w13b, 2 * DFF, (bf16_t*)(ws + WS_W13B), DM, 0, 0, scr, r, lane); continue; } r -= I13;
        if (r < I2) { transpose_item(w2a, DM, (bf16_t*)(ws + WS_W2A), DFF, 0, 0, scr, r, lane); continue; } r -= I2;
        if (r < I2) { transpose_item(w2b, DM, (bf16_t*)(ws + WS_W2B), DFF, 0, 0, scr, r, lane); continue; } r -= I2;
        if (r < IIN) { transpose_item(win, DIN, (bf16_t*)(ws + WS_WIN), DM, 0, 0, scr, r, lane); continue; } r -= IIN;
        if (r < ICO) { transpose_item(wco, DM, (bf16_t*)(ws + WS_WBR), KBR, 0, 0, scr, r, lane); continue; } r -= ICO;
        if (r < IF) { transpose_item(wf, DM, (bf16_t*)(ws + WS_WBR), KBR, 0, 1024, scr, r, lane); continue; } r -= IF;
        if (r < IF) { transpose_item(wf, DM, (bf16_t*)(ws + WS_WBR), KBR, 0, 1536, scr, r, lane); continue; } r -= IF;
        if (r < IKV) { transpose_item(wkv, 1024, (bf16_t*)(ws + WS_WKV), DM, 0, 0, scr, r, lane); continue; } r -= IKV;
        if (r < IO) { transpose_item(wo, DM, (bf16_t*)(ws + WS_WBR), KBR, 0, 2048, scr, r, lane); continue; } r -= IO;
        transpose_item(wout, DM, (bf16_t*)(ws + WS_WOUT), DM, 0, 0, scr, r, lane);
    }
    __syncthreads();
    {
        LAS float* tile = (LAS float*)lds;
        LAS float* tabc = tile + 32 * 129; LAS float* tabs = tabc + 128;
        const float* bin = P.in[7] + (size_t)l * DIN;
        bf16_t* WFT = (bf16_t*)(ws + WS_WFT); float* biasT = (float*)(ws + WS_BIAST);
        if (tid < 128) { float sn, cs; sincospif((float)tid * (1.0f / 64.0f), &sn, &cs); tabc[tid] = cs * 0.08838834764831845f; tabs[tid] = sn * 0.08838834764831845f; }
        for (int item = blockIdx.x; item < 256; item += gridDim.x) {
            const int kb = item >> 2, g = item & 3;
            __syncthreads();
            for (int idx = tid; idx < 32 * 128; idx += 512) { const int kk = idx >> 7, j = idx & 127; tile[kk * 129 + j] = win[(size_t)(kb * 32 + kk) * DIN + 2048 + g * 128 + j]; }
            __syncthreads();
            const int k = tid & 31, ccb = (tid >> 5) * 8;
            float ac[8], as[8];
#pragma unroll
            for (int c8 = 0; c8 < 8; ++c8) { ac[c8] = 0.f; as[c8] = 0.f; }
            for (int j = 0; j < 128; ++j) { const float w = tile[k * 129 + j];
#pragma unroll
                for (int c8 = 0; c8 < 8; ++c8) { const int idx = (j * (ccb + c8)) & 127; ac[c8] += w * tabc[idx]; as[c8] += w * tabs[idx]; } }
#pragma unroll
            for (int c8 = 0; c8 < 8; ++c8) { WFT[(size_t)(g * 128 + ccb + c8) * DM + kb * 32 + k] = f2bf(ac[c8]); WFT[(size_t)(512 + g * 128 + ccb + c8) * DM + kb * 32 + k] = f2bf(as[c8]); }
            if (kb == 0 && tid < 128) { float bc = 0.f, bs = 0.f;
                for (int j = 0; j < 128; ++j) { const float w = bin[2048 + g * 128 + j]; const int idx = (j * tid) & 127; bc += w * tabc[idx]; bs += w * tabs[idx]; }
                biasT[g * 128 + tid] = bc; biasT[512 + g * 128 + tid] = bs; }
        }
        __syncthreads();
    }
}

DI void setup_phase(const Params& P, LAS unsigned char* lds) {
    const int tid = ltid(); unsigned char* ws = P.ws;
    const size_t gt = (size_t)blockIdx.x * 512 + tid, ngt = (size_t)gridDim.x * 512;
    { const f32x4* src = (const f32x4*)P.in[0]; u32x4* dst = (u32x4*)(ws + WS_XB);
      for (size_t i = gt; i < (size_t)NTOK * DM / 8; i += ngt) dst[i] = pack8(src[2 * i], src[2 * i + 1]); }
    { const f32x4* src = (const f32x4*)P.in[1]; u32x4* dst = (u32x4*)(ws + WS_MEMB);
      for (size_t i = gt; i < (size_t)512 * DM / 8; i += ngt) dst[i] = pack8(src[2 * i], src[2 * i + 1]); }
    bf16_t* cm0 = (bf16_t*)(ws + WS_CM); bf16_t* cm1 = (bf16_t*)(ws + WS_CM + CM_HALF);
    for (int j = blockIdx.x; j < HSEQ; j += gridDim.x) {
        f32x4 c0, c1, s0, s1;
#pragma unroll
        for (int e = 0; e < 8; ++e) { const float x = (float)((j * (tid * 8 + e)) & (SEQ - 1)) * (1.0f / 8192.0f);
            const float cv = __builtin_amdgcn_cosf(x) * 0.011048543456039806f, sv = __builtin_amdgcn_sinf(x) * -0.011048543456039806f;
            if (e < 4) { c0[e] = cv; s0[e] = sv; } else { c1[e - 4] = cv; s1[e - 4] = sv; } }
        *(u32x4*)(cm0 + (size_t)j * HSEQ + tid * 8) = pack8(c0, c1); *(u32x4*)(cm1 + (size_t)j * HSEQ + tid * 8) = pack8(s0, s1);
    }
}

DI void ln_phase(float* X, bf16_t* XB, float* stats, const float* g, const float* bta, bool final_out) {
    const int tid = ltid(), lane = tid & 63, gw = blockIdx.x * 8 + (tid >> 6), ngw = gridDim.x * 8;
    f32x4 gv[8], bv[8];
#pragma unroll
    for (int j = 0; j < 8; ++j) { gv[j] = ((const f32x4*)g)[64 * j + lane]; bv[j] = ((const f32x4*)bta)[64 * j + lane]; }
    f32x4 na[8], nb[8];
    { const f32x4* xa = (const f32x4*)(X + (size_t)gw * DM) + lane; const f32x4* xq = (const f32x4*)(X + (size_t)(gw + ngw) * DM) + lane;
#pragma unroll
      for (int j = 0; j < 8; ++j) { na[j] = xa[64 * j]; nb[j] = xq[64 * j]; } }
    for (int row = gw; row < NTOK; row += 2 * ngw) {
        const int rowb = row + ngw;
        f32x4 va[8], vb[8];
#pragma unroll
        for (int j = 0; j < 8; ++j) { va[j] = na[j]; vb[j] = nb[j]; }
        if (row + 2 * ngw < NTOK) { const f32x4* xa = (const f32x4*)(X + (size_t)(row + 2 * ngw) * DM) + lane; const f32x4* xq = (const f32x4*)(X + (size_t)(row + 3 * ngw) * DM) + lane;
#pragma unroll
            for (int j = 0; j < 8; ++j) { na[j] = xa[64 * j]; nb[j] = xq[64 * j]; } }
        float sa = 0.f, sb = 0.f;
#pragma unroll
        for (int j = 0; j < 8; ++j) { sa += (va[j][0] + va[j][1]) + (va[j][2] + va[j][3]); sb += (vb[j][0] + vb[j][1]) + (vb[j][2] + vb[j][3]); }
        sa += shx<1>(sa); sb += shx<1>(sb); sa += shx<2>(sa); sb += shx<2>(sb); sa += shx<4>(sa); sb += shx<4>(sb);
        sa += shx<8>(sa); sb += shx<8>(sb); sa += shx<16>(sa); sb += shx<16>(sb); sa += shx<32>(sa); sb += shx<32>(sb);
        const float ma = sa * (1.0f / DM), mb = sb * (1.0f / DM); float qa = 0.f, qb = 0.f;
#pragma unroll
        for (int j = 0; j < 8; ++j) { va[j] = va[j] - ma; vb[j] = vb[j] - mb;
            qa += (va[j][0] * va[j][0] + va[j][1] * va[j][1]) + (va[j][2] * va[j][2] + va[j][3] * va[j][3]); qb += (vb[j][0] * vb[j][0] + vb[j][1] * vb[j][1]) + (vb[j][2] * vb[j][2] + vb[j][3] * vb[j][3]); }
        qa += shx<1>(qa); qb += shx<1>(qb); qa += shx<2>(qa); qb += shx<2>(qb); qa += shx<4>(qa); qb += shx<4>(qb);
        qa += shx<8>(qa); qb += shx<8>(qb); qa += shx<16>(qa); qb += shx<16>(qb); qa += shx<32>(qa); qb += shx<32>(qb);
        const float ra = 1.0f / sqrtf(qa * (1.0f / DM) + LN_EPS), rb = 1.0f / sqrtf(qb * (1.0f / DM) + LN_EPS);
        if (final_out) {
            f32x4* xa = (f32x4*)(X + (size_t)row * DM) + lane; f32x4* xq = (f32x4*)(X + (size_t)rowb * DM) + lane;
#pragma unroll
            for (int j = 0; j < 8; ++j) { xa[64 * j] = va[j] * ra * gv[j] + bv[j]; xq[64 * j] = vb[j] * rb * gv[j] + bv[j]; }
        } else {
            if (lane == 0) { f32x2 st = {ma, ra}; *(f32x2*)(stats + 2 * row) = st; st[0] = mb; st[1] = rb; *(f32x2*)(stats + 2 * rowb) = st; }
            u32x2* oa = (u32x2*)(XB + (size_t)row * DM) + lane; u32x2* ob = (u32x2*)(XB + (size_t)rowb * DM) + lane;
#pragma unroll
            for (int j = 0; j < 8; ++j) { const f32x4 ya = va[j] * ra * gv[j] + bv[j], yb = vb[j] * rb * gv[j] + bv[j]; u32x2 w; w.x = pk2(ya[0], ya[1]); w.y = pk2(ya[2], ya[3]); oa[64 * j] = w; w.x = pk2(yb[0], yb[1]); w.y = pk2(yb[2], yb[3]); ob[64 * j] = w; }
        }
    }
}

DI void ln_row(f32x4 (&v)[8], const f32x4 (&gv)[8], const f32x4 (&bv)[8], float* stats, int row, bf16_t* XB, int lane) {
    float s = 0.f;
#pragma unroll
    for (int j = 0; j < 8; ++j) s += (v[j][0] + v[j][1]) + (v[j][2] + v[j][3]);
    const float mean = wave_sum(s) * (1.0f / DM); float s2 = 0.f;
#pragma unroll
    for (int j = 0; j < 8; ++j) { v[j] = v[j] - mean; s2 += (v[j][0] * v[j][0] + v[j][1] * v[j][1]) + (v[j][2] * v[j][2] + v[j][3] * v[j][3]); }
    const float rstd = 1.0f / sqrtf(wave_sum(s2) * (1.0f / DM) + LN_EPS);
    if (lane == 0) { f32x2 st = {mean, rstd}; *(f32x2*)(stats + 2 * row) = st; }
    u32x2* ob = (u32x2*)(XB + (size_t)row * DM) + lane;
#pragma unroll
    for (int j = 0; j < 8; ++j) { v[j] = v[j] * rstd * gv[j] + bv[j]; u32x2 w; w.x = pk2(v[j][0], v[j][1]); w.y = pk2(v[j][2], v[j][3]); ob[64 * j] = w; }
}
DI void ln_fold_phase(const float* X, bf16_t* XB, bf16_t* XP, bf16_t* XM, float* stats, const float* g, const float* bta, int vb) {
    const int tid = ltid(), lane = tid & 63, wv = (vb - 8) * 8 + (tid >> 6), nwv = ((int)gridDim.x - 8) * 8;
    f32x4 gv[8], bv[8];
#pragma unroll
    for (int j = 0; j < 8; ++j) { gv[j] = ((const f32x4*)g)[64 * j + lane]; bv[j] = ((const f32x4*)bta)[64 * j + lane]; }
    for (int it = wv; it < 2 * (HSEQ + 1); it += nwv) {
        const int b = it / (HSEQ + 1), i = it - b * (HSEQ + 1);
        const bool pair = (i != 0) && (i != HSEQ);
        const int rowA = b * SEQ + i, rowB = b * SEQ + (SEQ - i);
        f32x4 va[8], vb[8];
        { const f32x4* xa = (const f32x4*)(X + (size_t)rowA * DM) + lane;
#pragma unroll
          for (int j = 0; j < 8; ++j) va[j] = xa[64 * j]; }
        if (pair) { const f32x4* xq = (const f32x4*)(X + (size_t)rowB * DM) + lane;
#pragma unroll
            for (int j = 0; j < 8; ++j) vb[j] = xq[64 * j]; }
        else {
#pragma unroll
            for (int j = 0; j < 8; ++j) vb[j] = (f32x4){0.f, 0.f, 0.f, 0.f}; }
        ln_row(va, gv, bv, stats, rowA, XB, lane);
        if (pair) ln_row(vb, gv, bv, stats, rowB, XB, lane);
        if (i != HSEQ) {
            u32x2* op = (u32x2*)(XP + (size_t)(b * HSEQ + i) * DM) + lane; u32x2* om = (u32x2*)(XM + (size_t)(b * HSEQ + i) * DM) + lane;
#pragma unroll
            for (int j = 0; j < 8; ++j) { f32x4 p = va[j], m = {0.f, 0.f, 0.f, 0.f}; if (pair) { p = va[j] + vb[j]; m = va[j] - vb[j]; }
                u32x2 w; w.x = pk2(p[0], p[1]); w.y = pk2(p[2], p[3]); op[64 * j] = w; w.x = pk2(m[0], m[1]); w.y = pk2(m[2], m[3]); om[64 * j] = w; }
        }
    }
}

constexpr int CT = 16, CROWS = CT + 30;
DI void conv_tile(const bf16_t* GLU, bf16_t* CV, const float* cw, const float* cb, const float* lg, const float* lb, int tile, LAS unsigned char* lds) {
    const int tid = ltid(), lane = tid & 63, wid = __builtin_amdgcn_readfirstlane(tid >> 6);
    const int tok0 = tile * CT, b = tok0 >> 13, s0 = tok0 & (SEQ - 1);
    LAS unsigned char* ldst = lds + tid * 4;
    asm volatile("" : "+v"(ldst));
    asm volatile("" : "+s"(GLU), "+s"(CV), "+s"(cw), "+s"(cb), "+s"(lg), "+s"(lb));
    constexpr int NLD = (CROWS * 128 + 511) / 512;
    u32x4 rv[NLD];
#pragma unroll
    for (int i = 0; i < NLD; ++i) { const int idx = i * 512 + tid, rr = idx >> 7, c16 = idx & 127, s = s0 - 15 + rr; rv[i] = (u32x4){0u, 0u, 0u, 0u};
        if (idx < CROWS * 128 && s >= 0 && s < SEQ) rv[i] = *(const u32x4*)(GLU + ((size_t)(b * SEQ + s)) * 1024 + c16 * 8); }
    float w0[31], w1[31];
#pragma unroll
    for (int j = 0; j < 31; ++j) { const f32x2 w = *(const f32x2*)(cw + j * 1024 + 2 * tid); w0[j] = w[0]; w1[j] = w[1]; }
    __syncthreads();
#pragma unroll
    for (int i = 0; i < NLD; ++i) { const int idx = i * 512 + tid, rr = idx >> 7, c16 = idx & 127; if (idx < CROWS * 128) *(LAS u32x4*)(lds + rr * 2048 + c16 * 16) = rv[i]; }
    __syncthreads();
    float a0[CT], a1[CT];
#pragma unroll
    for (int t = 0; t < CT; ++t) { a0[t] = 0.f; a1[t] = 0.f; }
    unsigned vq[4];
#pragma unroll
    for (int q = 0; q < 4; ++q) vq[q] = *(const LAS unsigned*)(ldst + q * 2048);
#pragma unroll
    for (int rr = 0; rr < CROWS; ++rr) { const unsigned v = vq[rr & 3]; if (rr + 4 < CROWS) vq[rr & 3] = *(const LAS unsigned*)(ldst + (rr + 4) * 2048);
        if ((rr & 3) == 3) asm volatile("" ::: "memory");
        const float x0 = __uint_as_float(v << 16), x1 = __uint_as_float(v & 0xffff0000u);
#pragma unroll
        for (int t = 0; t < CT; ++t) { const int j = rr - t; if (j >= 0 && j <= 30) { a0[t] += x0 * w0[j]; a1[t] += x1 * w1[j]; } } }
    const f32x2 cbv = *(const f32x2*)(cb + 2 * tid);
    __syncthreads();
    { LAS float* yw = (LAS float*)lds + 2 * tid;
      asm volatile("" : "+v"(yw));
#pragma unroll
      for (int t = 0; t < CT; ++t) { f32x2 y = {a0[t] + cbv[0], a1[t] + cbv[1]}; *(LAS f32x2*)(yw + t * 1024) = y; } }
    __syncthreads();
    {
        f32x4 gv[4], bv[4];
#pragma unroll
        for (int i = 0; i < 4; ++i) { gv[i] = *(const f32x4*)(lg + 4 * lane + 256 * i); bv[i] = *(const f32x4*)(lb + 4 * lane + 256 * i); }
#pragma unroll
        for (int tt = 0; tt < 2; ++tt) { const int t = 2 * wid + tt; const LAS float* yr = (const LAS float*)lds + t * 1024 + 4 * lane;
            f32x4 v[4]; float s = 0.f;
#pragma unroll
            for (int i = 0; i < 4; ++i) { v[i] = *(const LAS f32x4*)(yr + 256 * i); s += (v[i][0] + v[i][1]) + (v[i][2] + v[i][3]); }
            const float mean = wave_sum(s) * (1.0f / 1024.0f); float s2 = 0.f;
#pragma unroll
            for (int i = 0; i < 4; ++i) { v[i] = v[i] - mean; s2 += (v[i][0] * v[i][0] + v[i][1] * v[i][1]) + (v[i][2] * v[i][2] + v[i][3] * v[i][3]); }
            const float rstd = 1.0f / sqrtf(wave_sum(s2) * (1.0f / 1024.0f) + LN_EPS);
            bf16_t* op = CV + (size_t)(tok0 + t) * KBR + 4 * lane;
#pragma unroll
            for (int i = 0; i < 4; ++i) { f32x4 y = v[i] * rstd * gv[i] + bv[i];
#pragma unroll
                for (int j = 0; j < 4; ++j) y[j] *= sigmoidf_fast(y[j]);
                u32x2 w; w.x = pk2(y[0], y[1]); w.y = pk2(y[2], y[3]); *(u32x2*)(op + 256 * i) = w; } }
    }
}

DI void attn_unit(const bf16_t* Q, const bf16_t* KK, const bf16_t* VT, bf16_t* OO, int b, int h, int qt, LAS unsigned char* lds, bool stage) {
    const int tid = ltid(), lane = tid & 63, wid = __builtin_amdgcn_readfirstlane(tid >> 6), r = lane & 31, h2 = lane >> 5;
    const int tok0 = b * SEQ + qt * 256 + wid * 32;
    asm volatile("" : "+s"(Q), "+s"(KK), "+s"(VT), "+s"(OO));
    LAS unsigned char* ldsK = lds; LAS unsigned char* ldsV = lds + 65536;
    if (stage) {
    __syncthreads();
#pragma unroll
    for (int i = 0; i < 8; ++i) { const int id = i * 512 + tid, row = id >> 4, ch = id & 15;
        const u32x4 v = *(const u32x4*)(KK + (size_t)(b * 256 + row) * 512 + h * 128 + ch * 8);
        *(LAS u32x4*)(ldsK + row * 256 + ((ch ^ (row & 15)) << 4)) = v; }
#pragma unroll
    for (int i = 0; i < 8; ++i) { const int id = i * 512 + tid, row = id >> 5, ch = id & 31;
        const u32x4 v = *(const u32x4*)(VT + (size_t)(h * 128 + row) * 512 + b * 256 + ch * 8);
        *(LAS u32x4*)(ldsV + row * 512 + ((ch ^ (row & 31)) << 4)) = v; }
    }
    bf16x8 qf[8];
    { const bf16_t* qp = Q + (size_t)(tok0 + r) * 512 + h * 128 + 8 * h2;
#pragma unroll
      for (int s = 0; s < 8; ++s) qf[s] = *(const bf16x8*)(qp + 16 * s); }
    __syncthreads();
    f32x16 sacc[8];
    { const LAS unsigned char* kbase = ldsK + r * 256; const int rx = r & 15;
#pragma unroll
      for (int kb = 0; kb < 8; ++kb) {
#pragma unroll
        for (int i = 0; i < 16; ++i) sacc[kb][i] = 0.f;
#pragma unroll
        for (int s = 0; s < 8; ++s) { const bf16x8 kf = *(const LAS bf16x8*)(kbase + kb * 8192 + (((2 * s + h2) ^ rx) << 4)); sacc[kb] = __builtin_amdgcn_mfma_f32_32x32x16_bf16(kf, qf[s], sacc[kb], 0, 0, 0); }
      } }
    float mx = -3.0e38f;
#pragma unroll
    for (int kb = 0; kb < 8; ++kb)
#pragma unroll
        for (int i = 0; i < 16; ++i) mx = fmaxf(mx, sacc[kb][i]);
    mx = fmaxf(mx, __shfl_xor(mx, 32));
    float sum = 0.f;
#pragma unroll
    for (int kb = 0; kb < 8; ++kb)
#pragma unroll
        for (int i = 0; i < 16; ++i) { const float p = __expf(sacc[kb][i] - mx); sacc[kb][i] = p; sum += p; }
    sum += __shfl_xor(sum, 32);
    const float inv = 1.0f / sum;
    f32x16 oacc[4];
#pragma unroll
    for (int db = 0; db < 4; ++db)
#pragma unroll
        for (int i = 0; i < 16; ++i) oacc[db][i] = 0.f;
    { const LAS unsigned char* vbase = ldsV + r * 512 + h2 * 8;
#pragma unroll
      for (int kb = 0; kb < 8; ++kb)
#pragma unroll
        for (int s2 = 0; s2 < 2; ++s2) {
            u32x4 pw; pw.x = pk2(sacc[kb][8 * s2 + 0], sacc[kb][8 * s2 + 1]); pw.y = pk2(sacc[kb][8 * s2 + 2], sacc[kb][8 * s2 + 3]);
            pw.z = pk2(sacc[kb][8 * s2 + 4], sacc[kb][8 * s2 + 5]); pw.w = pk2(sacc[kb][8 * s2 + 6], sacc[kb][8 * s2 + 7]);
            const bf16x8 pf = __builtin_bit_cast(bf16x8, pw);
            const int c0 = 4 * kb + 2 * s2;
#pragma unroll
            for (int db = 0; db < 4; ++db) {
                const u32x2 lo = *(const LAS u32x2*)(vbase + db * 16384 + ((c0 ^ r) << 4)), hi = *(const LAS u32x2*)(vbase + db * 16384 + (((c0 + 1) ^ r) << 4));
                u32x4 vw; vw.x = lo.x; vw.y = lo.y; vw.z = hi.x; vw.w = hi.y;
                oacc[db] = __builtin_amdgcn_mfma_f32_32x32x16_bf16(__builtin_bit_cast(bf16x8, vw), pf, oacc[db], 0, 0, 0);
            }
        } }
    bf16_t* op = OO + (size_t)(tok0 + r) * KBR + h * 128 + 4 * h2;
#pragma unroll
    for (int db = 0; db < 4; ++db)
#pragma unroll
        for (int g = 0; g < 4; ++g) { u32x2 w; w.x = pk2(oacc[db][4 * g] * inv, oacc[db][4 * g + 1] * inv); w.y = pk2(oacc[db][4 * g + 2] * inv, oacc[db][4 * g + 3] * inv);
            *(u32x2*)(op + db * 32 + 8 * g) = w; }
}

#define XB_TMO      128
#define XB_XCNT(j)  (256  + 64 * (j))
#define XB_XSUB(j)  (1280 + 64 * (j))
#define XB_XGEN(j)  (2304 + 64 * (j))
#define XB_TOP      3328
#define XB_TOPGEN   3392
#define XCD_BAR_WORDS 3456
#define XB_SPIN_CAP (1u << 18)

__device__ __forceinline__ unsigned xb_ld(unsigned* p)              { return __hip_atomic_load(p, __ATOMIC_RELAXED, __HIP_MEMORY_SCOPE_AGENT); }
__device__ __forceinline__ unsigned xb_add(unsigned* p, unsigned v) { return __hip_atomic_fetch_add(p, v, __ATOMIC_RELAXED, __HIP_MEMORY_SCOPE_AGENT); }
__device__ __forceinline__ unsigned xb_xcc_id() { return (unsigned)__builtin_amdgcn_s_getreg((3 << 11) | 20) & 0xFu; }
#define XB_SPIN(cond, bar) do { unsigned _sp = 0; while (cond) { __builtin_amdgcn_s_sleep(1); \
    if ((++_sp & 255u) == 0u) { if (xb_ld(&(bar)[XB_TMO])) break; if (_sp > XB_SPIN_CAP) { atomicAdd(&(bar)[XB_TMO], 1u); break; } } } } while (0)

struct XcdBarrier {
    unsigned* bar; unsigned x;
    volatile LAS unsigned* st;
};

__device__ __forceinline__ XcdBarrier xcd_barrier_post(unsigned* bar, volatile LAS unsigned* st) {
    XcdBarrier b; b.bar = bar; b.x = xb_xcc_id(); b.st = st;
    if (threadIdx.x == 0) (void)xb_add(&bar[XB_XCNT(b.x)], 1u);
    return b;
}
__device__ __forceinline__ void xcd_barrier_complete(unsigned* bar, unsigned x, unsigned& nloc, unsigned& nx) {
    const unsigned G = gridDim.x * gridDim.y * gridDim.z;
    unsigned sum, cnt, mine, sp = 0u;
    for (;;) {
        sum = 0u; cnt = 0u; mine = 0u;
#pragma unroll
        for (unsigned j = 0; j < 16; ++j) { const unsigned c = xb_ld(&bar[XB_XCNT(j)]); sum += c; cnt += (c > 0u) ? 1u : 0u; mine = (j == x) ? c : mine; }
        if (sum == G) break;
        __builtin_amdgcn_s_sleep(1);
        if ((++sp & 255u) == 0u) { if (xb_ld(&bar[XB_TMO])) break; if (sp > XB_SPIN_CAP) { atomicAdd(&bar[XB_TMO], 1u); break; } }
    }
    nloc = mine > 0u ? mine : 1u; nx = cnt > 0u ? cnt : 1u;
}

__device__ __forceinline__ void xcd_barrier(const XcdBarrier& b) {
    asm volatile("s_waitcnt vmcnt(0)" ::: "memory");
    __syncthreads();
    if (threadIdx.x == 0) {
        unsigned* bar = b.bar;
        __builtin_amdgcn_s_waitcnt(0);
        unsigned nloc = b.st[0], nx = b.st[1];
        if (nloc == 0u) { xcd_barrier_complete(bar, b.x, nloc, nx); b.st[0] = nloc; b.st[1] = nx; }
        const unsigned old = xb_add(&bar[XB_XSUB(b.x)], 1u);
        const unsigned gen = old / nloc;
        if (old + 1u == (gen + 1u) * nloc) {
            __builtin_amdgcn_fence(__ATOMIC_RELEASE, "agent");
            asm volatile("s_waitcnt vmcnt(0)" ::: "memory");
            const unsigned og = xb_add(&bar[XB_TOP], 1u);
            const unsigned tg = og / nx;
            if (og + 1u == (tg + 1u) * nx) xb_add(&bar[XB_TOPGEN], 1u);
            else XB_SPIN(xb_ld(&bar[XB_TOPGEN]) == tg, bar);
            __builtin_amdgcn_fence(__ATOMIC_ACQUIRE, "agent");
            xb_add(&bar[XB_XGEN(b.x)], 1u);
            asm volatile("s_waitcnt vmcnt(0)" ::: "memory");
        } else {
            XB_SPIN(xb_ld(&bar[XB_XGEN(b.x)]) == gen, bar);
            __builtin_amdgcn_fence(__ATOMIC_ACQUIRE, "agent");
            asm volatile("s_waitcnt vmcnt(0)" ::: "memory");
        }
    }
    __syncthreads();
}


constexpr int NPHASE = 1 + 11 * NLAYER;

__global__ void __launch_bounds__(512, 2) fwd_mega(Params P) {
    extern __shared__ __attribute__((aligned(16))) unsigned char lds_raw[];
    LAS unsigned char* lds = (LAS unsigned char*)lds_raw;
    const int G = gridDim.x;
    if (threadIdx.x == 0) {
        unsigned vc = blockIdx.x;
#if ONE_LAUNCH
        unsigned* cen = (unsigned*)(P.ws + WS_BAR);
        const unsigned x = xb_xcc_id(), rank = xb_add(cen + 8 * x, 1u);
        unsigned sum = 0, base = 0, sp = 0;
        for (;;) { sum = 0; base = 0;
#pragma unroll
            for (unsigned j = 0; j < 16; ++j) { const unsigned cj = xb_ld(cen + 8 * j); sum += cj; base += (j < x) ? cj : 0u; }
            if (sum == (unsigned)G) break;
            __builtin_amdgcn_s_sleep(1);
            if (++sp > XB_SPIN_CAP) break; }
        const unsigned cp = base + rank, per = (unsigned)G / 8u;
        if (sum == (unsigned)G && (G % 8) == 0 && cp < (unsigned)G) vc = (cp % per) * 8u + cp / per;
#endif
        *(volatile LAS unsigned*)(lds + LDS_BYTES - 8) = vc;
    }
    __syncthreads();
    const int c = __builtin_amdgcn_readfirstlane((int)*(volatile LAS unsigned*)(lds + LDS_BYTES - 8));
    volatile LAS unsigned* bar_st = (volatile LAS unsigned*)(lds + LDS_BYTES - 16);
    if (threadIdx.x == 0) { bar_st[0] = 0u; bar_st[1] = 0u; }
    __syncthreads();
    XcdBarrier gbar = xcd_barrier_post((unsigned*)(P.ws + WS_BAR), bar_st);
#ifdef PROBE_MASK
    unsigned long long pr_acc = 0, pr_t0 = 0;
#endif
    for (int ph = P.ph_lo; ph < P.ph_hi; ++ph) {
#ifdef PROBE_MASK
        if ((PROBE_MASK >> ph) & 1) pr_t0 = wall_clock64();
#endif
        unsigned char* ws = P.ws;
        asm volatile("" : "+s"(ws));
        const char* xb = (const char*)(ws + WS_XB);
        if (ph == 0) {
            if (PHON(0)) setup_phase(P, lds);
            if (PHON(1)) convert_weights(P, 0, lds);
        } else {
            const int l = (ph - 1) / 11, sp = (ph - 1) % 11;
            if (PHON(2) && (sp == 0 || sp == 8)) {
                SchedFfnUp S{xb, (const char*)(ws + (sp == 0 ? WS_W13A : WS_W13B)), G, c};
                EpiSwiGLU E{(bf16_t*)(ws + WS_H)};
                gemm_phase(lds, DM, DM, DM, S, E);
            } else if (PHON(3) && (sp == 1 || sp == 9)) {
                SchedPlain S{(const char*)(ws + WS_H), (const char*)(ws + (sp == 1 ? WS_W2A : WS_W2B)), 64, 8, (size_t)256 * DFF * 2, (size_t)256 * DFF * 2, G, c};
                const float* stats = (const float*)(ws + WS_STATS);
                if (l == 0 && sp == 1) { EpiResid<false, 1> E{P.in[0], P.out, stats, nullptr, nullptr}; gemm_phase(lds, DFF, DFF, DFF, S, E); }
                else {
                    const float* lg = (sp == 1) ? P.in[21] + (size_t)(l - 1) * DM : P.in[17] + (size_t)l * DM;
                    const float* lb = (sp == 1) ? P.in[22] + (size_t)(l - 1) * DM : P.in[18] + (size_t)l * DM;
                    asm volatile("" : "+s"(lg), "+s"(lb), "+s"(stats));
                    EpiResid<true, 1> E{P.out, P.out, stats, lg, lb}; gemm_phase(lds, DFF, DFF, DFF, S, E); }
            } else if (PHON(4) && (sp == 2 || sp == 7 || sp == 10)) {
                const int gi = sp == 2 ? 4 : (sp == 7 ? 17 : 21);
                if (sp == 2) {
                    if (c < 8) { SchedKV S{(const char*)(ws + WS_MEMB), (const char*)(ws + WS_WKV), c}; EpiKV E{(bf16_t*)(ws + WS_KK), (bf16_t*)(ws + WS_VT)}; gemm_phase(lds, DM, DM, DM, S, E); }
                    else ln_fold_phase(P.out, (bf16_t*)(ws + WS_XB), (bf16_t*)(ws + WS_XP), (bf16_t*)(ws + WS_XM), (float*)(ws + WS_STATS), P.in[4] + (size_t)l * DM, P.in[5] + (size_t)l * DM, c);
                } else
                ln_phase(P.out, (bf16_t*)(ws + WS_XB), (float*)(ws + WS_STATS), P.in[gi] + (size_t)l * DM, P.in[gi + 1] + (size_t)l * DM, sp == 10 && l == NLAYER - 1);
                if (PHON(1) && sp == 10 && l + 1 < NLAYER) convert_weights(P, l + 1, lds);
            } else if (PHON(5) && sp == 3) {
                {
                    const int tid = ltid(), lane = tid & 63, gwv = c * 8 + (tid >> 6);
                    if (gwv < 1024) { const int bb = gwv >> 9, ch = gwv & 511;
                        const u32x4* xr = (const u32x4*)(xb + ((size_t)(bb * SEQ + HSEQ)) * ROWB) + lane; const u32x4* wrow = (const u32x4*)(ws + WS_WFT + (size_t)ch * ROWB) + lane; float sdot = 0.f;
#pragma unroll
                        for (int i = 0; i < 4; ++i) { f32x4 x0, x1, w0, w1; unpack8(xr[64 * i], x0, x1); unpack8(wrow[64 * i], w0, w1);
                            sdot += (x0[0] * w0[0] + x0[1] * w0[1]) + (x0[2] * w0[2] + x0[3] * w0[3]) + (x1[0] * w1[0] + x1[1] * w1[1]) + (x1[2] * w1[2] + x1[3] * w1[3]); }
                        sdot = wave_sum(sdot);
                        if (lane == 0) ((float*)(ws + WS_UH))[gwv] = (sdot + ((const float*)(ws + WS_BIAST))[ch]) * 0.011048543456039806f; }
                }
                SchedWin S{xb, (const char*)(ws + WS_WIN), (const char*)(ws + WS_WFT), (const char*)(ws + WS_XP), (const char*)(ws + WS_XM), G, c};
                EpiWin E{P.in[7] + (size_t)l * DIN, (const float*)(ws + WS_BIAST), (bf16_t*)(ws + WS_GLU), (bf16_t*)(ws + WS_Q), (bf16_t*)(ws + WS_G), (bf16_t*)(ws + WS_TT)};
                gemm_phase(lds, DM, DM, DM, S, E);
            } else if (sp == 4) {
                if (PHON(6)) { SchedDft S{(const char*)(ws + WS_CM), (const char*)(ws + WS_TT), G, c};
                  EpiDft E{(bf16_t*)(ws + WS_BR) + 1024, (const float*)(ws + WS_UH)};
                  gemm_phase(lds, HSEQ, HSEQ, SEQ, S, E); }
                const int half = G >> 1, hi = (c >= half) ? 1 : 0, cc = c - hi * half;
                if (hi) {
                    const int tid = ltid(), lane = tid & 63, gwv = cc * 8 + (tid >> 6);
                    if (gwv < 1024) { const int bb = gwv >> 9, ch = gwv & 511;
                        const u32x4* tr = (const u32x4*)(ws + WS_TT + ((size_t)ch * SEQ + (size_t)bb * HSEQ) * 2) + lane; float sa = 0.f;
#pragma unroll
                        for (int i = 0; i < 8; ++i) { f32x4 x0, x1; unpack8(tr[64 * i], x0, x1); sa += (x0[0] - x0[1]) + (x0[2] - x0[3]) + (x1[0] - x1[1]) + (x1[2] - x1[3]); }
                        sa = wave_sum(sa);
                        if (lane == 0) { bf16_t* orow = (bf16_t*)(ws + WS_BR) + (size_t)(bb * SEQ + HSEQ) * KBR; orow[1024 + ch] = f2bf(sa * 0.011048543456039806f + ((const float*)(ws + WS_UH))[gwv]); orow[1536 + ch] = 0; } }
                }
                if (PHON(7)) { const int nct = hi ? 6 : 2, ct0 = hi ? 2 * half : 0;
                    for (int j = 0; j < nct; ++j)
                        conv_tile((const bf16_t*)(ws + WS_GLU), (bf16_t*)(ws + WS_BR), P.in[8] + (size_t)l * 31 * 1024, P.in[9] + (size_t)l * 1024, P.in[10] + (size_t)l * 1024, P.in[11] + (size_t)l * 1024, ct0 + cc + half * j, lds); }
                if (PHON(8) && hi) for (int j = 0; j < 2; ++j) { const int t = 2 * cc + j;
                    attn_unit((const bf16_t*)(ws + WS_Q), (const bf16_t*)(ws + WS_KK), (const bf16_t*)(ws + WS_VT), (bf16_t*)(ws + WS_BR) + 2048, t >> 7, (t >> 5) & 3, t & 31, lds, j == 0); }
                __syncthreads();
            } else if (PHON(9) && sp == 5) {
                SchedPlain S{(const char*)(ws + WS_BR), (const char*)(ws + WS_WBR), 64, 8, (size_t)256 * KBR * 2, (size_t)256 * KBR * 2, G, c};
                EpiBranchFused E{(const bf16_t*)(ws + WS_G), (bf16_t*)(ws + WS_MG)};
                gemm_phase(lds, KBR, KBR, KBR, S, E);
            } else if (PHON(10) && sp == 6) {
                SchedPlain S{(const char*)(ws + WS_MG), (const char*)(ws + WS_WOUT), 64, 8, (size_t)256 * DM * 2, (size_t)256 * DM * 2, G, c};
                const float* stats = (const float*)(ws + WS_STATS); const float* lg = P.in[4] + (size_t)l * DM; const float* lb = P.in[5] + (size_t)l * DM;
                asm volatile("" : "+s"(lg), "+s"(lb), "+s"(stats));
                EpiResid<true, 2> E{P.out, P.out, stats, lg, lb};
                gemm_phase(lds, DM, DM, DM, S, E);
            }
        }
        if (ph + 1 < P.ph_hi) { if (P.ph_lo < 0) cg::this_grid().sync(); else xcd_barrier(gbar); }
#ifdef PROBE_MASK
        if ((PROBE_MASK >> ph) & 1) pr_acc += wall_clock64() - pr_t0;
#endif
    }
#ifdef PROBE_MASK
    if (c == 0) { const unsigned long long t0 = wall_clock64(); while (wall_clock64() - t0 < (unsigned long long)PROBE_MULT * pr_acc) __builtin_amdgcn_s_sleep(32); }
#endif
}

extern "C" void kernel_launch(void* const* d_in, const int* in_sizes, int n_in, void* d_out, int out_size, void* d_ws, size_t ws_size, hipStream_t stream) {
    static int grid = 0;
    if (grid == 0) {
        if (n_in != 23 || out_size != NTOK * DM || ws_size < WS_END) { fprintf(stderr, "kernel_launch: unexpected shapes (n_in %d, out %d, ws %zu < %zu)\n", n_in, out_size, ws_size, (size_t)WS_END); grid = -1; return; }
        int dev = 0, cus = 0, per_cu = 0;
        hipGetDevice(&dev);
        hipDeviceGetAttribute(&cus, hipDeviceAttributeMultiprocessorCount, dev);
        hipFuncSetAttribute((const void*)fwd_mega, hipFuncAttributeMaxDynamicSharedMemorySize, LDS_BYTES);
        hipOccupancyMaxActiveBlocksPerMultiprocessor(&per_cu, (const void*)fwd_mega, 512, LDS_BYTES);
        if (per_cu < 1) { fprintf(stderr, "kernel_launch: occupancy query says %d blocks per CU\n", per_cu); per_cu = 1; }
        (void)hipGetLastError();
        grid = cus;
    }
    if (grid < 0) return;
    Params p{};
    for (int i = 0; i < 23; ++i) p.in[i] = (const float*)d_in[i];
    p.out = (float*)d_out; p.ws = (unsigned char*)d_ws;
#if ONE_LAUNCH
    hipMemsetAsync((unsigned char*)d_ws + WS_BAR, 0, XCD_BAR_WORDS * sizeof(unsigned), stream);
    p.ph_lo = 0; p.ph_hi = NPHASE;
    void* args[] = {&p};
    hipError_t e = hipLaunchCooperativeKernel((const void*)fwd_mega, dim3(grid), dim3(512), args, LDS_BYTES, stream);
    if (e != hipSuccess) fprintf(stderr, "cooperative launch failed: %s (grid %d)\n", hipGetErrorString(e), grid);
#else
    for (int ph = 0; ph < NPHASE; ++ph) { p.ph_lo = ph; p.ph_hi = ph + 1; hipLaunchKernelGGL(fwd_mega, dim3(grid), dim3(512), LDS_BYTES, stream, p); }
#endif
}
```
